# Optimizing an MI355X kernel written in HIP

```python
import math
import jax, jax.numpy as jnp
from jax import lax
import numpy as np

D_MODEL = 2048
BATCH = 1
SEQ = 16384
DEPTH = 2
DEC_BATCH = 4
DEC_SEQ = 8192
PAST_LEN = 128

GRID_W = 64
PLE_DIM = 256
NORM_EPS = 1e-6
Q_BLOCK = 128
HA = 8
DA = 128
A_WIDTH = HA * DA
SHORT_CONV = 3
DELTA_CHUNK = 64
HB = 8
KVB = 2
DB = 128
AXIAL_THETA = 10000.0
HC = 8
DC = 64
DVC = 2 * DC
ROT_C = DC // 4
ROPE_THETA = 500000.0
D_FF = 5632
FFN_CONV = 3
IN_SIZES = (3 * A_WIDTH, A_WIDTH, 2 * HA, 2 * HA, HB * DB, KVB * DB, KVB * DB, HC * 2 * DC, HC * 2 * DC, HC * DVC, 3 * D_MODEL)
N_IN = sum(IN_SIZES)

kernel_name = 'hybrid_bidir_encoder_gdn_axialgqa_diffattn'


def rms_norm(x, g):
    xf = x.astype(jnp.float32)
    y = xf * lax.rsqrt(jnp.mean(xf * xf, axis=-1, keepdims=True) + NORM_EPS)
    return (y * g.astype(jnp.float32)).astype(x.dtype)


def l2_normalise(x):
    xf = x.astype(jnp.float32)
    return xf * lax.rsqrt(jnp.sum(xf * xf, axis=-1, keepdims=True) + NORM_EPS)


def dwconv_centred(x, w):
    K = w.shape[0]
    r = K // 2
    S = x.shape[1]
    xp = jnp.pad(x, ((0, 0), (r, r), (0, 0)))
    return sum(xp[:, j:j + S] * w[j] for j in range(K))


def rope_angles(pos, dim, theta):
    inv = theta ** (-jnp.arange(0, dim, 2, dtype=jnp.float32) / dim)
    return pos[:, None] * inv[None, :]


def rotate_half_rope(x, ang):
    d2 = x.shape[-1] // 2
    c = jnp.cos(ang).astype(x.dtype)
    s = jnp.sin(ang).astype(x.dtype)
    x1, x2 = x[..., :d2], x[..., d2:]
    return jnp.concatenate([x1 * c - x2 * s, x2 * c + x1 * s], axis=-1)


def axial_rope(x):
    S = x.shape[1]
    rows = S // GRID_W
    row = jnp.broadcast_to(jnp.arange(rows, dtype=jnp.float32)[:, None], (rows, GRID_W)).reshape(S)
    col = jnp.broadcast_to(jnp.arange(GRID_W, dtype=jnp.float32)[None, :], (rows, GRID_W)).reshape(S)
    half = x.shape[-1] // 2
    ang_r = rope_angles(row, half, AXIAL_THETA)[:, None, :]
    ang_c = rope_angles(col, half, AXIAL_THETA)[:, None, :]
    return jnp.concatenate([rotate_half_rope(x[..., :half], ang_r), rotate_half_rope(x[..., half:], ang_c)], axis=-1)


def sweep_query_blocks(fn, q):
    B, S = q.shape[0], q.shape[1]
    nb = S // Q_BLOCK
    qb = jnp.moveaxis(q.reshape((B, nb, Q_BLOCK) + q.shape[2:]), 1, 0)
    out = jnp.moveaxis(lax.map(fn, qb), 0, 1)
    return out.reshape((B, S) + out.shape[3:])


def gated_delta_chunked(q, k, v, g, beta):
    f32 = jnp.float32
    B, S, H, dk = q.shape
    dv = v.shape[-1]
    C = DELTA_CHUNK
    n = S // C

    def chunks(t):
        return t.astype(f32).reshape(B, n, C, H, -1).transpose(0, 3, 1, 2, 4)

    q = chunks(q) * (dk ** -0.5)
    k = chunks(k)
    v = chunks(v)
    g = jnp.cumsum(g.astype(f32).reshape(B, n, C, H).transpose(0, 3, 1, 2), axis=-1)
    beta = beta.astype(f32).reshape(B, n, C, H).transpose(0, 3, 1, 2)[..., None]
    k_beta = k * beta
    v_beta = v * beta
    incl = jnp.tril(jnp.ones((C, C), dtype=bool))
    strict = jnp.tril(jnp.ones((C, C), dtype=bool), -1)
    diff = g[..., :, None] - g[..., None, :]
    decay = jnp.where(incl, jnp.exp(jnp.where(incl, diff, 0.0)), 0.0)
    lower = jnp.where(strict, jnp.einsum('bhncd,bhnsd->bhncs', k_beta, k) * decay, 0.0)
    a = lower + jnp.eye(C, dtype=f32)
    rhs = jnp.concatenate([v_beta, k_beta * jnp.exp(g)[..., None]], axis=-1)
    sol = lax.linalg.triangular_solve(a, rhs, left_side=True, lower=True, unit_diagonal=True)
    u, w = sol[..., :dv], sol[..., dv:]
    intra = jnp.where(incl, jnp.einsum('bhncd,bhnsd->bhncs', q, k) * decay, 0.0)
    g_last = g[..., -1]
    q_dec = q * jnp.exp(g)[..., None]
    k_dec = k * jnp.exp(g_last[..., None] - g)[..., None]

    def step(state, xs):
        q_n, k_n, u_n, w_n, a_n, gl_n = xs
        v_new = u_n - jnp.einsum('bhcd,bhde->bhce', w_n, state)
        o = jnp.einsum('bhcd,bhde->bhce', q_n, state) + jnp.einsum('bhcs,bhse->bhce', a_n, v_new)
        state = state * jnp.exp(gl_n)[..., None, None] + jnp.einsum('bhcd,bhce->bhde', k_n, v_new)
        return state, o

    xs = tuple(jnp.moveaxis(t, 2, 0) for t in (q_dec, k_dec, u, w, intra, g_last))
    state0 = jnp.zeros((B, H, dk, dv), f32)
    _, o = lax.scan(step, state0, xs)
    return o.transpose(1, 0, 3, 2, 4).reshape(B, S, H, dv)


def gdn_branch(qkv, z, alpha, beta_logit, conv_w, a_log, dt_bias, norm_w):
    B, S, _ = qkv.shape
    qkv = jax.nn.silu(dwconv_centred(qkv, conv_w))
    q, k, v = jnp.split(qkv, 3, axis=-1)
    q = l2_normalise(q.reshape(B, S, HA, DA))
    k = l2_normalise(k.reshape(B, S, HA, DA))
    v = v.reshape(B, S, HA, DA)
    g = -jnp.exp(a_log.astype(jnp.float32)) * jax.nn.softplus(alpha.astype(jnp.float32) + dt_bias.astype(jnp.float32))
    bt = jax.nn.sigmoid(beta_logit.astype(jnp.float32))
    o_fwd = gated_delta_chunked(q, k, v, g[:, :, 0], bt[:, :, 0])
    flip = lambda t: jnp.flip(t, axis=1)
    o_bwd = flip(gated_delta_chunked(flip(q), flip(k), flip(v), flip(g[:, :, 1]), flip(bt[:, :, 1])))
    o = rms_norm(o_fwd + o_bwd, norm_w) * jax.nn.silu(z.reshape(B, S, HA, DA).astype(jnp.float32))
    return o.reshape(B, S, A_WIDTH).astype(qkv.dtype)


def gqa_axial_branch(q, k, v, qn, kn):
    B, S, _ = q.shape
    q = axial_rope(rms_norm(q.reshape(B, S, HB, DB), qn))
    k = axial_rope(rms_norm(k.reshape(B, S, KVB, DB), kn))
    v = v.reshape(B, S, KVB, DB)
    q = q.reshape(B, S, KVB, HB // KVB, DB)
    scale = DB ** -0.5

    def block(qb):
        s = jnp.einsum('bqhgd,bshd->bhgqs', qb, k).astype(jnp.float32) * scale
        pr = jax.nn.softmax(s, axis=-1).astype(v.dtype)
        return jnp.einsum('bhgqs,bshd->bqhgd', pr, v)

    o = sweep_query_blocks(block, q)
    return o.reshape(B, S, HB * DB)


def diff_branch(q, k, v, qn, kn, lambdas, subln, lambda_init):
    B, S, _ = q.shape
    pos = jnp.arange(S, dtype=jnp.float32)
    ang = rope_angles(pos, ROT_C, ROPE_THETA)[:, None, None, :]

    def prep(t, gn):
        t = rms_norm(t.reshape(B, S, HC, 2, DC), gn)
        return jnp.concatenate([rotate_half_rope(t[..., :ROT_C], ang), t[..., ROT_C:]], axis=-1)

    q = prep(q, qn)
    k = prep(k, kn)
    v = v.reshape(B, S, HC, DVC)
    lf = lambdas.astype(jnp.float32)
    lam = jnp.exp(jnp.sum(lf[0] * lf[1])) - jnp.exp(jnp.sum(lf[2] * lf[3])) + lambda_init
    scale = DC ** -0.5

    def block(qb):
        s = jnp.einsum('bqhcd,bshcd->bhcqs', qb, k).astype(jnp.float32) * scale
        pr = jax.nn.softmax(s, axis=-1)
        a = (pr[:, :, 0] - lam * pr[:, :, 1]).astype(v.dtype)
        return jnp.einsum('bhqs,bshd->bqhd', a, v)

    o = sweep_query_blocks(block, q)
    o = rms_norm(o, subln) * (1.0 - lambda_init)
    return o.reshape(B, S, HC * DVC)


def encoder_layer(x, p_emb, prm, i):
    B, S, _ = x.shape
    h = rms_norm(x, prm['norm_mix'][i])
    proj = h @ prm['w_in'][i]
    offs = [int(o) for o in np.cumsum(IN_SIZES)[:-1]]
    a_qkv, a_z, a_alpha, a_beta, b_q, b_k, b_v, c_q, c_k, c_v, gate_logits = jnp.split(proj, offs, axis=-1)
    y_a = gdn_branch(a_qkv, a_z, a_alpha.reshape(B, S, 2, HA), a_beta.reshape(B, S, 2, HA),
                     prm['conv_a'][i], prm['a_log'][i], prm['dt_bias'][i], prm['norm_a'][i]) @ prm['w_o_a'][i]
    y_b = gqa_axial_branch(b_q, b_k, b_v, prm['qn_b'][i], prm['kn_b'][i]) @ prm['w_o_b'][i]
    lambda_init = 0.8 - 0.6 * math.exp(-0.3 * i)
    y_c = diff_branch(c_q, c_k, c_v, prm['qn_c'][i], prm['kn_c'][i], prm['lambdas_c'][i],
                      prm['subln_c'][i], lambda_init) @ prm['w_o_c'][i]
    g_a, g_b, g_c = jnp.split(jax.nn.sigmoid(gate_logits), 3, axis=-1)
    x = x + (g_a * y_a + g_b * y_b + g_c * y_c) @ prm['w_out'][i]
    h2 = rms_norm(x, prm['norm_ffn'][i])
    u = dwconv_centred(h2 @ prm['w_up'][i], prm['conv_ffn'][i]) + prm['conv_ffn_b'][i]
    u_gate, u_val = jnp.split(u, 2, axis=-1)
    x = x + (jax.nn.silu(u_gate) * u_val) @ prm['w_down'][i]
    x = x + jax.nn.sigmoid(x @ prm['w_ple_gate'][i]) * (p_emb @ prm['w_ple'][i])
    return x


def encoder_trunk(x, p, prm):
    for i in range(DEPTH):
        x = encoder_layer(x, p[i], prm, i)
    return x


def setup_inputs(seed: int = 0) -> dict:
    key = jax.random.key(seed)
    ks = iter(jax.random.split(key, 32))
    f32 = jnp.float32
    L = DEPTH

    def nrm(shape, scale):
        return jax.random.normal(next(ks), shape, f32) * scale

    def gain(shape):
        return 1.0 + 0.05 * jax.random.normal(next(ks), shape, f32)

    return {
        'x_prompt': nrm((BATCH, SEQ, D_MODEL), 1.0),
        'x_sample': nrm((DEC_BATCH, DEC_SEQ, D_MODEL), 1.0),
        'p_prompt': nrm((DEPTH, BATCH, SEQ, PLE_DIM), 1.0),
        'p_sample': nrm((DEPTH, DEC_BATCH, DEC_SEQ, PLE_DIM), 1.0),
        'norm_mix': gain((L, D_MODEL)),
        'w_in': nrm((L, D_MODEL, N_IN), D_MODEL ** -0.5),
        'conv_a': nrm((L, SHORT_CONV, 3 * A_WIDTH), SHORT_CONV ** -0.5),
        'a_log': jnp.log(jax.random.uniform(next(ks), (L, 2, HA), f32, 1.0, 16.0)),
        'dt_bias': nrm((L, 2, HA), 0.1),
        'norm_a': gain((L, DA)),
        'qn_b': gain((L, DB)),
        'kn_b': gain((L, DB)),
        'qn_c': gain((L, DC)),
        'kn_c': gain((L, DC)),
        'lambdas_c': nrm((L, 4, DC), 0.1),
        'subln_c': gain((L, DVC)),
        'w_o_a': nrm((L, A_WIDTH, D_MODEL), A_WIDTH ** -0.5),
        'w_o_b': nrm((L, HB * DB, D_MODEL), (HB * DB) ** -0.5),
        'w_o_c': nrm((L, HC * DVC, D_MODEL), (HC * DVC) ** -0.5),
        'w_out': nrm((L, D_MODEL, D_MODEL), D_MODEL ** -0.5),
        'norm_ffn': gain((L, D_MODEL)),
        'w_up': nrm((L, D_MODEL, 2 * D_FF), D_MODEL ** -0.5),
        'conv_ffn': nrm((L, FFN_CONV, 2 * D_FF), FFN_CONV ** -0.5),
        'conv_ffn_b': nrm((L, 2 * D_FF), 0.01),
        'w_down': nrm((L, D_FF, D_MODEL), D_FF ** -0.5),
        'w_ple': nrm((L, PLE_DIM, D_MODEL), PLE_DIM ** -0.5),
        'w_ple_gate': nrm((L, D_MODEL, D_MODEL), D_MODEL ** -0.5),
    }


def reference(x_prompt, x_sample, p_prompt, p_sample, norm_mix, w_in, conv_a, a_log, dt_bias, norm_a,
              qn_b, kn_b, qn_c, kn_c, lambdas_c, subln_c, w_o_a, w_o_b, w_o_c, w_out, norm_ffn,
              w_up, conv_ffn, conv_ffn_b, w_down, w_ple, w_ple_gate):
    prm = dict(norm_mix=norm_mix, w_in=w_in, conv_a=conv_a, a_log=a_log, dt_bias=dt_bias, norm_a=norm_a,
               qn_b=qn_b, kn_b=kn_b, qn_c=qn_c, kn_c=kn_c, lambdas_c=lambdas_c, subln_c=subln_c,
               w_o_a=w_o_a, w_o_b=w_o_b, w_o_c=w_o_c, w_out=w_out, norm_ffn=norm_ffn,
               w_up=w_up, conv_ffn=conv_ffn, conv_ffn_b=conv_ffn_b, w_down=w_down,
               w_ple=w_ple, w_ple_gate=w_ple_gate)
    y_prompt = encoder_trunk(x_prompt, p_prompt, prm)
    y_sample = encoder_trunk(x_sample, p_sample, prm)
    return (y_prompt, y_sample)
```

```cpp
#include <hip/hip_runtime.h>
#include <cstdio>
#include <cstdint>
namespace pg8 {
#define PG8_LAS __attribute__((address_space(3)))
typedef unsigned short bf16_t;
typedef short bf16x8 __attribute__((ext_vector_type(8)));
typedef float f32x4 __attribute__((ext_vector_type(4)));
typedef unsigned u32x4 __attribute__((ext_vector_type(4)));
constexpr int BM = 256, BK = 64, HALF = 128, HTB = HALF * BK * 2  , STAGE_BYTES = 8 * HTB, NXCD = 8, WGM = 8;

__host__ __device__ __forceinline__ int lds_byte(int r, int c) { const int st = (r >> 4) * 2 + (c >> 5), rr = r & 15, cc = c & 31, ob = rr * 64 + cc * 2; return st * 1024 + (ob ^ (((ob >> 9) & 1) << 5)); }
__host__ __device__ __forceinline__ void stage_rc(int b, int& R, int& C) { const int st = b / 1024, sb = b % 1024, swz = sb ^ (((sb >> 9) & 1) << 5); R = (st >> 1) * 16 + swz / 64; C = (st & 1) * 32 + (swz % 64) / 2; }
__host__ __device__ __forceinline__ int perm32(int rho) { const int n = rho >> 4, i = rho & 15; return 8 * (i >> 2) + 4 * n + (i & 3); }

struct Unit { int pm, pn; };
struct Gemm { const bf16_t* A; const bf16_t* Bt; int M, N, K, lda, ldb; };

struct StaticOrder {
    int nM, nN, nwg, G, c;
    __host__ __device__ void init(int M, int N, int G_, int c_) { nM = M / BM; nN = N / BM; nwg = nM * nN; G = G_; c = c_; }
    __host__ __device__ bool next(int i, Unit& u) const {
        const long L = (long)i * G + c; if (L >= nwg) return false;
        int wgid = (int)L; { const int q = nwg / NXCD, r = nwg % NXCD, xcd = wgid % NXCD, off = wgid / NXCD; wgid = (xcd < r ? xcd * (q + 1) : r * (q + 1) + (xcd - r) * q) + off; }
        const int nig = WGM * nN, gid = wgid / nig, fm = gid * WGM, gsz = (nM - fm) < WGM ? (nM - fm) : WGM;
        u.pm = fm + ((wgid % nig) % gsz); u.pn = (wgid % nig) / gsz; return true;
    }
    __device__ __forceinline__ void a_ready(const Unit&) const {}
    __device__ __forceinline__ void done(const Unit&) const {}
};
template <class Epi, class Sched, bool STAMP = false>
__device__ __forceinline__ void gemm_phase(PG8_LAS unsigned char* lds, const Gemm g, const Sched& S, const Epi& E, unsigned long long* stamps) {
    int tid_ = threadIdx.x; asm volatile("" : "+v"(tid_));
    const int tid = tid_, wid = __builtin_amdgcn_readfirstlane(tid >> 6), lane = tid & 63, wr = wid >> 2, wc = wid & 3, fr = lane & 15, fq = lane >> 4;
    const int K = g.K, nt = K / BK;
    int ts_lo = 0, ts_hi = 0, nts = 0; const unsigned long long rt_entry = STAMP ? (unsigned long long)wall_clock64() : 0ull;
#define PG8_STAMP() do { if (STAMP && wid == 0 && nts < 64) { const unsigned long long _c = (unsigned long long)clock64(); \
        ts_lo = (lane == nts) ? (int)(unsigned)_c : ts_lo; ts_hi = (lane == nts) ? (int)(unsigned)(_c >> 32) : ts_hi; ++nts; } } while (0)
    PG8_STAMP();
    unsigned voffA[2], voffB[2];
#pragma unroll
    for (int i = 0; i < 2; ++i) { int R, C; stage_rc(tid * 16 + i * 8192, R, C); const int Rb = Epi::PERM ? ((R & ~31) + perm32(R & 31)) : R;
        voffA[i] = (unsigned)(R * g.lda + C) * 2u; voffB[i] = (unsigned)(Rb * g.ldb + C) * 2u; }
    const size_t kstep = (size_t)(BK * 2);
    const size_t hstepA = (size_t)HALF * g.lda * 2, hstepB = (size_t)HALF * g.ldb * 2;
    const size_t tstepA = 2 * hstepA, tstepB = 2 * hstepB;
    const unsigned ldsw = (unsigned)wid * 1024u;
    const int aoff = lds_byte(wr * 64 + fr, fq * 8), boff = lds_byte(wc * 32 + fr, fq * 8);
#define PG8_SA(b, h) (((b) * 2 + (h)) * HTB)
#define PG8_SB(b, h) ((4 + (b) * 2 + (h)) * HTB)
#define PG8_STAGE(bufoff, gbase, voff) do { _Pragma("unroll") for (int _i = 0; _i < 2; ++_i) \
        __builtin_amdgcn_global_load_lds((const unsigned*)((const char*)(gbase) + (voff)[_i]), (PG8_LAS unsigned*)(lds + (bufoff) + ldsw + _i * 8192), 16, 0, 0); } while (0)
#define PG8_LDA(dst, b, h) do { _Pragma("unroll") for (int m = 0; m < 4; ++m) _Pragma("unroll") for (int k = 0; k < 2; ++k) dst[m][k] = *(const PG8_LAS bf16x8*)(lds + PG8_SA(b, h) + aoff + m * 2048 + k * 1024); } while (0)
#define PG8_LDB(dst, b, h) do { _Pragma("unroll") for (int n = 0; n < 2; ++n) _Pragma("unroll") for (int k = 0; k < 2; ++k) dst[n][k] = *(const PG8_LAS bf16x8*)(lds + PG8_SB(b, h) + boff + n * 2048 + k * 1024); } while (0)
#define PG8_MMA(ai, bj, At, Bt) do { __builtin_amdgcn_s_setprio(1); _Pragma("unroll") for (int m = 0; m < 4; ++m) _Pragma("unroll") for (int n = 0; n < 2; ++n) _Pragma("unroll") for (int k = 0; k < 2; ++k) \
        acc[ai][bj][m][n] = __builtin_amdgcn_mfma_f32_16x16x32_bf16(Bt[n][k], At[m][k], acc[ai][bj][m][n], 0, 0, 0); __builtin_amdgcn_s_setprio(0); } while (0)
#define PG8_WAIT_V(n) asm volatile("s_waitcnt vmcnt(" #n ")" ::: "memory")
#define PG8_WAIT_L(n) asm volatile("s_waitcnt lgkmcnt(" #n ")" ::: "memory")
#define PG8_BAR __builtin_amdgcn_s_barrier()
#define PG8_SCHED __builtin_amdgcn_sched_barrier(0)
    Unit cur, nxt; int ui = 0;
    if (!S.next(0, cur)) return;
    f32x4 acc[2][2][4][2];
#pragma unroll
    for (int a = 0; a < 2; ++a)
#pragma unroll
        for (int b = 0; b < 2; ++b)
#pragma unroll
            for (int m = 0; m < 4; ++m)
#pragma unroll
                for (int n = 0; n < 2; ++n) acc[a][b][m][n] = (f32x4){0.f, 0.f, 0.f, 0.f};
    bf16x8 At[4][2], B0[2][2], B1[2][2];
    const char* cA = (const char*)g.A + (size_t)cur.pm * tstepA; const char* cB = (const char*)g.Bt + (size_t)cur.pn * tstepB;
    S.a_ready(cur);
    PG8_STAGE(PG8_SB(0, 0), cB, voffB); PG8_STAGE(PG8_SA(0, 0), cA, voffA); PG8_STAGE(PG8_SB(0, 1), cB + hstepB, voffB); PG8_STAGE(PG8_SA(0, 1), cA + hstepA, voffA);
    if (wr == 1) PG8_BAR;
    PG8_WAIT_V(4); PG8_BAR;
    PG8_STAGE(PG8_SB(1, 0), cB + kstep, voffB); PG8_STAGE(PG8_SA(1, 0), cA + kstep, voffA); PG8_STAGE(PG8_SB(1, 1), cB + hstepB + kstep, voffB);
    PG8_WAIT_V(6); PG8_BAR;
    PG8_STAMP();
    for (;;) {
        const bool has_next = S.next(ui + 1, nxt);
        const char* nA = has_next ? (const char*)g.A + (size_t)nxt.pm * tstepA : cA; const char* nB = has_next ? (const char*)g.Bt + (size_t)nxt.pn * tstepB : cB;
        for (int t = 0; t < nt; t += 2) {
            const bool last = (t == nt - 2);
            const char* a1 = cA + (size_t)(t + 1) * kstep;
            const char* a2 = last ? nA : cA + (size_t)(t + 2) * kstep; const char* b2 = last ? nB : cB + (size_t)(t + 2) * kstep;
            const char* a3 = a2 + kstep; const char* b3 = b2 + kstep;
            if (last && has_next) S.a_ready(nxt);
            PG8_LDB(B0, 0, 0); PG8_SCHED; PG8_LDA(At, 0, 0); PG8_STAGE(PG8_SA(1, 1), a1 + hstepA, voffA);
            PG8_WAIT_L(8); PG8_BAR; PG8_WAIT_L(0); PG8_MMA(0, 0, At, B0); PG8_BAR; PG8_SCHED;
            PG8_LDB(B1, 0, 1); PG8_STAGE(PG8_SB(0, 0), b2, voffB);
            PG8_BAR; PG8_WAIT_L(0); PG8_MMA(0, 1, At, B1); PG8_BAR;
            PG8_LDA(At, 0, 1); PG8_STAGE(PG8_SA(0, 0), a2, voffA);
            PG8_BAR; PG8_WAIT_L(0); PG8_MMA(1, 0, At, B0); PG8_BAR; PG8_SCHED;
            PG8_STAGE(PG8_SB(0, 1), b2 + hstepB, voffB);
            PG8_WAIT_V(6); PG8_BAR; PG8_MMA(1, 1, At, B1); PG8_BAR;
            PG8_LDB(B0, 1, 0); PG8_SCHED; PG8_LDA(At, 1, 0); PG8_STAGE(PG8_SA(0, 1), a2 + hstepA, voffA);
            PG8_WAIT_L(8); PG8_BAR; PG8_WAIT_L(0); PG8_MMA(0, 0, At, B0); PG8_BAR; PG8_SCHED;
            PG8_LDB(B1, 1, 1); PG8_STAGE(PG8_SB(1, 0), b3, voffB);
            PG8_BAR; PG8_WAIT_L(0); PG8_MMA(0, 1, At, B1); PG8_BAR;
            PG8_LDA(At, 1, 1); PG8_STAGE(PG8_SA(1, 0), a3, voffA);
            PG8_BAR; PG8_WAIT_L(0); PG8_MMA(1, 0, At, B0); PG8_BAR; PG8_SCHED;
            PG8_STAGE(PG8_SB(1, 1), b3 + hstepB, voffB);
            PG8_WAIT_V(6); PG8_BAR; PG8_MMA(1, 1, At, B1); PG8_BAR;
        }
        PG8_STAMP();
        if constexpr (!Epi::AFTER_DRAIN) { E(acc, cur, wr, wc, fr, fq); S.done(cur); }
        PG8_STAMP();
        if (!has_next) break;
#pragma unroll
        for (int a = 0; a < 2; ++a)
#pragma unroll
            for (int b = 0; b < 2; ++b)
#pragma unroll
                for (int m = 0; m < 4; ++m)
#pragma unroll
                    for (int n = 0; n < 2; ++n) acc[a][b][m][n] = (f32x4){0.f, 0.f, 0.f, 0.f};
        cur = nxt; cA = nA; cB = nB; ++ui;
    }
    PG8_WAIT_V(0);
    if (wr == 0) PG8_BAR;
    PG8_BAR;
    if constexpr (Epi::AFTER_DRAIN) { E.fused(acc, cur, wr, wc, fr, fq, lds, wid, lane); S.done(cur); }
    PG8_STAMP();
    if (STAMP && wid == 0) { stamps[lane] = lane < nts ? (((unsigned long long)(unsigned)ts_hi << 32) | (unsigned)ts_lo) : 0ull;
        if (lane == 62) stamps[62] = rt_entry; if (lane == 63) stamps[63] = (unsigned long long)wall_clock64(); }
#undef PG8_STAMP
#undef PG8_SA
#undef PG8_SB
#undef PG8_STAGE
#undef PG8_LDA
#undef PG8_LDB
#undef PG8_MMA
#undef PG8_WAIT_V
#undef PG8_WAIT_L
#undef PG8_BAR
#undef PG8_SCHED
}
typedef __bf16 hbf2_t __attribute__((ext_vector_type(2)));
typedef float f32x2_t __attribute__((ext_vector_type(2)));
typedef unsigned u32x2 __attribute__((ext_vector_type(2)));
__device__ __forceinline__ unsigned pk2(float lo, float hi) { hbf2_t r = __builtin_convertvector((f32x2_t){lo, hi}, hbf2_t); return __builtin_bit_cast(unsigned, r); }
__device__ __forceinline__ float bflo(unsigned w) { return __uint_as_float(w << 16); }
__device__ __forceinline__ float bfhi(unsigned w) { return __uint_as_float(w & 0xffff0000u); }
__device__ __forceinline__ float sigmoidf_(float x) { return 1.0f / (1.0f + __expf(-x)); }
__device__ __forceinline__ u32x4 pack8(const f32x4& a, const f32x4& b) { u32x4 w; w.x = pk2(a[0], a[1]); w.y = pk2(a[2], a[3]); w.z = pk2(b[0], b[1]); w.w = pk2(b[2], b[3]); return w; }
#define PG8_EPI_ARGS const f32x4 (&acc)[2][2][4][2], const Unit& u, int wr, int wc, int fr, int fq

struct EpiStoreBf16 { static constexpr bool PERM = true, AFTER_DRAIN = false; bf16_t* O; int ldc;
    __device__ __forceinline__ void operator()(PG8_EPI_ARGS) const {
        const int row0 = u.pm * BM + wr * 64 + fr, col0 = u.pn * BM + wc * 32 + 8 * fq;
#pragma unroll
        for (int ai = 0; ai < 2; ++ai)
#pragma unroll
            for (int m = 0; m < 4; ++m) { bf16_t* rowp = O + (size_t)(row0 + ai * HALF + m * 16) * ldc + col0;
#pragma unroll
                for (int bj = 0; bj < 2; ++bj) *(u32x4*)(rowp + bj * HALF) = pack8(acc[ai][bj][m][0], acc[ai][bj][m][1]); }
    }
};
struct EpiProj { static constexpr bool PERM = true, AFTER_DRAIN = false; bf16_t* PJ; float* AB;
    __device__ __forceinline__ void operator()(PG8_EPI_ARGS) const {
        const int row0 = u.pm * BM + wr * 64 + fr;
        if (u.pn < 34) { const int col0 = u.pn * BM + wc * 32 + 8 * fq;
#pragma unroll
            for (int ai = 0; ai < 2; ++ai)
#pragma unroll
                for (int m = 0; m < 4; ++m) { bf16_t* rowp = PJ + (size_t)(row0 + ai * HALF + m * 16) * 8704 + col0;
#pragma unroll
                    for (int bj = 0; bj < 2; ++bj) *(u32x4*)(rowp + bj * HALF) = pack8(acc[ai][bj][m][0], acc[ai][bj][m][1]); }
        } else if (wc == 0) {
#pragma unroll
            for (int ai = 0; ai < 2; ++ai)
#pragma unroll
                for (int m = 0; m < 4; ++m) { float* rp = AB + (size_t)(row0 + ai * HALF + m * 16) * 32 + 8 * fq;
                    *(f32x4*)rp = acc[ai][0][m][0]; *(f32x4*)(rp + 4) = acc[ai][0][m][1]; }
        }
    }
};
struct EpiSigmoid { static constexpr bool PERM = true, AFTER_DRAIN = false; bf16_t* O; int ldc;
    __device__ __forceinline__ void operator()(PG8_EPI_ARGS) const {
        const int row0 = u.pm * BM + wr * 64 + fr, col0 = u.pn * BM + wc * 32 + 8 * fq;
#pragma unroll
        for (int ai = 0; ai < 2; ++ai)
#pragma unroll
            for (int m = 0; m < 4; ++m) { bf16_t* rowp = O + (size_t)(row0 + ai * HALF + m * 16) * ldc + col0;
#pragma unroll
                for (int bj = 0; bj < 2; ++bj) { f32x4 a = acc[ai][bj][m][0], b = acc[ai][bj][m][1];
#pragma unroll
                    for (int j = 0; j < 4; ++j) { a[j] = sigmoidf_(a[j]); b[j] = sigmoidf_(b[j]); }
                    *(u32x4*)(rowp + bj * HALF) = pack8(a, b); } }
    }
};
template <bool FIRST> struct EpiMerge { static constexpr bool PERM = true, AFTER_DRAIN = false; bf16_t* MG; const bf16_t* G; int ldg;
    __device__ __forceinline__ void operator()(PG8_EPI_ARGS) const {
        const int row0 = u.pm * BM + wr * 64 + fr, col0 = u.pn * BM + wc * 32 + 8 * fq;
#pragma unroll
        for (int ai = 0; ai < 2; ++ai)
#pragma unroll
            for (int m = 0; m < 4; ++m) { const size_t r = (size_t)(row0 + ai * HALF + m * 16); bf16_t* mp = MG + r * 2048 + col0; const bf16_t* gp = G + r * ldg + col0;
#pragma unroll
                for (int bj = 0; bj < 2; ++bj) { const u32x4 gw = *(const u32x4*)(gp + bj * HALF); f32x4 a = acc[ai][bj][m][0], b = acc[ai][bj][m][1];
                    a[0] *= bflo(gw.x); a[1] *= bfhi(gw.x); a[2] *= bflo(gw.y); a[3] *= bfhi(gw.y); b[0] *= bflo(gw.z); b[1] *= bfhi(gw.z); b[2] *= bflo(gw.w); b[3] *= bfhi(gw.w);
                    if (!FIRST) { const u32x4 ow = *(const u32x4*)(mp + bj * HALF);
                        a[0] += bflo(ow.x); a[1] += bfhi(ow.x); a[2] += bflo(ow.y); a[3] += bfhi(ow.y); b[0] += bflo(ow.z); b[1] += bfhi(ow.z); b[2] += bflo(ow.w); b[3] += bfhi(ow.w); }
                    *(u32x4*)(mp + bj * HALF) = pack8(a, b); } }
    }
};
template <bool WRITE_XB> struct EpiResid { static constexpr bool PERM = false, AFTER_DRAIN = false; float* X; bf16_t* XB;
    __device__ __forceinline__ void operator()(PG8_EPI_ARGS) const {
        const int row0 = u.pm * BM + wr * 64 + fr, col0 = u.pn * BM + wc * 32 + 4 * fq;
#pragma unroll
        for (int ai = 0; ai < 2; ++ai)
#pragma unroll
            for (int m = 0; m < 4; ++m) { const size_t off = (size_t)(row0 + ai * HALF + m * 16) * 2048 + col0;
#pragma unroll
                for (int bj = 0; bj < 2; ++bj)
#pragma unroll
                    for (int n = 0; n < 2; ++n) { const size_t o = off + bj * HALF + n * 16; const f32x4 v = *(const f32x4*)(X + o) + acc[ai][bj][m][n]; *(f32x4*)(X + o) = v;
                        if (WRITE_XB) { u32x2 w; w.x = pk2(v[0], v[1]); w.y = pk2(v[2], v[3]); *(u32x2*)(XB + o) = w; } } }
    }
};
struct EpiPle { static constexpr bool PERM = false, AFTER_DRAIN = false; float* X; const bf16_t* PL;
    __device__ __forceinline__ void operator()(PG8_EPI_ARGS) const {
        const int row0 = u.pm * BM + wr * 64 + fr, col0 = u.pn * BM + wc * 32 + 4 * fq;
#pragma unroll
        for (int ai = 0; ai < 2; ++ai)
#pragma unroll
            for (int m = 0; m < 4; ++m) { const size_t off = (size_t)(row0 + ai * HALF + m * 16) * 2048 + col0;
#pragma unroll
                for (int bj = 0; bj < 2; ++bj)
#pragma unroll
                    for (int n = 0; n < 2; ++n) { const size_t o = off + bj * HALF + n * 16; const u32x2 pw = *(const u32x2*)(PL + o); const f32x4 a = acc[ai][bj][m][n]; f32x4 v = *(const f32x4*)(X + o);
                        v[0] += sigmoidf_(a[0]) * bflo(pw.x); v[1] += sigmoidf_(a[1]) * bfhi(pw.x); v[2] += sigmoidf_(a[2]) * bflo(pw.y); v[3] += sigmoidf_(a[3]) * bfhi(pw.y);
                        *(f32x4*)(X + o) = v; } }
    }
};
}
namespace att {
typedef unsigned short bf16;
constexpr int D = 128, NW = 8, QBLK = 32, KVBLK = 64;
constexpr float THR = 8.f;
constexpr size_t SHM_V = KVBLK * D * 2, SHM_K = KVBLK * D * 2, SHM_ATTN = 2 * SHM_V + 2 * SHM_K + NW * 64 * 4;
using bf16x8 = __attribute__((ext_vector_type(8))) short;
using s16x4  = __attribute__((ext_vector_type(4))) short;
using f32x16 = __attribute__((ext_vector_type(16))) float;
using u32x4  = __attribute__((ext_vector_type(4))) unsigned;
#define KSWZ(row, colB) ((row) * 256 + ((colB) ^ (((row) & 7) << 4)))
#define SBAR() __builtin_amdgcn_sched_barrier(0)
__device__ __forceinline__ int crow(int r, int hi) { return (r & 3) + 8 * (r >> 2) + 4 * hi; }
__device__ __forceinline__ unsigned cvtpk(float lo, float hi) { return pg8::pk2(lo, hi); }
template <int SC> __device__ __forceinline__ void partialSM(f32x16& p0, f32x16& p1, float& m_reg, float& mn, float& alpha) {
  constexpr float SCALE = SC ? 0.125f : 0.088388347648318440f;
  constexpr float C = SCALE * 1.4426950408889634f;
  float pmax = p0[0];
#pragma unroll
  for (int r = 1; r < 16; ++r) pmax = fmaxf(pmax, p0[r]);
#pragma unroll
  for (int r = 0; r < 16; ++r) pmax = fmaxf(pmax, p1[r]);
  { auto rr = __builtin_amdgcn_permlane32_swap(__float_as_uint(pmax), __float_as_uint(pmax), false, false);
    pmax = fmaxf(__uint_as_float(rr[0]), __uint_as_float(rr[1])); }
  if (__builtin_expect(__all(pmax - m_reg <= THR / SCALE), 1)) { mn = m_reg; alpha = 1.f; }
  else { mn = fmaxf(m_reg, pmax); alpha = __builtin_amdgcn_exp2f((m_reg - mn) * C); m_reg = mn; }
  float mnC = -mn * C;
#pragma unroll
  for (int r = 0; r < 16; ++r) p0[r] = fmaf(p0[r], C, mnC);
#pragma unroll
  for (int r = 0; r < 16; ++r) p1[r] = fmaf(p1[r], C, mnC);
#pragma unroll
  for (int r = 0; r < 16; ++r) p0[r] = __builtin_amdgcn_exp2f(p0[r]);
}
__device__ __forceinline__ void finishSM(f32x16& p0, f32x16& p1, float alpha, float& l_reg, bf16x8& pa0, bf16x8& pa1, bf16x8& pa2, bf16x8& pa3) {
#pragma unroll
  for (int r = 0; r < 16; ++r) p1[r] = __builtin_amdgcn_exp2f(p1[r]);
  float ps = 0;
#pragma unroll
  for (int r = 0; r < 16; ++r) ps += p0[r];
#pragma unroll
  for (int r = 0; r < 16; ++r) ps += p1[r];
  { auto rr = __builtin_amdgcn_permlane32_swap(__float_as_uint(ps), __float_as_uint(ps), false, false);
    ps = __uint_as_float(rr[0]) + __uint_as_float(rr[1]); }
  l_reg = l_reg * alpha + ps;
#define PK4(P, BASE, OUT) do { unsigned a0 = cvtpk(P[BASE + 0], P[BASE + 1]), a1 = cvtpk(P[BASE + 2], P[BASE + 3]);   \
    unsigned b0 = cvtpk(P[BASE + 4], P[BASE + 5]), b1 = cvtpk(P[BASE + 6], P[BASE + 7]);                              \
    auto r0 = __builtin_amdgcn_permlane32_swap(a0, b0, false, false); auto r1 = __builtin_amdgcn_permlane32_swap(a1, b1, false, false); \
    u32x4 w = {r0[0], r1[0], r0[1], r1[1]}; OUT = *reinterpret_cast<bf16x8*>(&w); } while (0)
  PK4(p0, 0, pa0); PK4(p0, 8, pa1); PK4(p1, 0, pa2); PK4(p1, 8, pa3);
#undef PK4
}
template <int ND0> __device__ __forceinline__ void qkt(f32x16& p0, f32x16& p1, const bf16* Ks, const bf16x8* qr, int r32, int hi, int d0b) {
  p0 = f32x16{}; p1 = f32x16{};
#pragma unroll
  for (int d0 = 0; d0 < ND0; ++d0) { int cb = ((d0b + d0) * 16 + hi * 8) * 2;
    bf16x8 b0 = *reinterpret_cast<const bf16x8*>((const char*)Ks + KSWZ(r32, cb));
    bf16x8 b1 = *reinterpret_cast<const bf16x8*>((const char*)Ks + KSWZ(32 + r32, cb));
    p0 = __builtin_amdgcn_mfma_f32_32x32x16_bf16(b0, qr[d0], p0, 0, 0, 0);
    p1 = __builtin_amdgcn_mfma_f32_32x32x16_bf16(b1, qr[d0], p1, 0, 0, 0); }
}
__device__ __forceinline__ int v_st(int k, int c) { const int kk = (k & ~0xC) | ((k & 4) << 1) | ((k & 8) >> 1); return ((kk >> 3) * 4 + (c >> 5)) * 512 + ((kk & 7) * 32 + (c & 31)) * 2; }
__device__ __forceinline__ int v_rd_base(int lane) { return ((lane & 3) << 3) | (((lane >> 2) & 3) << 6) | (((lane >> 4) & 1) << 5) | (((lane >> 5) & 1) << 8); }
constexpr int v_rd_off(int d0, int ks, int half) { return d0 * 512 + ks * 4096 + half * 2048; }
template <int OFF> __device__ __forceinline__ s16x4 tr_read(int vb) {
  s16x4 r; asm volatile("ds_read_b64_tr_b16 %0, %1 offset:%2" : "=&v"(r) : "v"(vb), "i"(OFF) : "memory"); return r;
}
template <int D0> __device__ __forceinline__ void pv_one(f32x16& od, int vb, bf16x8 pa0, bf16x8 pa1, bf16x8 pa2, bf16x8 pa3) {
  const s16x4 l0 = tr_read<v_rd_off(D0, 0, 0)>(vb), h0 = tr_read<v_rd_off(D0, 0, 1)>(vb), l1 = tr_read<v_rd_off(D0, 1, 0)>(vb), h1 = tr_read<v_rd_off(D0, 1, 1)>(vb);
  const s16x4 l2 = tr_read<v_rd_off(D0, 2, 0)>(vb), h2 = tr_read<v_rd_off(D0, 2, 1)>(vb), l3 = tr_read<v_rd_off(D0, 3, 0)>(vb), h3 = tr_read<v_rd_off(D0, 3, 1)>(vb);
  asm volatile("s_waitcnt lgkmcnt(0)" ::: "memory"); SBAR();
#define PK(L, H) (bf16x8){L[0], L[1], L[2], L[3], H[0], H[1], H[2], H[3]}
  od = __builtin_amdgcn_mfma_f32_32x32x16_bf16(pa0, PK(l0, h0), od, 0, 0, 0);
  od = __builtin_amdgcn_mfma_f32_32x32x16_bf16(pa1, PK(l1, h1), od, 0, 0, 0);
  od = __builtin_amdgcn_mfma_f32_32x32x16_bf16(pa2, PK(l2, h2), od, 0, 0, 0);
  od = __builtin_amdgcn_mfma_f32_32x32x16_bf16(pa3, PK(l3, h3), od, 0, 0, 0);
#undef PK
}
__device__ __forceinline__ void pv_d0(f32x16* o, int vb, bf16x8 pa0, bf16x8 pa1, bf16x8 pa2, bf16x8 pa3) {
  pv_one<0>(o[0], vb, pa0, pa1, pa2, pa3); pv_one<1>(o[1], vb, pa0, pa1, pa2, pa3); pv_one<2>(o[2], vb, pa0, pa1, pa2, pa3); pv_one<3>(o[3], vb, pa0, pa1, pa2, pa3);
}
template <int LDQ, int LDK, int LDO, int ND0, int SC>
__device__ __forceinline__ void attn_dense_body(const bf16* Qb, const bf16* Kh, const bf16* Vh, bf16* Ob, int seq, int d0b, char* lds) {
  int tid_ = threadIdx.x; asm volatile("" : "+v"(tid_));
  const int tid = tid_, wid = tid >> 6, lane = tid & 63, r32 = lane & 31, hi = lane >> 5;
  bf16* V_lds = (bf16*)lds; bf16* K_lds = (bf16*)(lds + 2 * SHM_V);
  float* ws = (float*)(lds + 2 * SHM_V + 2 * SHM_K) + wid * 64; float* li_l = ws; float* al_l = ws + 32;
  float m_reg = -1e30f, l_reg = 0; f32x16 o[4] = {}; bf16x8 qr[ND0];
  const bf16* Qw = Qb + (long)(wid * QBLK + r32) * LDQ + hi * 8 + d0b * 16;
#pragma unroll
  for (int d0 = 0; d0 < ND0; ++d0) qr[d0] = *reinterpret_cast<const bf16x8*>(Qw + d0 * 16);
  const int sr = tid >> 4, sc = (tid & 15) * 8, vst0 = v_st(sr, sc), vst1 = v_st(32 + sr, sc);
  const int vb0 = (int)(uintptr_t)V_lds + v_rd_base(lane);
  struct { bf16x8 vs0, vs1, ks0, ks1; } sr_[2];
#define SLOAD(i, k0) do { sr_[i].vs0 = *reinterpret_cast<const bf16x8*>(&Vh[(long)((k0) + sr) * LDK + sc]); sr_[i].vs1 = *reinterpret_cast<const bf16x8*>(&Vh[(long)((k0) + 32 + sr) * LDK + sc]); \
    sr_[i].ks0 = *reinterpret_cast<const bf16x8*>(&Kh[(long)((k0) + sr) * LDK + sc]); sr_[i].ks1 = *reinterpret_cast<const bf16x8*>(&Kh[(long)((k0) + 32 + sr) * LDK + sc]); } while (0)
#define SWRITE(b, i) do { *(bf16x8*)((char*)V_lds + (b) * SHM_V + vst0) = sr_[i].vs0;          \
    *(bf16x8*)((char*)V_lds + (b) * SHM_V + vst1) = sr_[i].vs1; int kc = sc * 2;               \
    *(bf16x8*)((char*)K_lds + (b) * SHM_K + KSWZ(sr, kc)) = sr_[i].ks0;                       \
    *(bf16x8*)((char*)K_lds + (b) * SHM_K + KSWZ(32 + sr, kc)) = sr_[i].ks1; } while (0)
#define SWAIT() asm volatile("s_waitcnt vmcnt(4)" ::: "memory")
#define RESC(a) do { if (__any((a) < 1.f)) { if (hi == 0) al_l[r32] = (a); asm volatile("s_waitcnt lgkmcnt(0)" ::: "memory"); \
    _Pragma("unroll") for (int d = 0; d < 4; ++d) _Pragma("unroll") for (int r = 0; r < 16; ++r) o[d][r] *= al_l[crow(r, hi)]; } } while (0)
  f32x16 pA0, pA1, pB0, pB1; float mnA, mnB, alA, alB; bf16x8 pa0, pa1, pa2, pa3; const int NT = seq / KVBLK;
  constexpr int SE = 0, SO = 1;
  SLOAD(SE, 0); asm volatile("s_waitcnt vmcnt(0)" ::: "memory"); SWRITE(0, SE); __syncthreads();
  qkt<ND0>(pA0, pA1, K_lds, qr, r32, hi, d0b); partialSM<SC>(pA0, pA1, m_reg, mnA, alA);
  SLOAD(SO, KVBLK); if (2 < NT) SLOAD(SE, 2 * KVBLK);
  SWAIT(); SWRITE(1, SO); __syncthreads();
  for (int j = 1; j + 1 < NT; j += 2) {
    SBAR(); qkt<ND0>(pB0, pB1, (bf16*)((char*)K_lds + SHM_K), qr, r32, hi, d0b);
    finishSM(pA0, pA1, alA, l_reg, pa0, pa1, pa2, pa3); SBAR();
    SLOAD(SO, (j + 2) * KVBLK); SBAR();
    pv_d0(o, vb0, pa0, pa1, pa2, pa3); partialSM<SC>(pB0, pB1, m_reg, mnB, alB);
    __syncthreads(); SWAIT(); SWRITE(0, SE);
    RESC(alB); __syncthreads();
    SBAR(); qkt<ND0>(pA0, pA1, K_lds, qr, r32, hi, d0b);
    finishSM(pB0, pB1, alB, l_reg, pa0, pa1, pa2, pa3); SBAR();
    if (j + 3 < NT) SLOAD(SE, (j + 3) * KVBLK); SBAR();
    pv_d0(o, vb0 + (int)SHM_V, pa0, pa1, pa2, pa3); partialSM<SC>(pA0, pA1, m_reg, mnA, alA);
    __syncthreads(); SWAIT(); SWRITE(1, SO);
    RESC(alA); __syncthreads();
  }
  SBAR(); qkt<ND0>(pB0, pB1, (bf16*)((char*)K_lds + SHM_K), qr, r32, hi, d0b);
  finishSM(pA0, pA1, alA, l_reg, pa0, pa1, pa2, pa3); SBAR();
  pv_d0(o, vb0, pa0, pa1, pa2, pa3); partialSM<SC>(pB0, pB1, m_reg, mnB, alB);
  __syncthreads(); RESC(alB);
  finishSM(pB0, pB1, alB, l_reg, pa0, pa1, pa2, pa3); SBAR();
  pv_d0(o, vb0 + (int)SHM_V, pa0, pa1, pa2, pa3);
  if (hi == 0) li_l[r32] = l_reg; asm volatile("s_waitcnt lgkmcnt(0)" ::: "memory");
  float rli[16];
#pragma unroll
  for (int r = 0; r < 16; ++r) rli[r] = __builtin_amdgcn_rcpf(li_l[crow(r, hi)]);
  bf16* Ow = Ob + (long)(wid * QBLK) * LDO;
#pragma unroll
  for (int r = 0; r < 16; ++r) { int orow = crow(r, hi);
#pragma unroll
    for (int d0 = 0; d0 < 4; ++d0) Ow[(long)orow * LDO + d0 * 32 + r32] = (bf16)(cvtpk(o[d0][r] * rli[r], 0.f) & 0xffffu); }
  __syncthreads();
#undef SLOAD
#undef SWRITE
#undef SWAIT
#undef RESC
}
#undef KSWZ
#undef SBAR
}
#define XB_TMO      128
#define XB_XCNT(j)  (256  + 64 * (j))
#define XB_XSUB(j)  (1280 + 64 * (j))
#define XB_XGEN(j)  (2304 + 64 * (j))
#define XB_TOP      3328
#define XB_TOPGEN   3392
#define XCD_BAR_WORDS 3456
#define XB_SPIN_CAP (1u << 22)
#define LAS __attribute__((address_space(3)))

__device__ __forceinline__ unsigned xb_ld(unsigned* p)              { return __hip_atomic_load(p, __ATOMIC_RELAXED, __HIP_MEMORY_SCOPE_AGENT); }
__device__ __forceinline__ unsigned xb_add(unsigned* p, unsigned v) { return __hip_atomic_fetch_add(p, v, __ATOMIC_RELAXED, __HIP_MEMORY_SCOPE_AGENT); }
__device__ __forceinline__ unsigned xb_xcc_id() { return (unsigned)__builtin_amdgcn_s_getreg((3 << 11) | 20) & 0xFu; }
#define XB_SPIN(cond, bar) do { unsigned _sp = 0; while (cond) { __builtin_amdgcn_s_sleep(1); \
    if ((++_sp & 255u) == 0u) { if (xb_ld(&(bar)[XB_TMO])) break; if (_sp > XB_SPIN_CAP) { atomicAdd(&(bar)[XB_TMO], 1u); break; } } } } while (0)

struct XcdBarrier {
    unsigned* bar; unsigned x;
    volatile LAS unsigned* st;
};

__device__ __forceinline__ XcdBarrier xcd_barrier_post(unsigned* bar, volatile LAS unsigned* st) {
    XcdBarrier b; b.bar = bar; b.x = xb_xcc_id(); b.st = st;
    if (threadIdx.x == 0) (void)xb_add(&bar[XB_XCNT(b.x)], 1u);
    return b;
}
__device__ __forceinline__ void xcd_barrier_complete(unsigned* bar, unsigned x, unsigned& nloc, unsigned& nx) {
    const unsigned G = gridDim.x * gridDim.y * gridDim.z;
    unsigned sum, cnt, mine, sp = 0u;
    for (;;) {
        sum = 0u; cnt = 0u; mine = 0u;
#pragma unroll
        for (unsigned j = 0; j < 16; ++j) { const unsigned c = xb_ld(&bar[XB_XCNT(j)]); sum += c; cnt += (c > 0u) ? 1u : 0u; mine = (j == x) ? c : mine; }
        if (sum == G) break;
        __builtin_amdgcn_s_sleep(1);
        if ((++sp & 255u) == 0u) { if (xb_ld(&bar[XB_TMO])) break; if (sp > XB_SPIN_CAP) { atomicAdd(&bar[XB_TMO], 1u); break; } }
    }
    nloc = mine > 0u ? mine : 1u; nx = cnt > 0u ? cnt : 1u;
}

__device__ __forceinline__ void xcd_barrier(const XcdBarrier& b) {
    asm volatile("s_waitcnt vmcnt(0)" ::: "memory");
    __syncthreads();
    if (threadIdx.x == 0) {
        unsigned* bar = b.bar;
        __builtin_amdgcn_s_waitcnt(0);
        unsigned nloc = b.st[0], nx = b.st[1];
        if (nloc == 0u) { xcd_barrier_complete(bar, b.x, nloc, nx); b.st[0] = nloc; b.st[1] = nx; }
        const unsigned old = xb_add(&bar[XB_XSUB(b.x)], 1u);
        const unsigned gen = old / nloc;
        if (old + 1u == (gen + 1u) * nloc) {
            __builtin_amdgcn_fence(__ATOMIC_RELEASE, "agent");
            asm volatile("s_waitcnt vmcnt(0)" ::: "memory");
            const unsigned og = xb_add(&bar[XB_TOP], 1u);
            const unsigned tg = og / nx;
            if (og + 1u == (tg + 1u) * nx) xb_add(&bar[XB_TOPGEN], 1u);
            else XB_SPIN(xb_ld(&bar[XB_TOPGEN]) == tg, bar);
            __builtin_amdgcn_fence(__ATOMIC_ACQUIRE, "agent");
            xb_add(&bar[XB_XGEN(b.x)], 1u);
            asm volatile("s_waitcnt vmcnt(0)" ::: "memory");
        } else {
            XB_SPIN(xb_ld(&bar[XB_XGEN(b.x)]) == gen, bar);
            __builtin_amdgcn_fence(__ATOMIC_ACQUIRE, "agent");
            asm volatile("s_waitcnt vmcnt(0)" ::: "memory");
        }
    }
    __syncthreads();
}
#define DI __device__ __forceinline__
#define GAS __attribute__((address_space(1)))
typedef unsigned short bf16;
typedef float f32x4 __attribute__((ext_vector_type(4)));
typedef float f32x16 __attribute__((ext_vector_type(16)));
typedef short bf16x8 __attribute__((ext_vector_type(8)));
typedef unsigned u32x4 __attribute__((ext_vector_type(4)));
typedef unsigned u32x2 __attribute__((ext_vector_type(2)));
typedef GAS unsigned gu32;
using pg8::pk2; using pg8::bflo; using pg8::bfhi; using pg8::sigmoidf_;
#define MFMA32(a, b, c) __builtin_amdgcn_mfma_f32_32x32x16_bf16((a), (b), (c), 0, 0, 0)
#define RLX_AGENT __ATOMIC_RELAXED, __HIP_MEMORY_SCOPE_AGENT

constexpr int NWAVES = 8, NTHREADS = 512;
constexpr int DM = 2048, JR = 16384, NJOB = 3, NLAYER = 2, MALL = 49152;
constexpr int N_IN = 14880, NP1 = 8960, LDPJ = 8704, NGT = 6144, DFF = 5632, NUP = 11264, PLE = 256, NWIN = 15104;
constexpr int PJ_AQ = 0, PJ_AZ = 3072, PJ_BQ = 4096, PJ_BK = 5120, PJ_BV = 5376, PJ_CQ = 5632, PJ_CK = 6656, PJ_CV = 7680;
constexpr float EPS = 1e-6f;
constexpr int G1_UNIT_BYTES = 73728, G1_W = 0, G1_QD = 16384, G1_IN = 32768, G1_KD = 40960, G1_U = 57344, G1_STAGE = 57344;
constexpr size_t MiB = (size_t)1 << 20;
constexpr size_t WS_CTL = 0, CTL_ZERO_BYTES = 1 * MiB;
constexpr size_t WS_WIN = 1 * MiB, WS_WOA = 60 * MiB, WS_WOB = 64 * MiB, WS_WOC = 68 * MiB, WS_WOUT = 72 * MiB, WS_WUP = 80 * MiB, WS_WDOWN = 124 * MiB, WS_WPLE = 146 * MiB, WS_WPG = 147 * MiB;
constexpr size_t WS_HB = 156 * MiB, WS_AB = 220 * MiB, WS_PB = 222 * MiB, WS_GL = 230 * MiB, WS_OAF = 232 * MiB, WS_OAB = 264 * MiB, WS_OB = 296 * MiB, WS_OC2 = 328 * MiB, WS_OCP = 392 * MiB;
constexpr size_t WS_PJ = 424 * MiB, WS_G1 = 696 * MiB, WS_END = 984 * MiB;
constexpr size_t WS_GT = WS_G1, WS_MG = WS_PJ, WS_U = WS_PJ, WS_ACT = WS_PJ + 352 * MiB, WS_PL = WS_PJ;
static_assert(WS_WIN + (size_t)NWIN * DM * 2 <= WS_WOA && WS_WPG + 8 * MiB <= WS_HB && WS_G1 + (size_t)4096 * G1_UNIT_BYTES <= WS_END && WS_ACT + (size_t)JR * DFF * 2 <= WS_END && WS_PJ + (size_t)JR * LDPJ * 2 <= WS_G1, "ws map");
constexpr int CW_BAR = 4096, CW_Q = 16384;
constexpr int RING_BYTES = 131072, LDSCTL_OFF = RING_BYTES, MISC_OFF = LDSCTL_OFF + 320, LDS_BYTES = 147456;

DI float bf2f(bf16 b) { return __uint_as_float(((unsigned)b) << 16); }
DI bf16 f2bf(float f) { return (bf16)(pk2(f, 0.f) & 0xffffu); }
DI float wave_sum(float v) {
#pragma unroll
    for (int o = 1; o < 64; o <<= 1) v += __shfl_xor(v, o);
    return v;
}
DI float silu_(float y) { return y / (1.0f + __expf(-y)); }
DI float softplus_(float x) { return fmaxf(x, 0.f) + __logf(1.0f + __expf(-fabsf(x))); }
DI void sincos_(float ang, float& s, float& c) { const float n = rintf(ang * 0.15915494309189535f); float r = fmaf(-n, 6.2831854820251465f, ang); r = fmaf(-n, -1.7484556e-7f, r); s = __sinf(r); c = __cosf(r); }
DI int crow(int reg, int hh) { return (reg & 3) + 8 * (reg >> 2) + 4 * hh; }
template <int S> DI bf16x8 pack_step(const f32x16& x) {
    u32x4 p; p.x = pk2(x[8 * S + 0], x[8 * S + 1]); p.y = pk2(x[8 * S + 2], x[8 * S + 3]); p.z = pk2(x[8 * S + 4], x[8 * S + 5]); p.w = pk2(x[8 * S + 6], x[8 * S + 7]);
    return __builtin_bit_cast(bf16x8, p);
}

struct Args { const float* in[27]; float* out; unsigned char* ws; int l0, l1, j0, j1, ph_lo, ph_hi, one_launch, dbg; };
typedef const __attribute__((address_space(4))) Args CArgs;
struct Frame {
    LAS unsigned char* lds; volatile LAS unsigned* MISC; gu32* ctl;
    int tid, lane, wave, G, bid;
    unsigned char* ws;
};
struct JobGeo { int row0, nseq, seqlen; };
DI JobGeo job_geo(int job) { JobGeo g; g.row0 = job * JR; g.nseq = job == 0 ? 1 : 2; g.seqlen = job == 0 ? 16384 : 8192; return g; }
DI int win_dst(int sc) {
    if (sc < 4096) return sc;
    if (sc < 4128) return 8704 + (sc - 4096);
    if (sc < 8736) return 4096 + (sc - 4128);
    return 8960 + (sc - 8736);
}
DI void transpose_item(const float* W, int K, int N, bf16* WT, int remap, LAS float* scr, int item, int lane) {
    const int nblk = N / 32, kb = item / nblk, nb = item % nblk, k0 = 64 * kb, n0 = 32 * nb;
#pragma unroll 8
    for (int i = 0; i < 32; ++i) { const int kk = 2 * i + (lane >> 5); scr[kk * 33 + (lane & 31)] = W[(size_t)(k0 + kk) * N + n0 + (lane & 31)]; }
    asm volatile("s_waitcnt lgkmcnt(0)" ::: "memory");
    const int c = lane & 7; const int d0 = remap ? win_dst(n0) : n0;
#pragma unroll
    for (int j = 0; j < 4; ++j) { const int n = (lane >> 3) + 8 * j; const LAS float* s = scr + (8 * c) * 33 + n;
        u32x4 o; o.x = pk2(s[0 * 33], s[1 * 33]); o.y = pk2(s[2 * 33], s[3 * 33]); o.z = pk2(s[4 * 33], s[5 * 33]); o.w = pk2(s[6 * 33], s[7 * 33]);
        *(u32x4*)(WT + (size_t)(d0 + n) * K + k0 + 8 * c) = o; }
    asm volatile("s_waitcnt lgkmcnt(0)" ::: "memory");
}
DI void phase_weights(Frame& F, CArgs* a, int layer) {
    LAS float* scr = (LAS float*)(F.lds + F.wave * 16384);
    const int gw = F.bid * NWAVES + F.wave, NGW = F.G * NWAVES;
    unsigned char* ws = F.ws;
    const float* w_in = a->in[5] + (size_t)layer * DM * N_IN;
    const float* w_oa = a->in[16] + (size_t)layer * 1024 * DM; const float* w_ob = a->in[17] + (size_t)layer * 1024 * DM; const float* w_oc = a->in[18] + (size_t)layer * 1024 * DM;
    const float* w_out = a->in[19] + (size_t)layer * DM * DM; const float* w_up = a->in[21] + (size_t)layer * DM * NUP; const float* w_down = a->in[24] + (size_t)layer * DFF * DM;
    const float* w_ple = a->in[25] + (size_t)layer * PLE * DM; const float* w_pg = a->in[26] + (size_t)layer * DM * DM;
    constexpr int I_IN = (DM / 64) * (N_IN / 32), I_O = (1024 / 64) * (DM / 32), I_OUT = (DM / 64) * (DM / 32), I_UP = (DM / 64) * (NUP / 32), I_DN = (DFF / 64) * (DM / 32), I_PLE = (PLE / 64) * (DM / 32);
    constexpr int NITEMS = I_IN + 3 * I_O + I_OUT + I_UP + I_DN + I_PLE + I_OUT;
    for (int it = gw; it < NITEMS; it += NGW) {
        int r = it;
        if (r < I_IN) { transpose_item(w_in, DM, N_IN, (bf16*)(ws + WS_WIN), 1, scr, r, F.lane); continue; } r -= I_IN;
        if (r < I_O) { transpose_item(w_oa, 1024, DM, (bf16*)(ws + WS_WOA), 0, scr, r, F.lane); continue; } r -= I_O;
        if (r < I_O) { transpose_item(w_ob, 1024, DM, (bf16*)(ws + WS_WOB), 0, scr, r, F.lane); continue; } r -= I_O;
        if (r < I_O) { transpose_item(w_oc, 1024, DM, (bf16*)(ws + WS_WOC), 0, scr, r, F.lane); continue; } r -= I_O;
        if (r < I_OUT) { transpose_item(w_out, DM, DM, (bf16*)(ws + WS_WOUT), 0, scr, r, F.lane); continue; } r -= I_OUT;
        if (r < I_UP) { transpose_item(w_up, DM, NUP, (bf16*)(ws + WS_WUP), 0, scr, r, F.lane); continue; } r -= I_UP;
        if (r < I_DN) { transpose_item(w_down, DFF, DM, (bf16*)(ws + WS_WDOWN), 0, scr, r, F.lane); continue; } r -= I_DN;
        if (r < I_PLE) { transpose_item(w_ple, PLE, DM, (bf16*)(ws + WS_WPLE), 0, scr, r, F.lane); continue; } r -= I_PLE;
        transpose_item(w_pg, DM, DM, (bf16*)(ws + WS_WPG), 0, scr, r, F.lane);
    }
    u32x4* z = (u32x4*)((bf16*)(ws + WS_WIN) + (size_t)8736 * DM);
    unsigned zz = 0u; asm volatile("" : "+v"(zz));
    for (int i = F.bid * NTHREADS + F.tid; i < 224 * DM / 8; i += F.G * NTHREADS) z[i] = (u32x4){zz, zz, zz, zz};
}
DI void rms_row_2048(const float* xrow, const float* g, bf16* orow, int lane) {
    const f32x4* xr = (const f32x4*)xrow + lane; f32x4 v[8]; float s = 0.f;
#pragma unroll
    for (int j = 0; j < 8; ++j) { v[j] = xr[64 * j]; s += (v[j].x * v[j].x + v[j].y * v[j].y) + (v[j].z * v[j].z + v[j].w * v[j].w); }
    const float r = rsqrtf(wave_sum(s) * (1.f / DM) + EPS);
    const f32x4* gr = (const f32x4*)g + lane; u32x2* o8 = (u32x2*)orow + lane;
#pragma unroll
    for (int j = 0; j < 8; ++j) { const f32x4 gg = gr[64 * j]; u32x2 w; w.x = pk2(v[j].x * r * gg.x, v[j].y * r * gg.y); w.y = pk2(v[j].z * r * gg.z, v[j].w * r * gg.w); o8[64 * j] = w; }
}
DI void phase_rms(Frame& F, const float* X, const float* g, bf16* HB) {
    const int gw = F.bid * NWAVES + F.wave, NGW = F.G * NWAVES;
    for (int m = gw; m < JR; m += NGW) rms_row_2048(X + (size_t)m * DM, g, HB + (size_t)m * DM, F.lane);
}
DI void prepB_head(bf16* p, const float* gain, int pos, int lane) {
    float a = bf2f(p[lane]), b = bf2f(p[64 + lane]);
    const float r = rsqrtf(wave_sum(a * a + b * b) * (1.f / 128.f) + EPS);
    a = a * r * gain[lane]; b = b * r * gain[64 + lane];
    const int i = lane & 31; const float inv = exp2f(-(float)(2 * i) * (13.287712379549449f / 64.f));
    const float ar = (float)(pos >> 6) * inv, ac = (float)(pos & 63) * inv;
    float sr, cr, sc, cc; sincos_(ar, sr, cr); sincos_(ac, sc, cc);
    const float pa = __shfl_xor(a, 32), pb = __shfl_xor(b, 32);
    const float oa = lane < 32 ? a * cr - pa * sr : a * cr + pa * sr;
    const float ob = lane < 32 ? b * cc - pb * sc : b * cc + pb * sc;
    p[lane] = f2bf(oa); p[64 + lane] = f2bf(ob);
}
DI void prepC_head(bf16* p, const float* gain, int pos, int lane) {
    float a = bf2f(p[lane]), b = bf2f(p[64 + lane]);
    const float ra = rsqrtf(wave_sum(a * a) * (1.f / 64.f) + EPS), rb = rsqrtf(wave_sum(b * b) * (1.f / 64.f) + EPS);
    const float g = gain[lane]; a = a * ra * g; b = b * rb * g;
    const int i = lane & 7; const float inv = exp2f(-(float)(2 * i) * (18.931568569324174f / 16.f));
    const float ang = (float)pos * inv; float s, c; sincos_(ang, s, c);
    const float pa = __shfl_xor(a, 8), pb = __shfl_xor(b, 8);
    if (lane < 16) { a = lane < 8 ? a * c - pa * s : a * c + pa * s; b = lane < 8 ? b * c - pb * s : b * c + pb * s; }
    p[lane] = f2bf(a); p[64 + lane] = f2bf(b);
}
DI void phase_prep(Frame& F, CArgs* a, int layer, bf16* PJ, const JobGeo& jg) {
    const int gw = F.bid * NWAVES + F.wave, NGW = F.G * NWAVES;
    const float* qn_b = a->in[10] + layer * 128; const float* kn_b = a->in[11] + layer * 128; const float* qn_c = a->in[12] + layer * 64; const float* kn_c = a->in[13] + layer * 64;
    for (int m = gw; m < JR; m += NGW) {
        const int pos = m % jg.seqlen; bf16* row = PJ + (size_t)m * LDPJ;
#pragma unroll 1
        for (int hq = 0; hq < 8; ++hq) prepB_head(row + PJ_BQ + hq * 128, qn_b, pos, F.lane);
#pragma unroll 1
        for (int hk = 0; hk < 2; ++hk) prepB_head(row + PJ_BK + hk * 128, kn_b, pos, F.lane);
#pragma unroll 1
        for (int h = 0; h < 8; ++h) { prepC_head(row + PJ_CQ + h * 128, qn_c, pos, F.lane); prepC_head(row + PJ_CK + h * 128, kn_c, pos, F.lane); }
    }
}
DI void phase_gdn_post(Frame& F, CArgs* a, int layer, bf16* OAF, const bf16* OAB, const bf16* PJ) {
    const int gw = F.bid * NWAVES + F.wave, NGW = F.G * NWAVES; const float* nw = a->in[9] + layer * 128;
    const float g0 = nw[2 * F.lane], g1 = nw[2 * F.lane + 1];
    for (int it = gw; it < JR * 8; it += NGW) { const int m = it >> 3, h = it & 7;
        unsigned* pf = (unsigned*)(OAF + (size_t)m * 1024 + h * 128) + F.lane; const unsigned* pb = (const unsigned*)(OAB + (size_t)m * 1024 + h * 128) + F.lane;
        const unsigned wf = *pf, wb = *pb, wz = *((const unsigned*)(PJ + (size_t)m * LDPJ + PJ_AZ + h * 128) + F.lane);
        const float x0 = bflo(wf) + bflo(wb), x1 = bfhi(wf) + bfhi(wb);
        const float r = rsqrtf(wave_sum(x0 * x0 + x1 * x1) * (1.f / 128.f) + EPS);
        *pf = pk2(x0 * r * g0 * silu_(bflo(wz)), x1 * r * g1 * silu_(bfhi(wz))); }
}
DI void phase_diff_combine(Frame& F, CArgs* a, int layer, const bf16* OC2, bf16* OCP) {
    const int gw = F.bid * NWAVES + F.wave, NGW = F.G * NWAVES;
    const float* lm = a->in[14] + layer * 256; const float* sub = a->in[15] + layer * 128;
    const float l01 = wave_sum(lm[F.lane] * lm[64 + F.lane]), l23 = wave_sum(lm[128 + F.lane] * lm[192 + F.lane]);
    const float linit = 0.8f - 0.6f * __expf(-0.3f * (float)layer), lam = __expf(l01) - __expf(l23) + linit, post = 1.f - linit;
    const float s0 = sub[2 * F.lane] * post, s1 = sub[2 * F.lane + 1] * post;
    for (int it = gw; it < JR * 8; it += NGW) { const int m = it >> 3, h = it & 7;
        const unsigned w0 = *((const unsigned*)(OC2 + (size_t)m * 2048 + (h * 2) * 128) + F.lane), w1 = *((const unsigned*)(OC2 + (size_t)m * 2048 + (h * 2 + 1) * 128) + F.lane);
        const float x0 = bflo(w0) - lam * bflo(w1), x1 = bfhi(w0) - lam * bfhi(w1);
        const float r = rsqrtf(wave_sum(x0 * x0 + x1 * x1) * (1.f / 128.f) + EPS);
        *((unsigned*)(OCP + (size_t)m * 1024 + h * 128) + F.lane) = pk2(x0 * r * s0, x1 * r * s1); }
}
DI void phase_conv_act(Frame& F, CArgs* a, int layer, const bf16* U, bf16* ACT, const JobGeo& jg) {
    const float* cw = a->in[22] + (size_t)layer * 3 * NUP; const float* cb = a->in[23] + (size_t)layer * NUP;
    constexpr int CPR = DFF / 8;
    for (int it = F.bid * NTHREADS + F.tid; it < JR * CPR; it += F.G * NTHREADS) {
        const int m = it / CPR, c = (it % CPR) * 8, pos = m % jg.seqlen; const bool okm = pos > 0, okp = pos < jg.seqlen - 1;
        float outv[8];
#pragma unroll
        for (int half = 0; half < 2; ++half) { const int col = half * DFF + c; const bf16* p = U + (size_t)m * NUP + col;
            u32x4 x0 = *(const u32x4*)p, xm = *(const u32x4*)(p - (okm ? NUP : 0)), xp = *(const u32x4*)(p + (okp ? NUP : 0));
            if (!okm) xm = xm ^ xm; if (!okp) xp = xp ^ xp;
            const f32x4 w0a = *(const f32x4*)(cw + col), w0b = *(const f32x4*)(cw + col + 4), w1a = *(const f32x4*)(cw + NUP + col), w1b = *(const f32x4*)(cw + NUP + col + 4);
            const f32x4 w2a = *(const f32x4*)(cw + 2 * NUP + col), w2b = *(const f32x4*)(cw + 2 * NUP + col + 4), ba = *(const f32x4*)(cb + col), bb = *(const f32x4*)(cb + col + 4);
            float y[8];
#pragma unroll
            for (int k = 0; k < 4; ++k) { const unsigned wm = xm[k], w0 = x0[k], wp = xp[k];
                const float wl0 = k < 2 ? w0a[2 * k] : w0b[2 * k - 4], wh0 = k < 2 ? w0a[2 * k + 1] : w0b[2 * k - 3];
                const float wl1 = k < 2 ? w1a[2 * k] : w1b[2 * k - 4], wh1 = k < 2 ? w1a[2 * k + 1] : w1b[2 * k - 3];
                const float wl2 = k < 2 ? w2a[2 * k] : w2b[2 * k - 4], wh2 = k < 2 ? w2a[2 * k + 1] : w2b[2 * k - 3];
                const float bl = k < 2 ? ba[2 * k] : bb[2 * k - 4], bh = k < 2 ? ba[2 * k + 1] : bb[2 * k - 3];
                y[2 * k] = wl0 * bflo(wm) + wl1 * bflo(w0) + wl2 * bflo(wp) + bl; y[2 * k + 1] = wh0 * bfhi(wm) + wh1 * bfhi(w0) + wh2 * bfhi(wp) + bh; }
#pragma unroll
            for (int k = 0; k < 8; ++k) outv[k] = half == 0 ? silu_(y[k]) : outv[k] * y[k];
        }
        u32x4 o; o.x = pk2(outv[0], outv[1]); o.y = pk2(outv[2], outv[3]); o.z = pk2(outv[4], outv[5]); o.w = pk2(outv[6], outv[7]);
        *(u32x4*)(ACT + (size_t)m * DFF + c) = o;
    }
}
DI void phase_pconvert(Frame& F, const float* P, bf16* PB) {
    for (int it = F.bid * NTHREADS + F.tid; it < JR * PLE / 8; it += F.G * NTHREADS) { const f32x4 a = *((const f32x4*)P + 2 * it), b = *((const f32x4*)P + 2 * it + 1);
        *((u32x4*)PB + it) = pg8::pack8(a, b); }
}
constexpr int G1_LF = 0, G1_TU = 17408, G1_TW = 26624, G1_TAB = 35840, G1_QN = 36864, G1_KN = 54272, G1_KT = 71680, G1_VT = 90112;
DI bf16x8 ldsfrag(const LAS unsigned char* p) { return *(const LAS bf16x8*)p; }
DI void g1_unit(Frame& F, CArgs* a, int layer, const bf16* PJ, const float* AB, unsigned char* G1B, float* GL, int unit, const JobGeo& jg) {
    const int dir = unit & 1, h = (unit >> 1) & 7, n = unit >> 4;
    const int tid = F.tid, lane = F.lane, wave = F.wave, r = lane & 31, hh = lane >> 5;
    LAS unsigned char* L = F.lds;
    LAS bf16* QN = (LAS bf16*)(L + G1_QN); LAS bf16* KN = (LAS bf16*)(L + G1_KN); LAS bf16* KT = (LAS bf16*)(L + G1_KT); LAS bf16* VT = (LAS bf16*)(L + G1_VT);
    LAS float* LF = (LAS float*)(L + G1_LF); LAS bf16* TU = (LAS bf16*)(L + G1_TU); LAS bf16* TW = (LAS bf16*)(L + G1_TW);
    LAS float* T_GC = (LAS float*)(L + G1_TAB); LAS float* T_BETA = T_GC + 64; LAS float* T_EGC = T_GC + 128; LAS float* T_EKD = T_GC + 192;
    unsigned char* outb = G1B + (size_t)unit * G1_UNIT_BYTES;
    const int s0 = ((n * 64) / jg.seqlen) * jg.seqlen, s1 = s0 + jg.seqlen;
    if (wave == 0) {
        const int t = n * 64 + (dir ? 63 - lane : lane);
        const float al = AB[(size_t)t * 32 + dir * 8 + h], bl = AB[(size_t)t * 32 + 16 + dir * 8 + h];
        const float alog = a->in[7][layer * 16 + dir * 8 + h], dtb = a->in[8][layer * 16 + dir * 8 + h];
        float g = -__expf(alog) * softplus_(al + dtb);
#pragma unroll
        for (int o = 1; o < 64; o <<= 1) { const float v = __shfl_up(g, o); if (lane >= o) g += v; }
        const float gl = __shfl(g, 63);
        T_GC[lane] = g; T_BETA[lane] = sigmoidf_(bl); T_EGC[lane] = __expf(g); T_EKD[lane] = __expf(gl - g);
        if (lane == 0) GL[unit] = __expf(gl);
    }
    {
        const int i = tid >> 3, cc = (tid & 7) * 16; const int t = n * 64 + (dir ? 63 - i : i);
        const bool okm = t > s0, okp = t < s1 - 1;
        const float* cwl = a->in[6] + (size_t)layer * 3 * 3072;
#pragma unroll
        for (int part = 0; part < 3; ++part) {
            float y[16];
            const int col = part * 1024 + h * 128 + cc; const bf16* p = PJ + (size_t)t * LDPJ + col;
            const float* w = cwl + col;
#pragma unroll
            for (int hf = 0; hf < 2; ++hf) {
                u32x4 c0 = *(const u32x4*)(p + 8 * hf), m0 = *(const u32x4*)(p - (okm ? LDPJ : 0) + 8 * hf), n0 = *(const u32x4*)(p + (okp ? LDPJ : 0) + 8 * hf);
                if (!okm) m0 = m0 ^ m0; if (!okp) n0 = n0 ^ n0;
                const f32x4 wa0 = *(const f32x4*)(w + 8 * hf), wa1 = *(const f32x4*)(w + 8 * hf + 4), wb0 = *(const f32x4*)(w + 3072 + 8 * hf), wb1 = *(const f32x4*)(w + 3072 + 8 * hf + 4);
                const f32x4 wc0 = *(const f32x4*)(w + 6144 + 8 * hf), wc1 = *(const f32x4*)(w + 6144 + 8 * hf + 4);
#pragma unroll
                for (int k = 0; k < 4; ++k) { const float wl0 = k < 2 ? wa0[2 * k] : wa1[2 * k - 4], wh0 = k < 2 ? wa0[2 * k + 1] : wa1[2 * k - 3];
                    const float wl1 = k < 2 ? wb0[2 * k] : wb1[2 * k - 4], wh1 = k < 2 ? wb0[2 * k + 1] : wb1[2 * k - 3];
                    const float wl2 = k < 2 ? wc0[2 * k] : wc1[2 * k - 4], wh2 = k < 2 ? wc0[2 * k + 1] : wc1[2 * k - 3];
                    y[8 * hf + 2 * k] = silu_(wl0 * bflo(m0[k]) + wl1 * bflo(c0[k]) + wl2 * bflo(n0[k]));
                    y[8 * hf + 2 * k + 1] = silu_(wh0 * bfhi(m0[k]) + wh1 * bfhi(c0[k]) + wh2 * bfhi(n0[k])); }
            }
            float rs = 1.f;
            if (part < 2) { float sq = 0.f;
#pragma unroll
                for (int e = 0; e < 16; ++e) sq += y[e] * y[e];
                sq += __shfl_xor(sq, 1); sq += __shfl_xor(sq, 2); sq += __shfl_xor(sq, 4);
                rs = rsqrtf(sq + EPS) * (part == 0 ? 0.088388347648318440f : 1.f); }
            if (part < 2) { LAS bf16* dst = part == 0 ? QN : KN; u32x4 q0, q1;
#pragma unroll
                for (int k = 0; k < 4; ++k) { q0[k] = pk2(y[2 * k] * rs, y[2 * k + 1] * rs); q1[k] = pk2(y[8 + 2 * k] * rs, y[8 + 2 * k + 1] * rs); }
                *(LAS u32x4*)(dst + i * 136 + cc) = q0; *(LAS u32x4*)(dst + i * 136 + cc + 8) = q1; }
            if (part >= 1) { LAS bf16* dT = part == 1 ? KT : VT;
#pragma unroll
                for (int e = 0; e < 16; ++e) dT[(cc + e) * 72 + i] = f2bf(y[e] * rs); }
            asm volatile("" ::: "memory");
        }
    }
    __syncthreads();
    if (wave < 4) {
        const int it = wave >> 1, jt = wave & 1; f32x16 acc = {};
        if (!(it == 0 && jt == 1)) {
#pragma unroll
            for (int ks = 0; ks < 8; ++ks) acc = MFMA32(ldsfrag((const LAS unsigned char*)KN + (32 * it + r) * 272 + (16 * ks + 8 * hh) * 2), ldsfrag((const LAS unsigned char*)KN + (32 * jt + r) * 272 + (16 * ks + 8 * hh) * 2), acc);
        }
        const int j = 32 * jt + r; const float gcj = T_GC[j];
#pragma unroll
        for (int reg = 0; reg < 16; ++reg) { const int i = 32 * it + crow(reg, hh); LF[i * 68 + j] = (i > j) ? acc[reg] * T_BETA[i] * __expf(T_GC[i] - gcj) : 0.f; }
    } else {
        const int w4 = wave - 4, ct = w4 >> 1, it = w4 & 1; f32x16 acc = {};
        if (!(it == 0 && ct == 1)) {
#pragma unroll
            for (int ks = 0; ks < 8; ++ks) acc = MFMA32(ldsfrag((const LAS unsigned char*)KN + (32 * ct + r) * 272 + (16 * ks + 8 * hh) * 2), ldsfrag((const LAS unsigned char*)QN + (32 * it + r) * 272 + (16 * ks + 8 * hh) * 2), acc);
        }
        const int i = 32 * it + r; const float gci = T_GC[i];
#pragma unroll
        for (int reg = 0; reg < 16; ++reg) { const int c = 32 * ct + crow(reg, hh); acc[reg] = (i >= c) ? acc[reg] * __expf(gci - T_GC[c]) : 0.f; }
        *(bf16x8*)(outb + G1_IN + ((it * 4 + 2 * ct + 0) * 64 + lane) * 16) = pack_step<0>(acc);
        *(bf16x8*)(outb + G1_IN + ((it * 4 + 2 * ct + 1) * 64 + lane) * 16) = pack_step<1>(acc);
    }
    __syncthreads();
    if (wave == 0) {
        float t[64]; const float lanef = (float)lane;
#pragma unroll
        for (int c = 0; c < 64; ++c) { float a0 = fmaxf(0.f, 1.f - fabsf(lanef - (float)c)), a1 = 0.f;
#pragma unroll
            for (int s4 = 0; s4 < c; s4 += 4) { const f32x4 l = *(const LAS f32x4*)(LF + c * 68 + s4);
                a0 -= l[0] * t[s4]; if (s4 + 1 < c) a1 -= l[1] * t[s4 + 1]; if (s4 + 2 < c) a0 -= l[2] * t[s4 + 2]; if (s4 + 3 < c) a1 -= l[3] * t[s4 + 3]; }
            t[c] = a0 + a1; asm volatile("" ::: "memory"); }
        const float bj = T_BETA[lane], bej = bj * T_EGC[lane];
#pragma unroll
        for (int c = 0; c < 64; ++c) { TU[c * 72 + lane] = f2bf(t[c] * bj); TW[c * 72 + lane] = f2bf(t[c] * bej); }
    } else {
        for (int f = wave - 1; f < 32; f += 7) {
            if (f < 16) { const int mt = f >> 3, ks = f & 7, dt = ks >> 1, s = ks & 1; const int i = 32 * mt + r, d0 = 32 * dt + 16 * s + 4 * hh; const float e = T_EGC[i];
                const u32x2 lo = *(const LAS u32x2*)(QN + i * 136 + d0), hi = *(const LAS u32x2*)(QN + i * 136 + d0 + 8);
                u32x4 o; o.x = pk2(bflo(lo.x) * e, bfhi(lo.x) * e); o.y = pk2(bflo(lo.y) * e, bfhi(lo.y) * e); o.z = pk2(bflo(hi.x) * e, bfhi(hi.x) * e); o.w = pk2(bflo(hi.y) * e, bfhi(hi.y) * e);
                *(u32x4*)(outb + G1_QD + (f * 64 + lane) * 16) = o;
            } else { const int g = f - 16, dt = g >> 2, ks = g & 3, ct = ks >> 1, s = ks & 1; const int d = 32 * dt + r, c0 = 32 * ct + 16 * s + 4 * hh;
                const u32x2 lo = *(const LAS u32x2*)(KT + d * 72 + c0), hi = *(const LAS u32x2*)(KT + d * 72 + c0 + 8);
                const f32x4 e0 = *(const LAS f32x4*)(T_EKD + c0), e1 = *(const LAS f32x4*)(T_EKD + c0 + 8);
                u32x4 o; o.x = pk2(bflo(lo.x) * e0[0], bfhi(lo.x) * e0[1]); o.y = pk2(bflo(lo.y) * e0[2], bfhi(lo.y) * e0[3]); o.z = pk2(bflo(hi.x) * e1[0], bfhi(hi.x) * e1[1]); o.w = pk2(bflo(hi.y) * e1[2], bfhi(hi.y) * e1[3]);
                *(u32x4*)(outb + G1_KD + (g * 64 + lane) * 16) = o; }
        }
    }
    __syncthreads();
    {
        const int dt = wave >> 1, it = wave & 1; f32x16 acc = {};
#pragma unroll
        for (int ks = 0; ks < 4; ++ks) acc = MFMA32(ldsfrag((const LAS unsigned char*)KT + (32 * dt + r) * 144 + (16 * ks + 8 * hh) * 2), ldsfrag((const LAS unsigned char*)TW + (32 * it + r) * 144 + (16 * ks + 8 * hh) * 2), acc);
        *(bf16x8*)(outb + G1_W + ((it * 8 + 2 * dt + 0) * 64 + lane) * 16) = pack_step<0>(acc);
        *(bf16x8*)(outb + G1_W + ((it * 8 + 2 * dt + 1) * 64 + lane) * 16) = pack_step<1>(acc);
        const int et = wave >> 1; f32x16 au = {};
#pragma unroll
        for (int ks = 0; ks < 4; ++ks) au = MFMA32(ldsfrag((const LAS unsigned char*)TU + (32 * it + r) * 144 + (16 * ks + 8 * hh) * 2), ldsfrag((const LAS unsigned char*)VT + (32 * et + r) * 144 + (16 * ks + 8 * hh) * 2), au);
        *(bf16x8*)(outb + G1_U + ((et * 2 + it) * 64 + lane) * 32) = pack_step<0>(au);
        *(bf16x8*)(outb + G1_U + ((et * 2 + it) * 64 + lane) * 32 + 16) = pack_step<1>(au);
    }
    __syncthreads();
}
DI void scan_unit(Frame& F, const unsigned char* G1B, const float* GL, bf16* OAF, bf16* OAB, int sid, const JobGeo& jg) {
    const int seq = sid >> 4, h = (sid >> 1) & 7, dir = sid & 1, N = jg.seqlen >> 6;
    const int tid = F.tid, lane = F.lane, wave = F.wave, r = lane & 31, hh = lane >> 5;
    bf16* OUT = dir ? OAB : OAF;
    f32x16 S0 = {}, S1 = {}, S2 = {}, S3 = {};
    const int lt = tid - 256;
    if (wave >= 4) {
        const int n = seq * N + (dir ? N - 1 : 0); const unsigned char* up = G1B + ((size_t)(n * 8 + h) * 2 + dir) * G1_UNIT_BYTES;
        u32x4 stg[14];
#pragma unroll
        for (int k = 0; k < 14; ++k) stg[k] = *(const u32x4*)(up + lt * 16 + k * 4096);
#pragma unroll
        for (int k = 0; k < 14; ++k) *(LAS u32x4*)(F.lds + lt * 16 + k * 4096) = stg[k];
    }
    __syncthreads();
    for (int st = 0; st < N; ++st) {
        const int n = seq * N + (dir ? N - 1 - st : st); const int unit = (n * 8 + h) * 2 + dir;
        const unsigned char* up = G1B + (size_t)unit * G1_UNIT_BYTES;
        if (wave < 4) {
            const LAS unsigned char* sl = F.lds + (st & 1) * G1_STAGE + lane * 16;
            const unsigned char* uu = up + G1_U + ((wave * 2) * 64 + lane) * 32;
            const u32x4 u0a = *(const u32x4*)uu, u0b = *(const u32x4*)(uu + 16), u1a = *(const u32x4*)(uu + 2048), u1b = *(const u32x4*)(uu + 2048 + 16);
            const float egl = GL[unit];
            f32x16 ws0 = {}, ws1 = {}, o0 = {}, o1 = {};
#define SCAN_STEP1(SX, DT) do { { const bf16x8 fr = pack_step<0>(SX); const int ks = 2 * (DT); \
                ws0 = MFMA32(ldsfrag(sl + G1_W + ks * 1024), fr, ws0); ws1 = MFMA32(ldsfrag(sl + G1_W + (8 + ks) * 1024), fr, ws1); \
                o0 = MFMA32(ldsfrag(sl + G1_QD + ks * 1024), fr, o0); o1 = MFMA32(ldsfrag(sl + G1_QD + (8 + ks) * 1024), fr, o1); } asm volatile("" ::: "memory"); \
              { const bf16x8 fr = pack_step<1>(SX); const int ks = 2 * (DT) + 1; \
                ws0 = MFMA32(ldsfrag(sl + G1_W + ks * 1024), fr, ws0); ws1 = MFMA32(ldsfrag(sl + G1_W + (8 + ks) * 1024), fr, ws1); \
                o0 = MFMA32(ldsfrag(sl + G1_QD + ks * 1024), fr, o0); o1 = MFMA32(ldsfrag(sl + G1_QD + (8 + ks) * 1024), fr, o1); } asm volatile("" ::: "memory"); } while (0)
            SCAN_STEP1(S0, 0); SCAN_STEP1(S1, 1); SCAN_STEP1(S2, 2); SCAN_STEP1(S3, 3);
#undef SCAN_STEP1
            f32x16 vn0, vn1;
#pragma unroll
            for (int k = 0; k < 4; ++k) { vn0[2 * k] = bflo(u0a[k]) - ws0[2 * k]; vn0[2 * k + 1] = bfhi(u0a[k]) - ws0[2 * k + 1]; vn0[8 + 2 * k] = bflo(u0b[k]) - ws0[8 + 2 * k]; vn0[8 + 2 * k + 1] = bfhi(u0b[k]) - ws0[8 + 2 * k + 1];
                vn1[2 * k] = bflo(u1a[k]) - ws1[2 * k]; vn1[2 * k + 1] = bfhi(u1a[k]) - ws1[2 * k + 1]; vn1[8 + 2 * k] = bflo(u1b[k]) - ws1[8 + 2 * k]; vn1[8 + 2 * k + 1] = bfhi(u1b[k]) - ws1[8 + 2 * k + 1]; }
            S0 *= egl; S1 *= egl; S2 *= egl; S3 *= egl;
#define SCAN_STEP2(VN, CT, SS) do { const bf16x8 vf = pack_step<SS>(VN); const int ks = 2 * (CT) + (SS); \
                o0 = MFMA32(ldsfrag(sl + G1_IN + ks * 1024), vf, o0); o1 = MFMA32(ldsfrag(sl + G1_IN + (4 + ks) * 1024), vf, o1); \
                S0 = MFMA32(ldsfrag(sl + G1_KD + (0 + ks) * 1024), vf, S0); S1 = MFMA32(ldsfrag(sl + G1_KD + (4 + ks) * 1024), vf, S1); \
                S2 = MFMA32(ldsfrag(sl + G1_KD + (8 + ks) * 1024), vf, S2); S3 = MFMA32(ldsfrag(sl + G1_KD + (12 + ks) * 1024), vf, S3); asm volatile("" ::: "memory"); } while (0)
            SCAN_STEP2(vn0, 0, 0); SCAN_STEP2(vn0, 0, 1); SCAN_STEP2(vn1, 1, 0); SCAN_STEP2(vn1, 1, 1);
#undef SCAN_STEP2
            const long rs = dir ? -1024 : 1024;
            bf16* ob = OUT + (size_t)(n * 64 + (dir ? 63 : 0)) * 1024 + h * 128 + 32 * wave + r + (long)(4 * hh) * rs;
#pragma unroll
            for (int reg = 0; reg < 16; ++reg) { ob[0] = f2bf(o0[reg]); ob[32 * rs] = f2bf(o1[reg]);
                ob += ((reg & 3) == 3 ? 5 : 1) * rs; asm volatile("" : "+v"(ob)); }
        }
        if (wave >= 4 && st + 1 < N) {
            const int n2 = seq * N + (dir ? N - 2 - st : st + 1); const unsigned char* up2 = G1B + ((size_t)(n2 * 8 + h) * 2 + dir) * G1_UNIT_BYTES;
            u32x4 stg[14];
#pragma unroll
            for (int k = 0; k < 14; ++k) stg[k] = *(const u32x4*)(up2 + lt * 16 + k * 4096);
#pragma unroll
            for (int k = 0; k < 14; ++k) *(LAS u32x4*)(F.lds + ((st + 1) & 1) * G1_STAGE + lt * 16 + k * 4096) = stg[k];
        }
        __syncthreads();
    }
}
constexpr int NPHASE = 16;
__global__ void __launch_bounds__(NTHREADS, 2) fwd_kernel(Args a) {
    extern __shared__ __attribute__((aligned(16))) unsigned char lds_raw[];
    Frame F;
    F.lds = (LAS unsigned char*)lds_raw; F.MISC = (volatile LAS unsigned*)(F.lds + MISC_OFF);
    F.tid = threadIdx.x; F.lane = F.tid & 63; F.wave = __builtin_amdgcn_readfirstlane(F.tid >> 6); F.G = gridDim.x; F.bid = blockIdx.x;
    CArgs* ap = (CArgs*)__builtin_amdgcn_kernarg_segment_ptr();
    F.ws = ap->ws; F.ctl = (gu32*)(ap->ws + WS_CTL);
    const int one_launch = ap->one_launch, ph_lo = ap->ph_lo, ph_hi = ap->ph_hi;
    for (int u = F.tid; u < (LDS_BYTES - LDSCTL_OFF) / 4; u += NTHREADS) ((LAS unsigned*)(F.lds + LDSCTL_OFF))[u] = 0u;
    __syncthreads();
    XcdBarrier bar; bar.bar = (unsigned*)(F.ctl + CW_BAR); bar.x = 0; bar.st = nullptr;
    if (one_launch) bar = xcd_barrier_post((unsigned*)(F.ctl + CW_BAR), F.MISC + 8);
#define SEAM() do { if (one_launch) { XcdBarrier b2_ = bar; asm volatile("" : "+s"(b2_.bar), "+s"(b2_.x)); xcd_barrier(b2_); } } while (0)
#define REFRESH() int layer = layer_i, job = job_i; asm volatile("" : "+s"(layer), "+s"(job)); const JobGeo jg = job_geo(job); (void)jg; do { int t_ = threadIdx.x; asm volatile("" : "+v"(t_)); F.tid = t_; F.lane = t_ & 63; F.wave = __builtin_amdgcn_readfirstlane(t_ >> 6); asm volatile("" : "+s"(ap)); F.ws = ap->ws; F.ctl = (gu32*)(F.ws + WS_CTL); } while (0)
#ifndef PH4MASK
#define PH4MASK 7
#endif
#ifndef PHMASK
#define PHMASK 0xffff
#endif
#define IN(k) (((PHMASK >> (k)) & 1) && ({ int lo_ = ph_lo, hi_ = ph_hi; asm volatile("" : "+s"(lo_), "+s"(hi_)); lo_ <= (k) && (k) < hi_; }))
#define HB ((bf16*)(F.ws + WS_HB))
#define AB ((float*)(F.ws + WS_AB))
#define PB ((bf16*)(F.ws + WS_PB))
#define GL ((float*)(F.ws + WS_GL))
#define OAF ((bf16*)(F.ws + WS_OAF))
#define OAB ((bf16*)(F.ws + WS_OAB))
#define OB ((bf16*)(F.ws + WS_OB))
#define OC2 ((bf16*)(F.ws + WS_OC2))
#define OCP ((bf16*)(F.ws + WS_OCP))
#define PJ ((bf16*)(F.ws + WS_PJ))
#define G1B (F.ws + WS_G1)
#define GT ((bf16*)(F.ws + WS_GT))
#define MG ((bf16*)(F.ws + WS_MG))
#define UB ((bf16*)(F.ws + WS_U))
#define ACT ((bf16*)(F.ws + WS_ACT))
#define PL ((bf16*)(F.ws + WS_PL))
#define Win_t ((const bf16*)(F.ws + WS_WIN))
    const int l0 = ap->l0, l1 = ap->l1, j0 = ap->j0, j1 = ap->j1;
    for (int layer_i = l0; layer_i < l1; ++layer_i) { const int job_i = 0;
        if (IN(0)) { REFRESH(); phase_weights(F, ap, layer); SEAM(); }
        for (int job_i = j0; job_i < j1; ++job_i) {

            if (IN(1)) { REFRESH(); phase_rms(F, ap->out + (size_t)jg.row0 * DM, ap->in[4] + layer * DM, HB); SEAM(); }
            if (IN(2)) { REFRESH();
                pg8::Gemm g{HB, Win_t, JR, NP1, DM, DM, DM}; pg8::StaticOrder S; S.init(JR, NP1, F.G, F.bid);
                pg8::EpiProj E{PJ, AB};
                pg8::gemm_phase<pg8::EpiProj, pg8::StaticOrder>(F.lds, g, S, E, nullptr);
                SEAM();
            }
            if (IN(3)) { REFRESH();
                for (int u = F.bid; u < 4096; u += F.G) g1_unit(F, ap, layer, PJ, AB, G1B, GL, u, jg);
                phase_prep(F, ap, layer, PJ, jg);
                SEAM();
            }
            if (IN(4)) { REFRESH();
                gu32* qh = F.ctl + CW_Q + 64 * (layer * NJOB + job);
                const int nscan = jg.nseq * 16, ntot = nscan + 512 + 1024;
#define QNEXT() do { __syncthreads(); if (F.tid == 0) F.MISC[16] = __hip_atomic_fetch_add(qh, 1u, RLX_AGENT); __syncthreads(); u = (int)F.MISC[16]; } while (0)
                int u; QNEXT();
#if (PH4MASK & 1)
                while (u < nscan) { scan_unit(F, G1B, GL, OAF, OAB, u, jg); QNEXT(); }
#endif
#if (PH4MASK & 2)
                while (u < nscan + 512) { const int v = u - nscan, hq = v >> 6, qb = v & 63, s0 = ((qb * 256) / jg.seqlen) * jg.seqlen;
                    att::attn_dense_body<LDPJ, LDPJ, 1024, 8, 0>(PJ + (size_t)(qb * 256) * LDPJ + PJ_BQ + hq * 128, PJ + (size_t)s0 * LDPJ + PJ_BK + (hq >> 2) * 128, PJ + (size_t)s0 * LDPJ + PJ_BV + (hq >> 2) * 128,
                                                                 OB + (size_t)(qb * 256) * 1024 + hq * 128, jg.seqlen, 0, (char*)lds_raw);
                    QNEXT(); }
#endif
#if (PH4MASK & 4)
                while (u < ntot) { const int v = u - nscan - 512, hc = v >> 6, qb = v & 63, h = hc >> 1, comp = hc & 1, s0 = ((qb * 256) / jg.seqlen) * jg.seqlen;
                    att::attn_dense_body<LDPJ, LDPJ, 2048, 4, 1>(PJ + (size_t)(qb * 256) * LDPJ + PJ_CQ + h * 128, PJ + (size_t)s0 * LDPJ + PJ_CK + h * 128, PJ + (size_t)s0 * LDPJ + PJ_CV + h * 128,
                                                                 OC2 + (size_t)(qb * 256) * 2048 + hc * 128, jg.seqlen, comp * 4, (char*)lds_raw);
                    QNEXT(); }
#endif
#undef QNEXT
                SEAM();
            }
            if (IN(5)) { REFRESH();
                phase_gdn_post(F, ap, layer, OAF, OAB, PJ);
                phase_diff_combine(F, ap, layer, OC2, OCP);
                __syncthreads();
                pg8::Gemm g{HB, Win_t + (size_t)NP1 * DM, JR, NGT, DM, DM, DM}; pg8::StaticOrder S; S.init(JR, NGT, F.G, F.bid);
                pg8::EpiSigmoid E{GT, NGT};
                pg8::gemm_phase<pg8::EpiSigmoid, pg8::StaticOrder>(F.lds, g, S, E, nullptr);
                SEAM();
            }
            if (IN(6)) { REFRESH();
                pg8::Gemm g{OAF, (const bf16*)(F.ws + WS_WOA), JR, DM, 1024, 1024, 1024}; pg8::StaticOrder S; S.init(JR, DM, F.G, F.bid);
                pg8::EpiMerge<true> E{MG, GT, NGT};
                pg8::gemm_phase<pg8::EpiMerge<true>, pg8::StaticOrder>(F.lds, g, S, E, nullptr);
                SEAM();
            }
            if (IN(7)) { REFRESH();
                pg8::Gemm g{OB, (const bf16*)(F.ws + WS_WOB), JR, DM, 1024, 1024, 1024}; pg8::StaticOrder S; S.init(JR, DM, F.G, F.bid);
                pg8::EpiMerge<false> E{MG, GT + 2048, NGT};
                pg8::gemm_phase<pg8::EpiMerge<false>, pg8::StaticOrder>(F.lds, g, S, E, nullptr);
                SEAM();
            }
            if (IN(8)) { REFRESH();
                pg8::Gemm g{OCP, (const bf16*)(F.ws + WS_WOC), JR, DM, 1024, 1024, 1024}; pg8::StaticOrder S; S.init(JR, DM, F.G, F.bid);
                pg8::EpiMerge<false> E{MG, GT + 4096, NGT};
                pg8::gemm_phase<pg8::EpiMerge<false>, pg8::StaticOrder>(F.lds, g, S, E, nullptr);
                SEAM();
            }
            if (IN(9)) { REFRESH();
                pg8::Gemm g{MG, (const bf16*)(F.ws + WS_WOUT), JR, DM, DM, DM, DM}; pg8::StaticOrder S; S.init(JR, DM, F.G, F.bid);
                pg8::EpiResid<false> E{ap->out + (size_t)jg.row0 * DM, nullptr};
                pg8::gemm_phase<pg8::EpiResid<false>, pg8::StaticOrder>(F.lds, g, S, E, nullptr);
                SEAM();
            }
            if (IN(10)) { REFRESH(); phase_rms(F, ap->out + (size_t)jg.row0 * DM, ap->in[20] + layer * DM, HB); SEAM(); }
            if (IN(11)) { REFRESH();
                pg8::Gemm g{HB, (const bf16*)(F.ws + WS_WUP), JR, NUP, DM, DM, DM}; pg8::StaticOrder S; S.init(JR, NUP, F.G, F.bid);
                pg8::EpiStoreBf16 E{UB, NUP};
                pg8::gemm_phase<pg8::EpiStoreBf16, pg8::StaticOrder>(F.lds, g, S, E, nullptr);
                SEAM();
            }
            if (IN(12)) { REFRESH();
                phase_conv_act(F, ap, layer, UB, ACT, jg);
                const float* P = job == 0 ? ap->in[2] + (size_t)layer * 16384 * PLE : ap->in[3] + ((size_t)layer * 32768 + (size_t)(job - 1) * 16384) * PLE;
                phase_pconvert(F, P, PB);
                SEAM();
            }
            if (IN(13)) { REFRESH();
                pg8::Gemm g{ACT, (const bf16*)(F.ws + WS_WDOWN), JR, DM, DFF, DFF, DFF}; pg8::StaticOrder S; S.init(JR, DM, F.G, F.bid);
                pg8::EpiResid<true> E{ap->out + (size_t)jg.row0 * DM, HB};
                pg8::gemm_phase<pg8::EpiResid<true>, pg8::StaticOrder>(F.lds, g, S, E, nullptr);
                SEAM();
            }
            if (IN(14)) { REFRESH();
                pg8::Gemm g{PB, (const bf16*)(F.ws + WS_WPLE), JR, DM, PLE, PLE, PLE}; pg8::StaticOrder S; S.init(JR, DM, F.G, F.bid);
                pg8::EpiStoreBf16 E{PL, DM};
                pg8::gemm_phase<pg8::EpiStoreBf16, pg8::StaticOrder>(F.lds, g, S, E, nullptr);
                SEAM();
            }
            if (IN(15)) { REFRESH();
                pg8::Gemm g{HB, (const bf16*)(F.ws + WS_WPG), JR, DM, DM, DM, DM}; pg8::StaticOrder S; S.init(JR, DM, F.G, F.bid);
                pg8::EpiPle E{ap->out + (size_t)jg.row0 * DM, PL};
                pg8::gemm_phase<pg8::EpiPle, pg8::StaticOrder>(F.lds, g, S, E, nullptr);
                SEAM();
            }
        }
    }
#undef SEAM
#undef IN
#undef HB
#undef AB
#undef PB
#undef GL
#undef OAF
#undef OAB
#undef OB
#undef OC2
#undef OCP
#undef PJ
#undef G1B
#undef GT
#undef MG
#undef UB
#undef ACT
#undef PL
#undef Win_t
}

#ifndef MK_ONE_LAUNCH
#define MK_ONE_LAUNCH 0
#endif
extern "C" void kernel_launch(void* const* d_in, const int* in_sizes, int n_in, void* d_out, int out_size, void* d_ws, size_t ws_size, hipStream_t stream) {
    static int grid = 0;
    if (grid == 0) {
        if (n_in != 27 || out_size != MALL * DM || ws_size < WS_END) { fprintf(stderr, "kernel_launch: unexpected shapes: n_in %d out %d ws %zu (need %zu)\n", n_in, out_size, ws_size, (size_t)WS_END); grid = -1; return; }
        int dev = 0, cus = 0, per_cu = 0;
        if (hipGetDevice(&dev) != hipSuccess || hipDeviceGetAttribute(&cus, hipDeviceAttributeMultiprocessorCount, dev) != hipSuccess) { grid = -1; return; }
        if (hipFuncSetAttribute((const void*)fwd_kernel, hipFuncAttributeMaxDynamicSharedMemorySize, LDS_BYTES) != hipSuccess) { fprintf(stderr, "kernel_launch: hipFuncSetAttribute failed\n"); grid = -1; return; }
        if (hipOccupancyMaxActiveBlocksPerMultiprocessor(&per_cu, (const void*)fwd_kernel, NTHREADS, LDS_BYTES) != hipSuccess || per_cu < 1) fprintf(stderr, "kernel_launch: occupancy query says %d\n", per_cu);
        (void)hipGetLastError();
        grid = cus;
    }
    if (grid < 0) return;
    (void)hipMemsetAsync((char*)d_ws + WS_CTL, 0, CTL_ZERO_BYTES, stream);
    (void)hipMemcpyAsync(d_out, d_in[0], (size_t)16384 * DM * 4, hipMemcpyDeviceToDevice, stream);
    (void)hipMemcpyAsync((float*)d_out + (size_t)16384 * DM, d_in[1], (size_t)32768 * DM * 4, hipMemcpyDeviceToDevice, stream);
    Args a{};
    for (int i = 0; i < 27; ++i) a.in[i] = (const float*)d_in[i];
    a.out = (float*)d_out; a.ws = (unsigned char*)d_ws; a.dbg = 0;
#if MK_ONE_LAUNCH
    a.l0 = 0; a.l1 = NLAYER; a.j0 = 0; a.j1 = NJOB; a.ph_lo = 0; a.ph_hi = NPHASE; a.one_launch = 1;
    hipLaunchKernelGGL(fwd_kernel, dim3(grid), dim3(NTHREADS), LDS_BYTES, stream, a);
#else
    a.one_launch = 0;
    for (int l = 0; l < NLAYER; ++l) {
        a.l0 = l; a.l1 = l + 1; a.j0 = 0; a.j1 = 0; a.ph_lo = 0; a.ph_hi = 1;
        hipLaunchKernelGGL(fwd_kernel, dim3(grid), dim3(NTHREADS), LDS_BYTES, stream, a);
        for (int j = 0; j < NJOB; ++j) for (int p = 1; p < NPHASE; ++p) { a.j0 = j; a.j1 = j + 1; a.ph_lo = p; a.ph_hi = p + 1;
            hipLaunchKernelGGL(fwd_kernel, dim3(grid), dim3(NTHREADS), LDS_BYTES, stream, a); }
    }
#endif
    const hipError_t le = hipPeekAtLastError();
    if (le != hipSuccess) fprintf(stderr, "kernel_launch: launch failed: %s\n", hipGetErrorName(le));
}
```

```cpp
#include <hip/hip_runtime.h>
#include <cstdio>
#include <cstdint>
namespace pg8 {
#define PG8_LAS __attribute__((address_space(3)))
typedef unsigned short bf16_t;
typedef short bf16x8 __attribute__((ext_vector_type(8)));
typedef float f32x4 __attribute__((ext_vector_type(4)));
typedef unsigned u32x4 __attribute__((ext_vector_type(4)));
constexpr int BM = 256, BK = 64, HALF = 128, HTB = HALF * BK * 2  , STAGE_BYTES = 8 * HTB, NXCD = 8, WGM = 4;

__host__ __device__ __forceinline__ int lds_byte(int r, int c) { const int st = (r >> 4) * 2 + (c >> 5), rr = r & 15, cc = c & 31, ob = rr * 64 + cc * 2; return st * 1024 + (ob ^ (((ob >> 9) & 1) << 5)); }
__host__ __device__ __forceinline__ void stage_rc(int b, int& R, int& C) { const int st = b / 1024, sb = b % 1024, swz = sb ^ (((sb >> 9) & 1) << 5); R = (st >> 1) * 16 + swz / 64; C = (st & 1) * 32 + (swz % 64) / 2; }
__host__ __device__ __forceinline__ int perm32(int rho) { const int n = rho >> 4, i = rho & 15; return 8 * (i >> 2) + 4 * n + (i & 3); }

struct Unit { int pm, pn, x; };
struct Gemm { const bf16_t* A; const bf16_t* Bt; int M, N, K, lda, ldb; size_t ksa; };

struct StaticOrder {
    int nM, nN, nwg, G, c;
    __host__ __device__ void init(int M, int N, int G_, int c_) { nM = M / BM; nN = N / BM; nwg = nM * nN; G = G_; c = c_; }
    __host__ __device__ bool next(int i, Unit& u) const {
        const long L = (long)i * G + c; if (L >= nwg) return false;
        int wgid = (int)L; { const int q = nwg / NXCD, r = nwg % NXCD, xcd = wgid % NXCD, off = wgid / NXCD; wgid = (xcd < r ? xcd * (q + 1) : r * (q + 1) + (xcd - r) * q) + off; }
        const int nig = WGM * nN, gid = wgid / nig, fm = gid * WGM, gsz = (nM - fm) < WGM ? (nM - fm) : WGM;
        u.pm = fm + ((wgid % nig) % gsz); u.pn = (wgid % nig) / gsz; u.x = 0; return true;
    }
    __device__ __forceinline__ void a_ready(const Unit&) const {}
    __device__ __forceinline__ void done(const Unit&) const {}
};
template <class Epi> __device__ __forceinline__ const char* pg8_base_a(const Epi& E, const Gemm& g, const Unit& u) { if constexpr (Epi::MULTI) return (const char*)E.opA(u.x); else return (const char*)g.A; }
template <class Epi> __device__ __forceinline__ const char* pg8_base_b(const Epi& E, const Gemm& g, const Unit& u) { if constexpr (Epi::MULTI) return (const char*)E.opB(u.x); else return (const char*)g.Bt; }
template <class Epi, class Sched, bool ALIGN_EPI = false, bool SP2 = false>
__device__ __forceinline__ void gemm_phase(PG8_LAS unsigned char* lds, const Gemm g, const Sched& S, const Epi& E, int wave_in) {
    int tid_ = (wave_in << 6) | (int)__builtin_amdgcn_mbcnt_hi(~0u, __builtin_amdgcn_mbcnt_lo(~0u, 0u)); asm volatile("" : "+v"(tid_));
    const int tid = tid_, wid = __builtin_amdgcn_readfirstlane(tid >> 6), lane = tid & 63, wr = wid >> 2, wc = wid & 3, fr = lane & 15, fq = lane >> 4;
    const int K = g.K, nt = K / BK;
    unsigned voffA[2], voffB[2];
#pragma unroll
    for (int i = 0; i < 2; ++i) { int R, C; stage_rc(tid * 16 + i * 8192, R, C); const int Rb = Epi::PERM ? ((R & ~31) + perm32(R & 31)) : R;
        const int Ra = Epi::APERM ? ((R & ~63) + 4 * (R & 15) + ((R >> 4) & 3)) : R;
        voffA[i] = (unsigned)(Ra * g.lda + C) * 2u; voffB[i] = (unsigned)(Rb * g.ldb + C) * 2u; }
    const size_t kstep = (size_t)(BK * 2), kstepA = g.ksa;
    const size_t hstepA = (size_t)HALF * g.lda * 2, hstepB = (size_t)HALF * g.ldb * 2;
    const size_t tstepA = 2 * hstepA, tstepB = 2 * hstepB;
    const unsigned ldsw = (unsigned)wid * 1024u;
    const int aoff = lds_byte(wr * 64 + fr, fq * 8), boff = lds_byte(wc * 32 + fr, fq * 8);
#define PG8_SA(b, h) (((b) * 2 + (h)) * HTB)
#define PG8_SB(b, h) ((4 + (b) * 2 + (h)) * HTB)
#define PG8_STAGE(bufoff, gbase, voff) do { _Pragma("unroll") for (int _i = 0; _i < 2; ++_i) \
        __builtin_amdgcn_global_load_lds((const unsigned*)((const char*)(gbase) + (voff)[_i]), (PG8_LAS unsigned*)(lds + (bufoff) + ldsw + _i * 8192), 16, 0, 0); } while (0)
#define PG8_LDA(dst, b, h) do { _Pragma("unroll") for (int m = 0; m < 4; ++m) _Pragma("unroll") for (int k = 0; k < 2; ++k) dst[m][k] = *(const PG8_LAS bf16x8*)(lds + PG8_SA(b, h) + aoff + m * 2048 + k * 1024); } while (0)
#define PG8_LDB(dst, b, h) do { _Pragma("unroll") for (int n = 0; n < 2; ++n) _Pragma("unroll") for (int k = 0; k < 2; ++k) dst[n][k] = *(const PG8_LAS bf16x8*)(lds + PG8_SB(b, h) + boff + n * 2048 + k * 1024); } while (0)
#define PG8_MMA(ai, bj, At, Bt) do { __builtin_amdgcn_s_setprio(1); _Pragma("unroll") for (int m = 0; m < 4; ++m) _Pragma("unroll") for (int n = 0; n < 2; ++n) _Pragma("unroll") for (int k = 0; k < 2; ++k) \
        acc[ai][bj][m][n] = __builtin_amdgcn_mfma_f32_16x16x32_bf16(Bt[n][k], At[m][k], acc[ai][bj][m][n], 0, 0, 0); __builtin_amdgcn_s_setprio(0); } while (0)
#define PG8_WAIT_V(n) asm volatile("s_waitcnt vmcnt(" #n ")" ::: "memory")
#define PG8_WAIT_L(n) asm volatile("s_waitcnt lgkmcnt(" #n ")" ::: "memory")
#define PG8_BAR __builtin_amdgcn_s_barrier()
#define PG8_SCHED __builtin_amdgcn_sched_barrier(0)
    Unit cur, nxt; int ui = 0;
    if (!S.next(0, cur)) return;
    f32x4 acc[2][2][4][2];
#pragma unroll
    for (int a = 0; a < 2; ++a)
#pragma unroll
        for (int b = 0; b < 2; ++b)
#pragma unroll
            for (int m = 0; m < 4; ++m)
#pragma unroll
                for (int n = 0; n < 2; ++n) acc[a][b][m][n] = (f32x4){0.f, 0.f, 0.f, 0.f};
    bf16x8 At[4][2], B0[2][2], B1[2][2];
#define PG8_BASEA(u_) pg8_base_a(E, g, (u_))
#define PG8_BASEB(u_) pg8_base_b(E, g, (u_))
    const char* cA = PG8_BASEA(cur) + (size_t)cur.pm * tstepA; const char* cB = PG8_BASEB(cur) + (size_t)cur.pn * tstepB;
    S.a_ready(cur);
    if constexpr (SP2) {
        PG8_STAGE(PG8_SB(0, 0), cB, voffB); PG8_STAGE(PG8_SB(0, 1), cB + hstepB, voffB); PG8_STAGE(PG8_SA(0, 0), cA, voffA); PG8_STAGE(PG8_SA(0, 1), cA + hstepA, voffA);
        if (wr == 1) PG8_BAR;
        PG8_WAIT_V(2); PG8_BAR;
        PG8_STAGE(PG8_SB(1, 0), cB + kstep, voffB); PG8_STAGE(PG8_SA(1, 0), cA + kstepA, voffA); PG8_STAGE(PG8_SB(1, 1), cB + hstepB + kstep, voffB);
        PG8_WAIT_V(6); PG8_BAR;
    } else {
        PG8_STAGE(PG8_SB(0, 0), cB, voffB); PG8_STAGE(PG8_SA(0, 0), cA, voffA); PG8_STAGE(PG8_SB(0, 1), cB + hstepB, voffB); PG8_STAGE(PG8_SA(0, 1), cA + hstepA, voffA);
        if (wr == 1) PG8_BAR;
        PG8_WAIT_V(4); PG8_BAR;
        PG8_STAGE(PG8_SB(1, 0), cB + kstep, voffB); PG8_STAGE(PG8_SA(1, 0), cA + kstepA, voffA); PG8_STAGE(PG8_SB(1, 1), cB + hstepB + kstep, voffB);
        PG8_WAIT_V(6); PG8_BAR;
    }
    for (;;) {
        const bool has_next = S.next(ui + 1, nxt);
        const char* nA = has_next ? PG8_BASEA(nxt) + (size_t)nxt.pm * tstepA : cA; const char* nB = has_next ? PG8_BASEB(nxt) + (size_t)nxt.pn * tstepB : cB;
        for (int t = 0; t < nt; t += 2) {
            const bool last = (t == nt - 2);
            const char* a1 = cA + (size_t)(t + 1) * kstepA;
            const char* a2 = last ? nA : cA + (size_t)(t + 2) * kstepA; const char* b2 = last ? nB : cB + (size_t)(t + 2) * kstep;
            const char* a3 = a2 + kstepA; const char* b3 = b2 + kstep;
            if (last && has_next) S.a_ready(nxt);
            if constexpr (SP2) {
            PG8_LDB(B0, 0, 0); PG8_LDB(B1, 0, 1); PG8_SCHED; PG8_LDA(At, 0, 0); PG8_STAGE(PG8_SA(1, 1), a1 + hstepA, voffA);
            PG8_WAIT_V(8); PG8_WAIT_L(0); PG8_BAR; PG8_MMA(0, 0, At, B0); PG8_MMA(0, 1, At, B1); PG8_BAR; PG8_SCHED;
            PG8_LDA(At, 0, 1); PG8_STAGE(PG8_SB(0, 0), b2, voffB); PG8_STAGE(PG8_SB(0, 1), b2 + hstepB, voffB); PG8_STAGE(PG8_SA(0, 0), a2, voffA);
            PG8_WAIT_V(8); PG8_WAIT_L(0); PG8_BAR; PG8_MMA(1, 0, At, B0); PG8_MMA(1, 1, At, B1); PG8_BAR; PG8_SCHED;
            PG8_LDB(B0, 1, 0); PG8_LDB(B1, 1, 1); PG8_SCHED; PG8_LDA(At, 1, 0); PG8_STAGE(PG8_SA(0, 1), a2 + hstepA, voffA);
            PG8_WAIT_V(8); PG8_WAIT_L(0); PG8_BAR; PG8_MMA(0, 0, At, B0); PG8_MMA(0, 1, At, B1); PG8_BAR; PG8_SCHED;
            PG8_LDA(At, 1, 1); PG8_STAGE(PG8_SB(1, 0), b3, voffB); PG8_STAGE(PG8_SB(1, 1), b3 + hstepB, voffB); PG8_STAGE(PG8_SA(1, 0), a3, voffA);
            PG8_WAIT_V(8); PG8_WAIT_L(0); PG8_BAR; PG8_MMA(1, 0, At, B0); PG8_MMA(1, 1, At, B1); PG8_BAR; PG8_SCHED;
            } else {
            PG8_LDB(B0, 0, 0); PG8_SCHED; PG8_LDA(At, 0, 0); PG8_STAGE(PG8_SA(1, 1), a1 + hstepA, voffA);
            PG8_WAIT_L(8); PG8_BAR; PG8_WAIT_L(0); PG8_MMA(0, 0, At, B0); PG8_BAR; PG8_SCHED;
            PG8_LDB(B1, 0, 1); PG8_STAGE(PG8_SB(0, 0), b2, voffB);
            PG8_BAR; PG8_WAIT_L(0); PG8_MMA(0, 1, At, B1); PG8_BAR;
            PG8_LDA(At, 0, 1); PG8_STAGE(PG8_SA(0, 0), a2, voffA);
            PG8_BAR; PG8_WAIT_L(0); PG8_MMA(1, 0, At, B0); PG8_BAR; PG8_SCHED;
            PG8_STAGE(PG8_SB(0, 1), b2 + hstepB, voffB);
            PG8_WAIT_V(6); PG8_BAR; PG8_MMA(1, 1, At, B1); PG8_BAR;
            PG8_LDB(B0, 1, 0); PG8_SCHED; PG8_LDA(At, 1, 0); PG8_STAGE(PG8_SA(0, 1), a2 + hstepA, voffA);
            PG8_WAIT_L(8); PG8_BAR; PG8_WAIT_L(0); PG8_MMA(0, 0, At, B0); PG8_BAR; PG8_SCHED;
            PG8_LDB(B1, 1, 1); PG8_STAGE(PG8_SB(1, 0), b3, voffB);
            PG8_BAR; PG8_WAIT_L(0); PG8_MMA(0, 1, At, B1); PG8_BAR;
            PG8_LDA(At, 1, 1); PG8_STAGE(PG8_SA(1, 0), a3, voffA);
            PG8_BAR; PG8_WAIT_L(0); PG8_MMA(1, 0, At, B0); PG8_BAR; PG8_SCHED;
            PG8_STAGE(PG8_SB(1, 1), b3 + hstepB, voffB);
            PG8_WAIT_V(6); PG8_BAR; PG8_MMA(1, 1, At, B1); PG8_BAR;
            }
        }
        if constexpr (ALIGN_EPI) { if (wr == 0) PG8_BAR; }
        bool keep_acc = false;
        int te_ = (int)__builtin_amdgcn_mbcnt_hi(~0u, __builtin_amdgcn_mbcnt_lo(~0u, 0u)); asm volatile("" : "+v"(te_)); const int fr_e = te_ & 15, fq_e = (te_ & 63) >> 4;
        if constexpr (Epi::MULTI) { if (cur.x < Epi::NSUB - 1) { E.rescale(acc, cur, wr, wc, fr_e, fq_e); keep_acc = true; } else E(acc, cur, wr, wc, fr_e, fq_e); }
        else if constexpr (!Epi::AFTER_DRAIN) { E(acc, cur, wr, wc, fr_e, fq_e); S.done(cur); }
        if (!has_next) break;
        if (!keep_acc) {
#pragma unroll
        for (int a = 0; a < 2; ++a)
#pragma unroll
            for (int b = 0; b < 2; ++b)
#pragma unroll
                for (int m = 0; m < 4; ++m)
#pragma unroll
                    for (int n = 0; n < 2; ++n) acc[a][b][m][n] = (f32x4){0.f, 0.f, 0.f, 0.f}; }
        cur = nxt; cA = nA; cB = nB; ++ui;
        if constexpr (ALIGN_EPI) { if (wr == 1) PG8_BAR; }
    }
    PG8_WAIT_V(0);
    if constexpr (!ALIGN_EPI) { if (wr == 0) PG8_BAR; }
    PG8_BAR;
    if constexpr (Epi::AFTER_DRAIN) { E.fused(acc, cur, wr, wc, fr, fq, lds, wid, lane); S.done(cur); }
#undef PG8_BASEA
#undef PG8_BASEB
#undef PG8_SA
#undef PG8_SB
#undef PG8_STAGE
#undef PG8_LDA
#undef PG8_LDB
#undef PG8_MMA
#undef PG8_WAIT_V
#undef PG8_WAIT_L
#undef PG8_BAR
#undef PG8_SCHED
}
typedef __bf16 hbf2_t __attribute__((ext_vector_type(2)));
typedef float f32x2_t __attribute__((ext_vector_type(2)));
typedef unsigned u32x2 __attribute__((ext_vector_type(2)));
__device__ __forceinline__ unsigned pk2(float lo, float hi) { hbf2_t r = __builtin_convertvector((f32x2_t){lo, hi}, hbf2_t); return __builtin_bit_cast(unsigned, r); }
__device__ __forceinline__ float bflo(unsigned w) { return __uint_as_float(w << 16); }
__device__ __forceinline__ float bfhi(unsigned w) { return __uint_as_float(w & 0xffff0000u); }
__device__ __forceinline__ float sigmoidf_(float x) { return __builtin_amdgcn_rcpf(1.0f + __expf(-x)); }
__device__ __forceinline__ u32x4 pack8(const f32x4& a, const f32x4& b) { u32x4 w; w.x = pk2(a[0], a[1]); w.y = pk2(a[2], a[3]); w.z = pk2(b[0], b[1]); w.w = pk2(b[2], b[3]); return w; }
#define PG8_EPI_ARGS const f32x4 (&acc)[2][2][4][2], const Unit& u, int wr, int wc, int fr, int fq

struct EpiStoreBf16 { static constexpr bool PERM = true, AFTER_DRAIN = false, MULTI = false, APERM = false; bf16_t* O; int ldc;
    __device__ __forceinline__ void operator()(PG8_EPI_ARGS) const {
        const int row0 = u.pm * BM + wr * 64 + fr, col0 = u.pn * BM + wc * 32 + 8 * fq;
#pragma unroll
        for (int ai = 0; ai < 2; ++ai)
#pragma unroll
            for (int m = 0; m < 4; ++m) { bf16_t* rowp = O + (size_t)(row0 + ai * HALF + m * 16) * ldc + col0;
#pragma unroll
                for (int bj = 0; bj < 2; ++bj) *(u32x4*)(rowp + bj * HALF) = pack8(acc[ai][bj][m][0], acc[ai][bj][m][1]); }
    }
};
struct EpiProj { static constexpr bool PERM = true, AFTER_DRAIN = false, MULTI = false, APERM = false; bf16_t* PJ; float* AB;
    __device__ __forceinline__ void operator()(PG8_EPI_ARGS) const {
        const int row0 = u.pm * BM + wr * 64 + fr;
        if (u.pn < 34) { const int col0 = u.pn * BM + wc * 32 + 8 * fq;
#pragma unroll
            for (int ai = 0; ai < 2; ++ai)
#pragma unroll
                for (int m = 0; m < 4; ++m) { bf16_t* rowp = PJ + (size_t)(row0 + ai * HALF + m * 16) * 8704 + col0;
#pragma unroll
                    for (int bj = 0; bj < 2; ++bj) *(u32x4*)(rowp + bj * HALF) = pack8(acc[ai][bj][m][0], acc[ai][bj][m][1]); }
        } else if (wc == 0) {
#pragma unroll
            for (int ai = 0; ai < 2; ++ai)
#pragma unroll
                for (int m = 0; m < 4; ++m) { float* rp = AB + (size_t)(row0 + ai * HALF + m * 16) * 32 + 8 * fq;
                    *(f32x4*)rp = acc[ai][0][m][0]; *(f32x4*)(rp + 4) = acc[ai][0][m][1]; }
        }
    }
};
struct EpiSigmoid { static constexpr bool PERM = true, AFTER_DRAIN = false, MULTI = false, APERM = false; bf16_t* O; int ldc;
    __device__ __forceinline__ void operator()(PG8_EPI_ARGS) const {
        const int row0 = u.pm * BM + wr * 64 + fr, col0 = u.pn * BM + wc * 32 + 8 * fq;
#pragma unroll
        for (int ai = 0; ai < 2; ++ai)
#pragma unroll
            for (int m = 0; m < 4; ++m) { bf16_t* rowp = O + (size_t)(row0 + ai * HALF + m * 16) * ldc + col0;
#pragma unroll
                for (int bj = 0; bj < 2; ++bj) { f32x4 a = acc[ai][bj][m][0], b = acc[ai][bj][m][1];
#pragma unroll
                    for (int j = 0; j < 4; ++j) { a[j] = sigmoidf_(a[j]); b[j] = sigmoidf_(b[j]); }
                    *(u32x4*)(rowp + bj * HALF) = pack8(a, b); } }
    }
};
template <bool FIRST> struct EpiMerge { static constexpr bool PERM = true, AFTER_DRAIN = false, MULTI = false, APERM = false; bf16_t* MG; const bf16_t* G; int ldg;
    __device__ __forceinline__ void operator()(PG8_EPI_ARGS) const {
        const int row0 = u.pm * BM + wr * 64 + fr, col0 = u.pn * BM + wc * 32 + 8 * fq;
#pragma unroll
        for (int ai = 0; ai < 2; ++ai)
#pragma unroll
            for (int m = 0; m < 4; ++m) { const size_t r = (size_t)(row0 + ai * HALF + m * 16); bf16_t* mp = MG + r * 2048 + col0; const bf16_t* gp = G + r * ldg + col0;
#pragma unroll
                for (int bj = 0; bj < 2; ++bj) { const u32x4 gw = *(const u32x4*)(gp + bj * HALF); f32x4 a = acc[ai][bj][m][0], b = acc[ai][bj][m][1];
                    a[0] *= bflo(gw.x); a[1] *= bfhi(gw.x); a[2] *= bflo(gw.y); a[3] *= bfhi(gw.y); b[0] *= bflo(gw.z); b[1] *= bfhi(gw.z); b[2] *= bflo(gw.w); b[3] *= bfhi(gw.w);
                    if (!FIRST) { const u32x4 ow = *(const u32x4*)(mp + bj * HALF);
                        a[0] += bflo(ow.x); a[1] += bfhi(ow.x); a[2] += bflo(ow.y); a[3] += bfhi(ow.y); b[0] += bflo(ow.z); b[1] += bfhi(ow.z); b[2] += bflo(ow.w); b[3] += bfhi(ow.w); }
                    *(u32x4*)(mp + bj * HALF) = pack8(a, b); } }
    }
};
template <bool WRITE_XB> struct EpiResid { static constexpr bool PERM = false, AFTER_DRAIN = false, MULTI = false, APERM = false; float* X; bf16_t* XB; const float* Xin;
    __device__ __forceinline__ void operator()(PG8_EPI_ARGS) const {
        const int row0 = u.pm * BM + wr * 64 + fr, col0 = u.pn * BM + wc * 32 + 4 * fq;
#pragma unroll
        for (int ai = 0; ai < 2; ++ai)
#pragma unroll
            for (int m = 0; m < 4; ++m) { const size_t off = (size_t)(row0 + ai * HALF + m * 16) * 2048 + col0;
#pragma unroll
                for (int bj = 0; bj < 2; ++bj)
#pragma unroll
                    for (int n = 0; n < 2; ++n) { const size_t o = off + bj * HALF + n * 16; const f32x4 v = *(const f32x4*)(Xin + o) + acc[ai][bj][m][n]; *(f32x4*)(X + o) = v;
                        if (WRITE_XB) { u32x2 w; w.x = pk2(v[0], v[1]); w.y = pk2(v[2], v[3]); *(u32x2*)(XB + o) = w; } } }
    }
};
struct EpiPle { static constexpr bool PERM = false, AFTER_DRAIN = false, MULTI = false, APERM = false; float* X; const bf16_t* PL;
    __device__ __forceinline__ void operator()(PG8_EPI_ARGS) const {
        const int row0 = u.pm * BM + wr * 64 + fr, col0 = u.pn * BM + wc * 32 + 4 * fq;
#pragma unroll
        for (int ai = 0; ai < 2; ++ai)
#pragma unroll
            for (int m = 0; m < 4; ++m) { const size_t off = (size_t)(row0 + ai * HALF + m * 16) * 2048 + col0;
#pragma unroll
                for (int bj = 0; bj < 2; ++bj)
#pragma unroll
                    for (int n = 0; n < 2; ++n) { const size_t o = off + bj * HALF + n * 16; const u32x2 pw = *(const u32x2*)(PL + o); const f32x4 a = acc[ai][bj][m][n]; f32x4 v = *(const f32x4*)(X + o);
                        v[0] += sigmoidf_(a[0]) * bflo(pw.x); v[1] += sigmoidf_(a[1]) * bfhi(pw.x); v[2] += sigmoidf_(a[2]) * bflo(pw.y); v[3] += sigmoidf_(a[3]) * bfhi(pw.y);
                        *(f32x4*)(X + o) = v; } }
    }
};
struct EpiResidToB { static constexpr bool PERM = true, AFTER_DRAIN = false, MULTI = false, APERM = false; bf16_t* XB; const float* Xin;
    __device__ __forceinline__ void operator()(PG8_EPI_ARGS) const {
        const int row0 = u.pm * BM + wr * 64 + fr, col0 = u.pn * BM + wc * 32 + 8 * fq;
#pragma unroll
        for (int ai = 0; ai < 2; ++ai)
#pragma unroll
            for (int m = 0; m < 4; ++m) { const size_t off = (size_t)(row0 + ai * HALF + m * 16) * 2048 + col0;
#pragma unroll
                for (int bj = 0; bj < 2; ++bj) { const size_t o = off + bj * HALF; const f32x4 a = *(const f32x4*)(Xin + o) + acc[ai][bj][m][0], b = *(const f32x4*)(Xin + o + 4) + acc[ai][bj][m][1];
                    *(u32x4*)(XB + o) = pack8(a, b); } }
    }
};
struct EpiResidBB { static constexpr bool PERM = true, AFTER_DRAIN = false, MULTI = false, APERM = false; bf16_t* XBo; const bf16_t* XBi;
    __device__ __forceinline__ void operator()(PG8_EPI_ARGS) const {
        const int row0 = u.pm * BM + wr * 64 + fr, col0 = u.pn * BM + wc * 32 + 8 * fq;
#pragma unroll
        for (int ai = 0; ai < 2; ++ai)
#pragma unroll
            for (int m = 0; m < 4; ++m) { const size_t off = (size_t)(row0 + ai * HALF + m * 16) * 2048 + col0;
#pragma unroll
                for (int bj = 0; bj < 2; ++bj) { const size_t o = off + bj * HALF; const u32x4 w = *(const u32x4*)(XBi + o); f32x4 a = acc[ai][bj][m][0], b = acc[ai][bj][m][1];
                    a[0] += bflo(w.x); a[1] += bfhi(w.x); a[2] += bflo(w.y); a[3] += bfhi(w.y); b[0] += bflo(w.z); b[1] += bfhi(w.z); b[2] += bflo(w.w); b[3] += bfhi(w.w);
                    *(u32x4*)(XBo + o) = pack8(a, b); } }
    }
};
struct EpiPleB { static constexpr bool PERM = true, AFTER_DRAIN = false, MULTI = false, APERM = false; float* X; const bf16_t* XB; const bf16_t* PL;
    __device__ __forceinline__ void operator()(PG8_EPI_ARGS) const {
        const int row0 = u.pm * BM + wr * 64 + fr, col0 = u.pn * BM + wc * 32 + 8 * fq;
#pragma unroll
        for (int ai = 0; ai < 2; ++ai)
#pragma unroll
            for (int m = 0; m < 4; ++m) { const size_t off = (size_t)(row0 + ai * HALF + m * 16) * 2048 + col0;
#pragma unroll
                for (int bj = 0; bj < 2; ++bj) { const size_t o = off + bj * HALF; const u32x4 xw = *(const u32x4*)(XB + o), pw = *(const u32x4*)(PL + o); const f32x4 a = acc[ai][bj][m][0], b = acc[ai][bj][m][1]; f32x4 v0, v1;
                    v0[0] = bflo(xw.x) + sigmoidf_(a[0]) * bflo(pw.x); v0[1] = bfhi(xw.x) + sigmoidf_(a[1]) * bfhi(pw.x); v0[2] = bflo(xw.y) + sigmoidf_(a[2]) * bflo(pw.y); v0[3] = bfhi(xw.y) + sigmoidf_(a[3]) * bfhi(pw.y);
                    v1[0] = bflo(xw.z) + sigmoidf_(b[0]) * bflo(pw.z); v1[1] = bfhi(xw.z) + sigmoidf_(b[1]) * bfhi(pw.z); v1[2] = bflo(xw.w) + sigmoidf_(b[2]) * bflo(pw.w); v1[3] = bfhi(xw.w) + sigmoidf_(b[3]) * bfhi(pw.w);
                    *(f32x4*)(X + o) = v0; *(f32x4*)(X + o + 4) = v1; } }
    }
};
struct EpiPleBB { static constexpr bool PERM = true, AFTER_DRAIN = false, MULTI = false, APERM = false; bf16_t* XBo; const bf16_t* XB; const bf16_t* PL;
    __device__ __forceinline__ void operator()(PG8_EPI_ARGS) const {
        const int row0 = u.pm * BM + wr * 64 + fr, col0 = u.pn * BM + wc * 32 + 8 * fq;
#pragma unroll
        for (int ai = 0; ai < 2; ++ai)
#pragma unroll
            for (int m = 0; m < 4; ++m) { const size_t off = (size_t)(row0 + ai * HALF + m * 16) * 2048 + col0;
#pragma unroll
                for (int bj = 0; bj < 2; ++bj) { const size_t o = off + bj * HALF; const u32x4 xw = *(const u32x4*)(XB + o), pw = *(const u32x4*)(PL + o); const f32x4 a = acc[ai][bj][m][0], b = acc[ai][bj][m][1]; f32x4 v0, v1;
                    v0[0] = bflo(xw.x) + sigmoidf_(a[0]) * bflo(pw.x); v0[1] = bfhi(xw.x) + sigmoidf_(a[1]) * bfhi(pw.x); v0[2] = bflo(xw.y) + sigmoidf_(a[2]) * bflo(pw.y); v0[3] = bfhi(xw.y) + sigmoidf_(a[3]) * bfhi(pw.y);
                    v1[0] = bflo(xw.z) + sigmoidf_(b[0]) * bflo(pw.z); v1[1] = bfhi(xw.z) + sigmoidf_(b[1]) * bfhi(pw.z); v1[2] = bflo(xw.w) + sigmoidf_(b[2]) * bflo(pw.w); v1[3] = bfhi(xw.w) + sigmoidf_(b[3]) * bfhi(pw.w);
                    *(u32x4*)(XBo + o) = pack8(v0, v1); } }
    }
};
constexpr int CA_NUP = 11264, CA_DFF = 5632, CA_JR = 16384;
template <int CTRL> __device__ __forceinline__ float dppf(float old, float v) { return __builtin_bit_cast(float, __builtin_amdgcn_update_dpp(__builtin_bit_cast(int, old), __builtin_bit_cast(int, v), CTRL, 0xF, 0xF, false)); }
struct EpiConvAct { static constexpr bool PERM = true, AFTER_DRAIN = false, MULTI = false, APERM = true; bf16_t* ACT; bf16_t* UH; const float* cw; const float* cb; PG8_LAS float* xl;
    __device__ __forceinline__ void operator()(PG8_EPI_ARGS) const {
        const int wv = wr * 4 + wc, cg = u.pn * 128 + wc * 32 + 8 * fq;
#pragma unroll
        for (int ai = 0; ai < 2; ++ai)
#pragma unroll
            for (int bj = 0; bj < 2; ++bj) {
                if (fr == 0) { PG8_LAS float* p = xl + ((((wv * 2 + ai) * 2 + 0) * 2 + bj) * 4 + fq) * 8; *(PG8_LAS f32x4*)p = acc[ai][bj][0][0]; *(PG8_LAS f32x4*)(p + 4) = acc[ai][bj][0][1]; }
                if (fr == 15) { PG8_LAS float* p = xl + ((((wv * 2 + ai) * 2 + 1) * 2 + bj) * 4 + fq) * 8; *(PG8_LAS f32x4*)p = acc[ai][bj][3][0]; *(PG8_LAS f32x4*)(p + 4) = acc[ai][bj][3][1]; } }
        asm volatile("s_waitcnt lgkmcnt(0)" ::: "memory"); __builtin_amdgcn_s_barrier(); asm volatile("" ::: "memory");
        { const bool top = (wr == 0) && (fr == 0), bot = (wr == 1) && (fr == 15);
          if (top) { bf16_t* hp = UH + (size_t)(u.pm * 4) * CA_NUP + cg;
              *(u32x4*)hp = pack8(acc[0][0][0][0], acc[0][0][0][1]); *(u32x4*)(hp + CA_DFF) = pack8(acc[0][1][0][0], acc[0][1][0][1]);
              *(u32x4*)(hp + CA_NUP) = pack8(acc[0][0][1][0], acc[0][0][1][1]); *(u32x4*)(hp + CA_NUP + CA_DFF) = pack8(acc[0][1][1][0], acc[0][1][1][1]); }
          if (bot) { bf16_t* hp = UH + (size_t)(u.pm * 4 + 2) * CA_NUP + cg;
              *(u32x4*)hp = pack8(acc[1][0][2][0], acc[1][0][2][1]); *(u32x4*)(hp + CA_DFF) = pack8(acc[1][1][2][0], acc[1][1][2][1]);
              *(u32x4*)(hp + CA_NUP) = pack8(acc[1][0][3][0], acc[1][0][3][1]); *(u32x4*)(hp + CA_NUP + CA_DFF) = pack8(acc[1][1][3][0], acc[1][1][3][1]); } }
#pragma unroll
        for (int n = 0; n < 2; ++n) {
            f32x4 wg[3], wvv[3];
#pragma unroll
            for (int tp = 0; tp < 3; ++tp) { wg[tp] = *(const f32x4*)(cw + (size_t)tp * CA_NUP + cg + 4 * n); wvv[tp] = *(const f32x4*)(cw + (size_t)tp * CA_NUP + CA_DFF + cg + 4 * n); }
#pragma unroll
            for (int ai = 0; ai < 2; ++ai) {
                const int pw_ = (wr == 1) ? wc : 4 + wc, pa_ = (wr == 1) ? ai : 0;
                const int nw_ = (wr == 0) ? 4 + wc : wc, na_ = (wr == 0) ? ai : 1;
#pragma unroll
                for (int m = 0; m < 4; ++m) {
                    __builtin_amdgcn_sched_barrier(0);
                    f32x4 y[2]; const float* cbp = cb; asm volatile("" : "+s"(cbp));
                    const f32x4 bg = *(const f32x4*)(cbp + cg + 4 * n), bv = *(const f32x4*)(cbp + CA_DFF + cg + 4 * n);
#pragma unroll
                    for (int bj = 0; bj < 2; ++bj) {
                        f32x4 xe = {0.f, 0.f, 0.f, 0.f};
                        if (m == 0) xe = *(const PG8_LAS f32x4*)(xl + ((((pw_ * 2 + pa_) * 2 + 1) * 2 + bj) * 4 + fq) * 8 + 4 * n);
                        if (m == 3) xe = *(const PG8_LAS f32x4*)(xl + ((((nw_ * 2 + na_) * 2 + 0) * 2 + bj) * 4 + fq) * 8 + 4 * n);
#pragma unroll
                        for (int j = 0; j < 4; ++j) { const float cur = acc[ai][bj][m][n][j];
                            const float pv = (m > 0) ? acc[ai][bj][m > 0 ? m - 1 : 0][n][j] : dppf<0x111>(xe[j], acc[ai][bj][3][n][j]);
                            const float nv = (m < 3) ? acc[ai][bj][m < 3 ? m + 1 : 3][n][j] : dppf<0x101>(xe[j], acc[ai][bj][0][n][j]);
                            const f32x4& w0 = bj ? wvv[0] : wg[0]; const f32x4& w1 = bj ? wvv[1] : wg[1]; const f32x4& w2 = bj ? wvv[2] : wg[2]; const f32x4& bb = bj ? bv : bg;
                            y[bj][j] = w0[j] * pv + w1[j] * cur + w2[j] * nv + bb[j]; } }
                    f32x4 o;
#pragma unroll
                    for (int j = 0; j < 4; ++j) o[j] = y[0][j] * sigmoidf_(y[0][j]) * y[1][j];
                    const int tr = 128 * ai + 64 * wr + 4 * fr + m;
                    if (tr != 0 && tr != 255) { u32x2 w; w.x = pk2(o[0], o[1]); w.y = pk2(o[2], o[3]);
                        *(u32x2*)(ACT + ((size_t)(cg >> 6) * CA_JR + (size_t)(u.pm * BM + tr)) * 64 + (cg & 63) + 4 * n) = w; }
                }
            }
        }
    }
};
struct EpiStoreBf16RS { static constexpr bool PERM = true, AFTER_DRAIN = false, MULTI = false, APERM = false; bf16_t* O; int ldc; const float* SS;
    __device__ __forceinline__ void operator()(PG8_EPI_ARGS) const {
        const int row0 = u.pm * BM + wr * 64 + fr, col0 = u.pn * BM + wc * 32 + 8 * fq;
#pragma unroll
        for (int ai = 0; ai < 2; ++ai)
#pragma unroll
            for (int m = 0; m < 4; ++m) { asm volatile("" ::: "memory");
                const int row = row0 + ai * HALF + m * 16; const float rs = rsqrtf(SS[row] * (1.0f / 2048.0f) + 1e-6f); bf16_t* rowp = O + (size_t)row * ldc + col0;
#pragma unroll
                for (int bj = 0; bj < 2; ++bj) *(u32x4*)(rowp + bj * HALF) = pack8(acc[ai][bj][m][0] * rs, acc[ai][bj][m][1] * rs); }
    }
};
struct EpiResidSS { static constexpr bool PERM = false, AFTER_DRAIN = false, MULTI = false, APERM = false; float* X; bf16_t* XB; float* SS;
    __device__ __forceinline__ void operator()(PG8_EPI_ARGS) const {
        const int row0 = u.pm * BM + wr * 64 + fr, col0 = u.pn * BM + wc * 32 + 4 * fq;
        float sqv[8];
#pragma unroll
        for (int ai = 0; ai < 2; ++ai)
#pragma unroll
            for (int m = 0; m < 4; ++m) { const int row = row0 + ai * HALF + m * 16; const size_t off = (size_t)row * 2048 + col0; float sq = 0.f;
#pragma unroll
                for (int bj = 0; bj < 2; ++bj)
#pragma unroll
                    for (int n = 0; n < 2; ++n) { const size_t o = off + bj * HALF + n * 16; const f32x4 v = *(const f32x4*)(X + o) + acc[ai][bj][m][n]; *(f32x4*)(X + o) = v;
                        u32x2 w; w.x = pk2(v[0], v[1]); w.y = pk2(v[2], v[3]); *(u32x2*)(XB + o) = w; sq += (v[0] * v[0] + v[1] * v[1]) + (v[2] * v[2] + v[3] * v[3]); }
                sq += __shfl_xor(sq, 16); sq += __shfl_xor(sq, 32); sqv[ai * 4 + m] = sq; }
        if (fq == 0) {
#pragma unroll
            for (int q = 0; q < 8; ++q) atomicAdd(SS + row0 + (q >> 2) * HALF + (q & 3) * 16, sqv[q]); }
    }
};
struct EpiMerge3 { static constexpr bool PERM = true, AFTER_DRAIN = false, MULTI = true, APERM = false; static constexpr int NSUB = 3;
    bf16_t* MG; const bf16_t* G; int ldg; const bf16_t* Ga; int ldga; const bf16_t* A0; const bf16_t* B0; long dA, ddA, dB;
    __device__ __forceinline__ const bf16_t* opA(int x) const { return A0 + (long)x * dA + (long)((x * (x - 1)) >> 1) * ddA; }
    __device__ __forceinline__ const bf16_t* opB(int x) const { return B0 + (long)x * dB; }
    __device__ __forceinline__ void rescale(f32x4 (&acc)[2][2][4][2], const Unit& u, int wr, int wc, int fr, int fq) const {
        const int row0 = u.pm * BM + wr * 64 + fr, col0 = u.pn * BM + wc * 32 + 8 * fq;
        const bool first = u.x == 0; const bf16_t* nb = first ? Ga : G + u.x * 2048; const size_t nld = first ? (size_t)ldga : (size_t)ldg;
#pragma unroll
        for (int ai = 0; ai < 2; ++ai)
#pragma unroll
            for (int m = 0; m < 4; ++m) { const size_t r = (size_t)(row0 + ai * HALF + m * 16); const bf16_t* gp = G + r * ldg + u.x * 2048 + col0; const bf16_t* np = nb + r * nld + col0;
#pragma unroll
                for (int bj = 0; bj < 2; ++bj) { const u32x4 gn = *(const u32x4*)(np + bj * HALF), gd = *(const u32x4*)(gp + 2048 + bj * HALF);
#define R_(num, den) (fmaxf(num, 1e-30f) * __builtin_amdgcn_rcpf(fmaxf(den, 1e-30f)))
                    f32x4 a = acc[ai][bj][m][0], b = acc[ai][bj][m][1];
                    a[0] *= R_(bflo(gn.x), bflo(gd.x)); a[1] *= R_(bfhi(gn.x), bfhi(gd.x)); a[2] *= R_(bflo(gn.y), bflo(gd.y)); a[3] *= R_(bfhi(gn.y), bfhi(gd.y));
                    b[0] *= R_(bflo(gn.z), bflo(gd.z)); b[1] *= R_(bfhi(gn.z), bfhi(gd.z)); b[2] *= R_(bflo(gn.w), bflo(gd.w)); b[3] *= R_(bfhi(gn.w), bfhi(gd.w));
                    acc[ai][bj][m][0] = a; acc[ai][bj][m][1] = b;
#undef R_
                } }
    }
    __device__ __forceinline__ void operator()(PG8_EPI_ARGS) const {
        const int row0 = u.pm * BM + wr * 64 + fr, col0 = u.pn * BM + wc * 32 + 8 * fq;
#pragma unroll
        for (int ai = 0; ai < 2; ++ai)
#pragma unroll
            for (int m = 0; m < 4; ++m) { const size_t r = (size_t)(row0 + ai * HALF + m * 16); bf16_t* mp = MG + r * 2048 + col0; const bf16_t* gp = G + r * ldg + 4096 + col0;
#pragma unroll
                for (int bj = 0; bj < 2; ++bj) { const u32x4 gw = *(const u32x4*)(gp + bj * HALF); f32x4 a = acc[ai][bj][m][0], b = acc[ai][bj][m][1];
                    a[0] *= fmaxf(bflo(gw.x), 1e-30f); a[1] *= fmaxf(bfhi(gw.x), 1e-30f); a[2] *= fmaxf(bflo(gw.y), 1e-30f); a[3] *= fmaxf(bfhi(gw.y), 1e-30f);
                    b[0] *= fmaxf(bflo(gw.z), 1e-30f); b[1] *= fmaxf(bfhi(gw.z), 1e-30f); b[2] *= fmaxf(bflo(gw.w), 1e-30f); b[3] *= fmaxf(bfhi(gw.w), 1e-30f);
                    *(u32x4*)(mp + bj * HALF) = pack8(a, b); } }
    }
};
template <int NSUB_> struct MultiOrder : StaticOrder {
    __host__ __device__ bool next(int i, Unit& u) const { if (!StaticOrder::next(i / NSUB_, u)) return false; u.x = i % NSUB_; return true; }
};
struct OneTile : StaticOrder {
    __host__ __device__ bool next(int i, Unit& u) const { return i == 0 && StaticOrder::next(0, u); }
};
}
namespace att {
typedef unsigned short bf16;
constexpr int D = 128, NW = 8, QBLK = 32, KVBLK = 64;
constexpr float THR = 8.f;
constexpr size_t SHM_V = KVBLK * D * 2, SHM_K = KVBLK * D * 2, SHM_ATTN = 2 * SHM_V + 2 * SHM_K + NW * 64 * 4;
using bf16x8 = __attribute__((ext_vector_type(8))) short;
using s16x4  = __attribute__((ext_vector_type(4))) short;
using f32x16 = __attribute__((ext_vector_type(16))) float;
using u32x4  = __attribute__((ext_vector_type(4))) unsigned;
#define KSWZ(row, colB) ((row) * 256 + ((colB) ^ (((row) & 7) << 4)))
#define SBAR() __builtin_amdgcn_sched_barrier(0)
__device__ __forceinline__ int crow(int r, int hi) { return (r & 3) + 8 * (r >> 2) + 4 * hi; }
__device__ __forceinline__ unsigned cvtpk(float lo, float hi) { return pg8::pk2(lo, hi); }
__device__ __forceinline__ void partialSM(f32x16& p0, f32x16& p1, float& m_reg, float& mn, float& alpha) {
  constexpr float THR2 = THR * 1.4426950408889634f;
  float pmax = p0[0];
#pragma unroll
  for (int r = 1; r < 16; ++r) pmax = fmaxf(pmax, p0[r]);
#pragma unroll
  for (int r = 0; r < 16; ++r) pmax = fmaxf(pmax, p1[r]);
  { auto rr = __builtin_amdgcn_permlane32_swap(__float_as_uint(pmax), __float_as_uint(pmax), false, false);
    pmax = fmaxf(__uint_as_float(rr[0]), __uint_as_float(rr[1])); }
  if (__builtin_expect(__all(pmax - m_reg <= THR2), 1)) { mn = m_reg; alpha = 1.f; }
  else { mn = fmaxf(m_reg, pmax); alpha = __builtin_amdgcn_exp2f(m_reg - mn); m_reg = mn; }
#pragma unroll
  for (int r = 0; r < 16; ++r) p0[r] = p0[r] - mn;
#pragma unroll
  for (int r = 0; r < 16; ++r) p1[r] = p1[r] - mn;
#pragma unroll
  for (int r = 0; r < 16; ++r) p0[r] = __builtin_amdgcn_exp2f(p0[r]);
}
__device__ __forceinline__ void partialSM_fast(f32x16& p0) {
#pragma unroll
  for (int r = 0; r < 16; ++r) p0[r] = __builtin_amdgcn_exp2f(p0[r]);
}
__device__ __forceinline__ void finishSM(f32x16& p0, f32x16& p1, float alpha, float& l_reg, bf16x8& pa0, bf16x8& pa1, bf16x8& pa2, bf16x8& pa3) {
#pragma unroll
  for (int r = 0; r < 16; ++r) p1[r] = __builtin_amdgcn_exp2f(p1[r]);
  float ps, ps0 = 0, ps1 = 0, ps2 = 0, ps3 = 0;
#pragma unroll
  for (int r = 0; r < 16; r += 4) { ps0 += p0[r]; ps1 += p0[r + 1]; ps2 += p0[r + 2]; ps3 += p0[r + 3]; }
#pragma unroll
  for (int r = 0; r < 16; r += 4) { ps0 += p1[r]; ps1 += p1[r + 1]; ps2 += p1[r + 2]; ps3 += p1[r + 3]; }
  ps = (ps0 + ps1) + (ps2 + ps3);
  { auto rr = __builtin_amdgcn_permlane32_swap(__float_as_uint(ps), __float_as_uint(ps), false, false);
    ps = __uint_as_float(rr[0]) + __uint_as_float(rr[1]); }
  l_reg = l_reg * alpha + ps;
#define PK4(P, BASE, OUT) do { unsigned a0 = cvtpk(P[BASE + 0], P[BASE + 1]), a1 = cvtpk(P[BASE + 2], P[BASE + 3]);   \
    unsigned b0 = cvtpk(P[BASE + 4], P[BASE + 5]), b1 = cvtpk(P[BASE + 6], P[BASE + 7]);                              \
    auto r0 = __builtin_amdgcn_permlane32_swap(a0, b0, false, false); auto r1 = __builtin_amdgcn_permlane32_swap(a1, b1, false, false); \
    u32x4 w = {r0[0], r1[0], r0[1], r1[1]}; OUT = *reinterpret_cast<bf16x8*>(&w); } while (0)
  PK4(p0, 0, pa0); PK4(p0, 8, pa1); PK4(p1, 0, pa2); PK4(p1, 8, pa3);
#undef PK4
}
__device__ __forceinline__ void finishSM_np(f32x16& p0, f32x16& p1, float alpha, float& l_reg, bf16x8& pa0, bf16x8& pa1, bf16x8& pa2, bf16x8& pa3) {
#pragma unroll
  for (int r = 0; r < 16; ++r) p1[r] = __builtin_amdgcn_exp2f(p1[r]);
  float ps, ps0 = 0, ps1 = 0, ps2 = 0, ps3 = 0;
#pragma unroll
  for (int r = 0; r < 16; r += 4) { ps0 += p0[r]; ps1 += p0[r + 1]; ps2 += p0[r + 2]; ps3 += p0[r + 3]; }
#pragma unroll
  for (int r = 0; r < 16; r += 4) { ps0 += p1[r]; ps1 += p1[r + 1]; ps2 += p1[r + 2]; ps3 += p1[r + 3]; }
  ps = (ps0 + ps1) + (ps2 + ps3);
  { auto rr = __builtin_amdgcn_permlane32_swap(__float_as_uint(ps), __float_as_uint(ps), false, false);
    ps = __uint_as_float(rr[0]) + __uint_as_float(rr[1]); }
  l_reg = l_reg * alpha + ps;
#define PK8(P, BASE, OUT) do { u32x4 w = {cvtpk(P[BASE + 0], P[BASE + 1]), cvtpk(P[BASE + 2], P[BASE + 3]), cvtpk(P[BASE + 4], P[BASE + 5]), cvtpk(P[BASE + 6], P[BASE + 7])}; OUT = *reinterpret_cast<bf16x8*>(&w); } while (0)
  PK8(p0, 0, pa0); PK8(p0, 8, pa1); PK8(p1, 0, pa2); PK8(p1, 8, pa3);
#undef PK8
}
template <int ND0> __device__ __forceinline__ void qkt(f32x16& p0, f32x16& p1, const bf16* Ks, const bf16x8* qr, int r32, int hi, int d0b) {
  p0 = f32x16{}; p1 = f32x16{};
#pragma unroll
  for (int d0 = 0; d0 < ND0; ++d0) { int cb = ((d0b + d0) * 16 + hi * 8) * 2;
    bf16x8 b0 = *reinterpret_cast<const bf16x8*>((const char*)Ks + KSWZ(r32, cb));
    bf16x8 b1 = *reinterpret_cast<const bf16x8*>((const char*)Ks + KSWZ(32 + r32, cb));
    p0 = __builtin_amdgcn_mfma_f32_32x32x16_bf16(b0, qr[d0], p0, 0, 0, 0);
    p1 = __builtin_amdgcn_mfma_f32_32x32x16_bf16(b1, qr[d0], p1, 0, 0, 0); }
}
__device__ __forceinline__ int v_st(int k, int c) { const int kk = (k & ~0xC) | ((k & 4) << 1) | ((k & 8) >> 1); return ((kk >> 3) * 4 + (c >> 5)) * 512 + ((kk & 7) * 32 + (c & 31)) * 2; }
__device__ __forceinline__ int v_rd_base(int lane) { return ((lane & 3) << 3) | (((lane >> 2) & 3) << 6) | (((lane >> 4) & 1) << 5) | (((lane >> 5) & 1) << 8); }
constexpr int v_rd_off(int d0, int ks, int half) { return d0 * 512 + ks * 4096 + half * 2048; }
template <int OFF> __device__ __forceinline__ s16x4 tr_read(int vb) {
  s16x4 r; asm volatile("ds_read_b64_tr_b16 %0, %1 offset:%2" : "=&v"(r) : "v"(vb), "i"(OFF) : "memory"); return r;
}
struct VFrag { s16x4 l0, h0, l1, h1, l2, h2, l3, h3; };
template <int D0> __device__ __forceinline__ void tr8(VFrag& v, int vb) {
  v.l0 = tr_read<v_rd_off(D0, 0, 0)>(vb); v.h0 = tr_read<v_rd_off(D0, 0, 1)>(vb); v.l1 = tr_read<v_rd_off(D0, 1, 0)>(vb); v.h1 = tr_read<v_rd_off(D0, 1, 1)>(vb);
  v.l2 = tr_read<v_rd_off(D0, 2, 0)>(vb); v.h2 = tr_read<v_rd_off(D0, 2, 1)>(vb); v.l3 = tr_read<v_rd_off(D0, 3, 0)>(vb); v.h3 = tr_read<v_rd_off(D0, 3, 1)>(vb);
}
__device__ __forceinline__ void mma4(f32x16& od, const VFrag& v, bf16x8 pa0, bf16x8 pa1, bf16x8 pa2, bf16x8 pa3) {
#define PK(L, H) (bf16x8){L[0], L[1], L[2], L[3], H[0], H[1], H[2], H[3]}
  od = __builtin_amdgcn_mfma_f32_32x32x16_bf16(pa0, PK(v.l0, v.h0), od, 0, 0, 0);
  od = __builtin_amdgcn_mfma_f32_32x32x16_bf16(pa1, PK(v.l1, v.h1), od, 0, 0, 0);
  od = __builtin_amdgcn_mfma_f32_32x32x16_bf16(pa2, PK(v.l2, v.h2), od, 0, 0, 0);
  od = __builtin_amdgcn_mfma_f32_32x32x16_bf16(pa3, PK(v.l3, v.h3), od, 0, 0, 0);
#undef PK
}
__device__ __forceinline__ void pv_d0(f32x16* o, int vb, bf16x8 pa0, bf16x8 pa1, bf16x8 pa2, bf16x8 pa3) {
  VFrag A, B;
  tr8<0>(A, vb); tr8<1>(B, vb);
  asm volatile("s_waitcnt lgkmcnt(8)" ::: "memory"); SBAR();
  mma4(o[0], A, pa0, pa1, pa2, pa3); SBAR();
  tr8<2>(A, vb);
  asm volatile("s_waitcnt lgkmcnt(8)" ::: "memory"); SBAR();
  mma4(o[1], B, pa0, pa1, pa2, pa3); SBAR();
  tr8<3>(B, vb);
  asm volatile("s_waitcnt lgkmcnt(8)" ::: "memory"); SBAR();
  mma4(o[2], A, pa0, pa1, pa2, pa3); SBAR();
  asm volatile("s_waitcnt lgkmcnt(0)" ::: "memory"); SBAR();
  mma4(o[3], B, pa0, pa1, pa2, pa3);
}
template <int LDQ, int LDK, int LDO, int ND0, bool FAST>
__device__ __forceinline__ void attn_dense_body(const bf16* Qb, const bf16* Kh, const bf16* Vh, bf16* Ob, int seq, int d0b, char* lds, int tid_in) {
  int tid_ = tid_in; asm volatile("" : "+v"(tid_));
  const int tid = tid_, wid = tid >> 6, lane = tid & 63, r32 = lane & 31, hi = lane >> 5;
  bf16* V_lds = (bf16*)lds; bf16* K_lds = (bf16*)(lds + 2 * SHM_V);
  float* ws = (float*)(lds + 2 * SHM_V + 2 * SHM_K) + wid * 64; float* li_l = ws; float* al_l = ws + 32;
  float m_reg = -1e30f, l_reg = 0; f32x16 o[4] = {}; bf16x8 qr[ND0];
  const bf16* Qw = Qb + (long)(wid * QBLK + r32) * LDQ + hi * 8 + d0b * 16;
#pragma unroll
  for (int d0 = 0; d0 < ND0; ++d0) qr[d0] = *reinterpret_cast<const bf16x8*>(Qw + d0 * 16);
  const int sr = tid >> 4, sc = (tid & 15) * 8, vst0 = v_st(sr, sc), vst1 = v_st(32 + sr, sc);
  const int vb0 = (int)(uintptr_t)V_lds + v_rd_base(lane);
  struct { bf16x8 vs0, vs1, ks0, ks1; } sr_[2];
#define SLOAD(i, k0) do { sr_[i].vs0 = *reinterpret_cast<const bf16x8*>(&Vh[(long)((k0) + sr) * LDK + sc]); sr_[i].vs1 = *reinterpret_cast<const bf16x8*>(&Vh[(long)((k0) + 32 + sr) * LDK + sc]); \
    sr_[i].ks0 = *reinterpret_cast<const bf16x8*>(&Kh[(long)((k0) + sr) * LDK + sc]); sr_[i].ks1 = *reinterpret_cast<const bf16x8*>(&Kh[(long)((k0) + 32 + sr) * LDK + sc]); } while (0)
#define SWRITE(b, i) do { *(bf16x8*)((char*)V_lds + (b) * SHM_V + vst0) = sr_[i].vs0;          \
    *(bf16x8*)((char*)V_lds + (b) * SHM_V + vst1) = sr_[i].vs1; int kc = sc * 2;               \
    *(bf16x8*)((char*)K_lds + (b) * SHM_K + KSWZ(sr, kc)) = sr_[i].ks0;                       \
    *(bf16x8*)((char*)K_lds + (b) * SHM_K + KSWZ(32 + sr, kc)) = sr_[i].ks1; } while (0)
#define SWAIT() asm volatile("s_waitcnt vmcnt(4)" ::: "memory")
#define PSM(P0, P1, MN, AL) do { if constexpr (FAST) { partialSM_fast(P0); AL = 1.f; MN = 0.f; } else partialSM(P0, P1, m_reg, MN, AL); } while (0)
#define RESC(a) do { if constexpr (!FAST) if (__any((a) < 1.f)) { if (hi == 0) al_l[r32] = (a); asm volatile("s_waitcnt lgkmcnt(0)" ::: "memory"); \
    _Pragma("unroll") for (int d = 0; d < 4; ++d) _Pragma("unroll") for (int r = 0; r < 16; ++r) o[d][r] *= al_l[crow(r, hi)]; } } while (0)
  f32x16 pA0, pA1, pB0, pB1; float mnA, mnB, alA, alB; bf16x8 pa0, pa1, pa2, pa3; const int NT = seq / KVBLK;
  constexpr int SE = 0, SO = 1;
  SLOAD(SE, 0); asm volatile("s_waitcnt vmcnt(0)" ::: "memory"); SWRITE(0, SE); __syncthreads();
  qkt<ND0>(pA0, pA1, K_lds, qr, r32, hi, d0b); PSM(pA0, pA1, mnA, alA);
  SLOAD(SO, KVBLK); if (2 < NT) SLOAD(SE, 2 * KVBLK);
  SWAIT(); SWRITE(1, SO); __syncthreads();
  for (int j = 1; j + 1 < NT; j += 2) {
    SBAR(); qkt<ND0>(pB0, pB1, (bf16*)((char*)K_lds + SHM_K), qr, r32, hi, d0b);
    finishSM(pA0, pA1, alA, l_reg, pa0, pa1, pa2, pa3); SBAR();
    SLOAD(SO, (j + 2) * KVBLK); SBAR();
    pv_d0(o, vb0, pa0, pa1, pa2, pa3); PSM(pB0, pB1, mnB, alB);
    __syncthreads(); SWAIT(); SWRITE(0, SE);
    RESC(alB); __syncthreads();
    SBAR(); qkt<ND0>(pA0, pA1, K_lds, qr, r32, hi, d0b);
    finishSM(pB0, pB1, alB, l_reg, pa0, pa1, pa2, pa3); SBAR();
    if (j + 3 < NT) SLOAD(SE, (j + 3) * KVBLK); SBAR();
    pv_d0(o, vb0 + (int)SHM_V, pa0, pa1, pa2, pa3); PSM(pA0, pA1, mnA, alA);
    __syncthreads(); SWAIT(); SWRITE(1, SO);
    RESC(alA); __syncthreads();
  }
  SBAR(); qkt<ND0>(pB0, pB1, (bf16*)((char*)K_lds + SHM_K), qr, r32, hi, d0b);
  finishSM(pA0, pA1, alA, l_reg, pa0, pa1, pa2, pa3); SBAR();
  pv_d0(o, vb0, pa0, pa1, pa2, pa3); PSM(pB0, pB1, mnB, alB);
  __syncthreads(); RESC(alB);
  finishSM(pB0, pB1, alB, l_reg, pa0, pa1, pa2, pa3); SBAR();
  pv_d0(o, vb0 + (int)SHM_V, pa0, pa1, pa2, pa3);
  if (hi == 0) li_l[r32] = l_reg; asm volatile("s_waitcnt lgkmcnt(0)" ::: "memory");
  float rli[16];
#pragma unroll
  for (int r = 0; r < 16; ++r) rli[r] = __builtin_amdgcn_rcpf(li_l[crow(r, hi)]);
  bf16* Ow = Ob + (long)(wid * QBLK) * LDO;
#pragma unroll
  for (int r = 0; r < 16; ++r) { int orow = crow(r, hi);
#pragma unroll
    for (int d0 = 0; d0 < 4; ++d0) Ow[(long)orow * LDO + d0 * 32 + r32] = (bf16)(cvtpk(o[d0][r] * rli[r], 0.f) & 0xffffu); }
  __syncthreads();
#undef SLOAD
#undef SWRITE
#undef SWAIT
#undef RESC
#undef PSM
}
template <int LDQ, int LDK, int LDO, int ND0, bool FAST>
__device__ __forceinline__ void attn_stag_body(const bf16* Qb, const bf16* Kh, const bf16* Vh, bf16* Ob, int seq, int d0b, char* lds, int tid_in) {
  int tid_ = tid_in; asm volatile("" : "+v"(tid_));
  const int tid = tid_, wid = __builtin_amdgcn_readfirstlane(tid >> 6), lane = tid & 63, r32 = lane & 31, hi = lane >> 5, half = wid >> 2, ht = tid & 255;
  bf16* V_lds = (bf16*)lds; bf16* K_lds = (bf16*)(lds + 2 * SHM_V);
  float* ws = (float*)(lds + 2 * SHM_V + 2 * SHM_K) + wid * 64; float* li_l = ws; float* al_l = ws + 32;
  float m_reg = -1e30f, l_reg = 0; f32x16 o[4] = {}; bf16x8 qr[ND0];
  const bf16* Qw = Qb + (long)(wid * QBLK + r32) * LDQ + hi * 8 + d0b * 16;
#pragma unroll
  for (int d0 = 0; d0 < ND0; ++d0) qr[d0] = *reinterpret_cast<const bf16x8*>(Qw + d0 * 16);
  const bf16* Sh = half ? Vh : Kh; int soff[4]; long goff[4];
#pragma unroll
  for (int i = 0; i < 4; ++i) { const int idx = ht + 256 * i, row = idx >> 4, ch = idx & 15; goff[i] = (long)row * LDK + ch * 8;
    soff[i] = half ? v_st(row, ch * 8) : (int)(2 * SHM_V) + KSWZ(row, ch * 16); }
  const int vb0 = (int)(uintptr_t)V_lds + v_rd_base(lane);
  bf16x8 sg0[4], sg1[4];
#define GLOAD(SG, k0) do { _Pragma("unroll") for (int i = 0; i < 4; ++i) SG[i] = *reinterpret_cast<const bf16x8*>(Sh + (long)(k0) * LDK + goff[i]); } while (0)
#define LWRITE(b, SG) do { _Pragma("unroll") for (int i = 0; i < 4; ++i) *(bf16x8*)(lds + (b) * (int)SHM_V + soff[i]) = SG[i]; } while (0)
#define XBAR() do { asm volatile("s_waitcnt lgkmcnt(0)" ::: "memory"); __builtin_amdgcn_s_barrier(); asm volatile("" ::: "memory"); } while (0)
#define RESC(a) do { if constexpr (!FAST) if (__any((a) < 1.f)) { if (hi == 0) al_l[r32] = (a); asm volatile("s_waitcnt lgkmcnt(0)" ::: "memory"); \
    _Pragma("unroll") for (int d = 0; d < 4; ++d) _Pragma("unroll") for (int r = 0; r < 16; ++r) o[d][r] *= al_l[crow(r, hi)]; } } while (0)
  f32x16 p0, p1; float mn, al; bf16x8 pa0, pa1, pa2, pa3; const int NT = seq / KVBLK;
  GLOAD(sg0, 0); LWRITE(0, sg0); GLOAD(sg1, KVBLK); if (2 < NT) GLOAD(sg0, 2 * KVBLK);
  XBAR();
  if (half == 1) __builtin_amdgcn_s_barrier();
#define TILE(J, BUF, SGN, SGNN) do { \
    SBAR(); qkt<ND0>(p0, p1, (bf16*)((char*)K_lds + (BUF) * SHM_K), qr, r32, hi, d0b); SBAR(); \
    XBAR(); \
    if constexpr (FAST) { partialSM_fast(p0); al = 1.f; mn = 0.f; } else partialSM(p0, p1, m_reg, mn, al); \
    RESC(al); \
    finishSM(p0, p1, al, l_reg, pa0, pa1, pa2, pa3); \
    if ((J) + 1 < NT) { LWRITE((BUF) ^ 1, SGN); if ((J) + 3 < NT) GLOAD(SGN, ((J) + 3) * KVBLK); } \
    XBAR(); \
    SBAR(); pv_d0(o, vb0 + (BUF) * (int)SHM_V, pa0, pa1, pa2, pa3); SBAR(); \
    XBAR(); } while (0)
  for (int j = 0; j < NT; j += 2) { TILE(j, 0, sg1, sg1); TILE(j + 1, 1, sg0, sg0); }
#undef TILE
  if (half == 0) __builtin_amdgcn_s_barrier();
  if (hi == 0) li_l[r32] = l_reg; asm volatile("s_waitcnt lgkmcnt(0)" ::: "memory");
  float rli[16];
#pragma unroll
  for (int r = 0; r < 16; ++r) rli[r] = __builtin_amdgcn_rcpf(li_l[crow(r, hi)]);
  bf16* Ow = Ob + (long)(wid * QBLK) * LDO;
#pragma unroll
  for (int r = 0; r < 16; ++r) { int orow = crow(r, hi);
#pragma unroll
    for (int d0 = 0; d0 < 4; ++d0) Ow[(long)orow * LDO + d0 * 32 + r32] = (bf16)(cvtpk(o[d0][r] * rli[r], 0.f) & 0xffffu); }
  __syncthreads();
#undef GLOAD
#undef LWRITE
#undef XBAR
#undef RESC
}
constexpr size_t DMA_K0 = 0, DMA_V0 = 3 * SHM_K, DMA_WS = 3 * SHM_K + 4 * SHM_V, SHM_ATTN_DMA = DMA_WS + NW * 64 * 4;
template <int LDQ, int LDK, int LDO, int ND0, bool FAST>
__device__ __forceinline__ void attn_dma_body(const bf16* Qb, const bf16* Kh, const bf16* Vh, bf16* Ob, int seq, int d0b, char* lds, int tid_in, unsigned* qhead, volatile __attribute__((address_space(3))) unsigned* qslot) {
  int tid_ = tid_in; asm volatile("" : "+v"(tid_));
  const int tid = tid_, wid = __builtin_amdgcn_readfirstlane(tid >> 6), lane = tid & 63, r32 = lane & 31, hi = lane >> 5;
  bf16* K_lds = (bf16*)(lds + DMA_K0); bf16* V_lds = (bf16*)(lds + DMA_V0);
  float* ws = (float*)(lds + DMA_WS) + wid * 64; float* li_l = ws; float* al_l = ws + 32;
  float m_reg = -1e30f, l_reg = 0; f32x16 o[4] = {}; bf16x8 qr[ND0];
  const bf16* Qw = Qb + (long)(wid * QBLK + r32) * LDQ + hi * 8 + d0b * 16;
#pragma unroll
  for (int d0 = 0; d0 < ND0; ++d0) qr[d0] = *reinterpret_cast<const bf16x8*>(Qw + d0 * 16);
  long kso[2], vso[2];
#pragma unroll
  for (int i = 0; i < 2; ++i) { const int c = 2 * wid + i;
    { const int row = 4 * c + (lane >> 4), colB = ((lane & 15) * 16) ^ ((row & 7) << 4); kso[i] = (long)row * LDK + (colB >> 1); }
    { const int st = 2 * c + (lane >> 5), kk = (st >> 2) * 8 + ((lane & 31) >> 2), k = kk  , col = (st & 3) * 32 + (lane & 3) * 8; vso[i] = (long)k * LDK + col; } }
  const int vb0 = (int)(uintptr_t)V_lds + v_rd_base(lane);
#define LDSP(off) ((__attribute__((address_space(3))) unsigned*)(uintptr_t)(unsigned)(uintptr_t)(lds + (off)))
#define DMA(T, KS, VS) do { const long tb_ = (long)(T) * KVBLK * LDK; _Pragma("unroll") for (int i = 0; i < 2; ++i) { \
      __builtin_amdgcn_global_load_lds((const unsigned*)(Kh + tb_ + kso[i]), LDSP(DMA_K0 + (KS) * SHM_K + (2 * wid + i) * 1024), 16, 0, 0); \
      __builtin_amdgcn_global_load_lds((const unsigned*)(Vh + tb_ + vso[i]), LDSP(DMA_V0 + (VS) * SHM_V + (2 * wid + i) * 1024), 16, 0, 0); } } while (0)
#define XBAR() do { asm volatile("s_waitcnt lgkmcnt(0)" ::: "memory"); __builtin_amdgcn_s_barrier(); asm volatile("" ::: "memory"); } while (0)
#define PSM(P0, P1, MN, AL) do { if constexpr (FAST) { partialSM_fast(P0); AL = 1.f; MN = 0.f; } else partialSM(P0, P1, m_reg, MN, AL); } while (0)
#define RESC(a) do { if constexpr (!FAST) if (__any((a) < 1.f)) { if (hi == 0) al_l[r32] = (a); asm volatile("s_waitcnt lgkmcnt(0)" ::: "memory"); \
    _Pragma("unroll") for (int d = 0; d < 4; ++d) _Pragma("unroll") for (int r = 0; r < 16; ++r) o[d][r] *= al_l[crow(r, hi)]; } } while (0)
  f32x16 pA0, pA1, pB0, pB1; float mnA, mnB, alA, alB; bf16x8 pa0, pa1, pa2, pa3; const int NT = seq / KVBLK;
  DMA(0, 0, 0); DMA(1, 1, 1);
  asm volatile("s_waitcnt vmcnt(4)" ::: "memory"); XBAR();
  qkt<ND0>(pA0, pA1, K_lds, qr, r32, hi, d0b); PSM(pA0, pA1, mnA, alA);
  if (2 < NT) { DMA(2, 2, 2); asm volatile("s_waitcnt vmcnt(4)" ::: "memory"); } else asm volatile("s_waitcnt vmcnt(0)" ::: "memory");
  XBAR();
  int kb = 1, vbi = 1;
#define QKC(C, P0, P1, KS) do { _Pragma("unroll") for (int dd_ = 0; dd_ < ND0 / 4; ++dd_) { const int d0_ = (C) * (ND0 / 4) + dd_; const int cb_ = ((d0b + d0_) * 16 + hi * 8) * 2; \
      const bf16x8 b0_ = *reinterpret_cast<const bf16x8*>((const char*)(KS) + KSWZ(r32, cb_)); const bf16x8 b1_ = *reinterpret_cast<const bf16x8*>((const char*)(KS) + KSWZ(32 + r32, cb_)); \
      P0 = __builtin_amdgcn_mfma_f32_32x32x16_bf16(b0_, qr[d0_], P0, 0, 0, 0); P1 = __builtin_amdgcn_mfma_f32_32x32x16_bf16(b1_, qr[d0_], P1, 0, 0, 0); } } while (0)
#define PK8(P, BASE, OUT) do { u32x4 w_ = {cvtpk(P[BASE + 0], P[BASE + 1]), cvtpk(P[BASE + 2], P[BASE + 3]), cvtpk(P[BASE + 4], P[BASE + 5]), cvtpk(P[BASE + 6], P[BASE + 7])}; OUT = *reinterpret_cast<bf16x8*>(&w_); } while (0)
#define STEP(PC0, PC1, MNC, ALC, PP0, PP1, ALP, KS, VB, DMA_STMT) do { \
    if constexpr (FAST) { \
      float q0_ = 0.f, q1_ = 0.f, q2_ = 0.f, q3_ = 0.f; PC0 = f32x16{}; PC1 = f32x16{}; \
      SBAR(); QKC(0, PC0, PC1, KS); \
      _Pragma("unroll") for (int r_ = 0; r_ < 8; ++r_) PP1[r_] = __builtin_amdgcn_exp2f(PP1[r_]); \
      _Pragma("unroll") for (int r_ = 0; r_ < 16; r_ += 4) { q0_ += PP0[r_]; q1_ += PP0[r_ + 1]; q2_ += PP0[r_ + 2]; q3_ += PP0[r_ + 3]; } \
      asm volatile("" : "+v"(q0_), "+v"(q1_), "+v"(q2_), "+v"(q3_));     \
      SBAR(); QKC(1, PC0, PC1, KS); \
      _Pragma("unroll") for (int r_ = 8; r_ < 16; ++r_) PP1[r_] = __builtin_amdgcn_exp2f(PP1[r_]); \
      PK8(PP0, 0, pa0); PK8(PP0, 8, pa1); asm volatile("" : "+v"(pa0), "+v"(pa1)); \
      SBAR(); QKC(2, PC0, PC1, KS); \
      _Pragma("unroll") for (int r_ = 0; r_ < 16; r_ += 4) { q0_ += PP1[r_]; q1_ += PP1[r_ + 1]; q2_ += PP1[r_ + 2]; q3_ += PP1[r_ + 3]; } \
      asm volatile("" : "+v"(q0_), "+v"(q1_), "+v"(q2_), "+v"(q3_)); \
      SBAR(); QKC(3, PC0, PC1, KS); \
      PK8(PP1, 0, pa2); PK8(PP1, 8, pa3); asm volatile("" : "+v"(pa2), "+v"(pa3)); \
      { float ps_ = (q0_ + q1_) + (q2_ + q3_); auto rr_ = __builtin_amdgcn_permlane32_swap(__float_as_uint(ps_), __float_as_uint(ps_), false, false); l_reg += __uint_as_float(rr_[0]) + __uint_as_float(rr_[1]); } \
      SBAR(); DMA_STMT; SBAR(); \
      { VFrag A_, B_; const int vb_ = (VB); tr8<0>(A_, vb_); tr8<1>(B_, vb_); \
        asm volatile("s_waitcnt lgkmcnt(8)" ::: "memory"); SBAR(); mma4(o[0], A_, pa0, pa1, pa2, pa3); \
        _Pragma("unroll") for (int r_ = 0; r_ < 4; ++r_) PC0[r_] = __builtin_amdgcn_exp2f(PC0[r_]); \
        SBAR(); tr8<2>(A_, vb_); asm volatile("s_waitcnt lgkmcnt(8)" ::: "memory"); SBAR(); mma4(o[1], B_, pa0, pa1, pa2, pa3); \
        _Pragma("unroll") for (int r_ = 4; r_ < 8; ++r_) PC0[r_] = __builtin_amdgcn_exp2f(PC0[r_]); \
        SBAR(); tr8<3>(B_, vb_); asm volatile("s_waitcnt lgkmcnt(8)" ::: "memory"); SBAR(); mma4(o[2], A_, pa0, pa1, pa2, pa3); \
        _Pragma("unroll") for (int r_ = 8; r_ < 12; ++r_) PC0[r_] = __builtin_amdgcn_exp2f(PC0[r_]); \
        SBAR(); asm volatile("s_waitcnt lgkmcnt(0)" ::: "memory"); SBAR(); mma4(o[3], B_, pa0, pa1, pa2, pa3); \
        _Pragma("unroll") for (int r_ = 12; r_ < 16; ++r_) PC0[r_] = __builtin_amdgcn_exp2f(PC0[r_]); } \
      ALC = 1.f; MNC = 0.f; \
    } else { \
      SBAR(); qkt<ND0>(PC0, PC1, (bf16*)(KS), qr, r32, hi, d0b); \
      finishSM_np(PP0, PP1, ALP, l_reg, pa0, pa1, pa2, pa3); SBAR(); \
      DMA_STMT; SBAR(); \
      pv_d0(o, (VB), pa0, pa1, pa2, pa3); partialSM(PC0, PC1, m_reg, MNC, ALC); \
      RESC(ALC); \
    } } while (0)
  for (int j = 1; j + 1 < NT; j += 2) {
    const int kb1 = kb == 2 ? 0 : kb + 1, kb2 = kb == 0 ? 2 : kb - 1;
    const int vp = (vbi + 3) & 3, v2 = (vbi + 2) & 3, v3 = (vbi + 3) & 3;
    STEP(pB0, pB1, mnB, alB, pA0, pA1, alA, (char*)K_lds + kb * SHM_K, vb0 + vp * (int)SHM_V, DMA(j + 2, kb2, v2));
    asm volatile("s_waitcnt vmcnt(4)" ::: "memory"); XBAR();
    STEP(pA0, pA1, mnA, alA, pB0, pB1, alB, (char*)K_lds + kb1 * SHM_K, vb0 + vbi * (int)SHM_V, if (j + 3 < NT) DMA(j + 3, kb, v3));
    if (j + 3 < NT) asm volatile("s_waitcnt vmcnt(4)" ::: "memory"); else asm volatile("s_waitcnt vmcnt(0)" ::: "memory");
    XBAR();
    kb = kb2; vbi = v2;
  }
  { const int vp = (vbi + 3) & 3;
  STEP(pB0, pB1, mnB, alB, pA0, pA1, alA, (char*)K_lds + kb * SHM_K, vb0 + vp * (int)SHM_V, (void)0);
  finishSM_np(pB0, pB1, alB, l_reg, pa0, pa1, pa2, pa3); SBAR();
  pv_d0(o, vb0 + vbi * (int)SHM_V, pa0, pa1, pa2, pa3); }
#undef STEP
#undef QKC
#undef PK8
  unsigned tk_ = 0u; if (tid == 0) tk_ = __hip_atomic_fetch_add(qhead, 1u, __ATOMIC_RELAXED, __HIP_MEMORY_SCOPE_AGENT);
  if (hi == 0) li_l[r32] = l_reg; asm volatile("s_waitcnt lgkmcnt(0)" ::: "memory");
  float rli[16];
#pragma unroll
  for (int r = 0; r < 16; ++r) rli[r] = __builtin_amdgcn_rcpf(li_l[crow(r, hi)]);
  bf16* Ow = Ob + (long)(wid * QBLK) * LDO;
#pragma unroll
  for (int r = 0; r < 16; ++r) { int orow = crow(r, hi);
#pragma unroll
    for (int d0 = 0; d0 < 4; ++d0) Ow[(long)orow * LDO + d0 * 32 + r32] = (bf16)(cvtpk(o[d0][r] * rli[r], 0.f) & 0xffffu); }
  if (tid == 0) qslot[0] = tk_;
  __syncthreads();
#undef LDSP
#undef DMA
#undef XBAR
#undef PSM
#undef RESC
}
#undef KSWZ
#undef SBAR
}
#define XB_TMO      128
#define XB_XCNT(j)  (256  + 64 * (j))
#define XB_XSUB(j)  (1280 + 64 * (j))
#define XB_XGEN(j)  (2304 + 64 * (j))
#define XB_TOP      3328
#define XB_TOPGEN   3392
#define XCD_BAR_WORDS 3456
#define XB_SPIN_CAP (1u << 22)
#define LAS __attribute__((address_space(3)))

__device__ __forceinline__ unsigned xb_ld(unsigned* p)              { return __hip_atomic_load(p, __ATOMIC_RELAXED, __HIP_MEMORY_SCOPE_AGENT); }
__device__ __forceinline__ unsigned xb_add(unsigned* p, unsigned v) { return __hip_atomic_fetch_add(p, v, __ATOMIC_RELAXED, __HIP_MEMORY_SCOPE_AGENT); }
__device__ __forceinline__ unsigned xb_xcc_id() { return (unsigned)__builtin_amdgcn_s_getreg((3 << 11) | 20) & 0xFu; }
#define XB_SPIN(cond, bar) do { unsigned _sp = 0; while (cond) { __builtin_amdgcn_s_sleep(1); \
    if ((++_sp & 255u) == 0u) { if (xb_ld(&(bar)[XB_TMO])) break; if (_sp > XB_SPIN_CAP) { atomicAdd(&(bar)[XB_TMO], 1u); break; } } } } while (0)

struct XcdBarrier {
    unsigned* bar; unsigned x;
    volatile LAS unsigned* st;
};

__device__ __forceinline__ XcdBarrier xcd_barrier_post(unsigned* bar, volatile LAS unsigned* st) {
    XcdBarrier b; b.bar = bar; b.x = xb_xcc_id(); b.st = st;
    if (threadIdx.x == 0) (void)xb_add(&bar[XB_XCNT(b.x)], 1u);
    return b;
}
__device__ __forceinline__ void xcd_barrier_complete(unsigned* bar, unsigned x, unsigned& nloc, unsigned& nx) {
    const unsigned G = gridDim.x * gridDim.y * gridDim.z;
    unsigned sum, cnt, mine, sp = 0u;
    for (;;) {
        sum = 0u; cnt = 0u; mine = 0u;
#pragma unroll
        for (unsigned j = 0; j < 16; ++j) { const unsigned c = xb_ld(&bar[XB_XCNT(j)]); sum += c; cnt += (c > 0u) ? 1u : 0u; mine = (j == x) ? c : mine; }
        if (sum == G) break;
        __builtin_amdgcn_s_sleep(1);
        if ((++sp & 255u) == 0u) { if (xb_ld(&bar[XB_TMO])) break; if (sp > XB_SPIN_CAP) { atomicAdd(&bar[XB_TMO], 1u); break; } }
    }
    nloc = mine > 0u ? mine : 1u; nx = cnt > 0u ? cnt : 1u;
}

__device__ __forceinline__ void xcd_barrier(const XcdBarrier& b, bool lead) {
    asm volatile("s_waitcnt vmcnt(0)" ::: "memory");
    __syncthreads();
    if (lead) {
        unsigned* bar = b.bar;
        __builtin_amdgcn_s_waitcnt(0);
        unsigned nloc = b.st[0], nx = b.st[1];
        if (nloc == 0u) { xcd_barrier_complete(bar, b.x, nloc, nx); b.st[0] = nloc; b.st[1] = nx; }
        const unsigned old = xb_add(&bar[XB_XSUB(b.x)], 1u);
        const unsigned gen = old / nloc;
        if (old + 1u == (gen + 1u) * nloc) {
            __builtin_amdgcn_fence(__ATOMIC_RELEASE, "agent");
            asm volatile("s_waitcnt vmcnt(0)" ::: "memory");
            const unsigned og = xb_add(&bar[XB_TOP], 1u);
            const unsigned tg = og / nx;
            __builtin_amdgcn_fence(__ATOMIC_ACQUIRE, "agent");
            if (og + 1u == (tg + 1u) * nx) xb_add(&bar[XB_TOPGEN], 1u);
            else XB_SPIN(xb_ld(&bar[XB_TOPGEN]) == tg, bar);
            xb_add(&bar[XB_XGEN(b.x)], 1u);
            asm volatile("s_waitcnt vmcnt(0)" ::: "memory");
        } else {
            __builtin_amdgcn_fence(__ATOMIC_ACQUIRE, "agent");
            XB_SPIN(xb_ld(&bar[XB_XGEN(b.x)]) == gen, bar);
            asm volatile("s_waitcnt vmcnt(0)" ::: "memory");
        }
    }
    __syncthreads();
}
#define DI __device__ __forceinline__
#define GAS __attribute__((address_space(1)))
typedef unsigned short bf16;
typedef float f32x4 __attribute__((ext_vector_type(4)));
typedef float f32x16 __attribute__((ext_vector_type(16)));
typedef short bf16x8 __attribute__((ext_vector_type(8)));
typedef unsigned u32x4 __attribute__((ext_vector_type(4)));
typedef unsigned u32x2 __attribute__((ext_vector_type(2)));
typedef GAS unsigned gu32;
using pg8::pk2; using pg8::bflo; using pg8::bfhi; using pg8::sigmoidf_;
#define MFMA32(a, b, c) __builtin_amdgcn_mfma_f32_32x32x16_bf16((a), (b), (c), 0, 0, 0)
#define RLX_AGENT __ATOMIC_RELAXED, __HIP_MEMORY_SCOPE_AGENT

constexpr int NWAVES = 8, NTHREADS = 512;
constexpr int DM = 2048, JR = 16384, NJOB = 3, NLAYER = 2, MALL = 49152;
constexpr int N_IN = 14880, NP1 = 8960, LDPJ = 8704, NGT = 6144, DFF = 5632, NUP = 11264, PLE = 256, NWIN = 15104;
constexpr int PJ_AQ = 0, PJ_AZ = 3072, PJ_BQ = 4096, PJ_BK = 5120, PJ_BV = 5376, PJ_CQ = 5632, PJ_CK = 6656, PJ_CV = 7680;
constexpr float EPS = 1e-6f;
constexpr int G1_UNIT_BYTES = 73728, G1_W = 0, G1_QD = 16384, G1_IN = 32768, G1_KD = 40960, G1_U = 57344, G1_STAGE = 57344;
constexpr size_t MiB = (size_t)1 << 20;
constexpr size_t WS_CTL = 0, CTL_ZERO_BYTES = 1 * MiB;
constexpr size_t WS_WIN = 1 * MiB, WS_WOA = 60 * MiB, WS_WOB = 64 * MiB, WS_WOC = 68 * MiB, WS_WOUT = 72 * MiB, WS_WUP = 80 * MiB, WS_WDOWN = 124 * MiB, WS_WPLE = 146 * MiB, WS_WPG = 147 * MiB;
constexpr size_t WS_HB = 156 * MiB, WS_AB = 220 * MiB, WS_PB = 222 * MiB, WS_GL = 230 * MiB, WS_SS2 = 231 * MiB, WS_OAF = 232 * MiB, WS_OAB = 264 * MiB, WS_OB = 296 * MiB, WS_OC2 = 328 * MiB, WS_OCP = 392 * MiB;
constexpr size_t WS_PJ = 424 * MiB, WS_G1 = 696 * MiB, WS_END = 984 * MiB;
constexpr size_t WS_GT = WS_G1, WS_MG = WS_HB, WS_U = WS_PJ, WS_ACT = WS_PJ + 352 * MiB, WS_PL = WS_OAF;
static_assert(pg8::CA_NUP == NUP && pg8::CA_DFF == DFF && pg8::CA_JR == JR, "conv epilogue constants");
static_assert(WS_WIN + (size_t)NWIN * DM * 2 <= WS_WOA && WS_WPG + 8 * MiB <= WS_HB && WS_G1 + (size_t)4096 * G1_UNIT_BYTES <= WS_END && WS_ACT + (size_t)JR * DFF * 2 <= WS_END && WS_PJ + (size_t)JR * LDPJ * 2 <= WS_G1, "ws map");
constexpr int CW_BAR = 4096, CW_Q = 16384;
constexpr int RING_BYTES = 131072, LDSCTL_OFF = RING_BYTES, MISC_OFF = LDSCTL_OFF + 320, LDS_BYTES = 147456;

DI float bf2f(bf16 b) { return __uint_as_float(((unsigned)b) << 16); }
DI bf16 f2bf(float f) { return (bf16)(pk2(f, 0.f) & 0xffffu); }
DI float wave_sum(float v) {
#pragma unroll
    for (int o = 1; o < 64; o <<= 1) v += __shfl_xor(v, o);
    return v;
}
DI float xchg32(float v, int lane) {
    const auto rr = __builtin_amdgcn_permlane32_swap(__float_as_uint(v), __float_as_uint(v), false, false);
    return __uint_as_float(lane < 32 ? rr[1] : rr[0]);
}
DI float silu_(float y) { return y * __builtin_amdgcn_rcpf(1.0f + __expf(-y)); }
DI float softplus_(float x) { return fmaxf(x, 0.f) + __logf(1.0f + __expf(-fabsf(x))); }
DI void sincos_(float ang, float& s, float& c) { const float n = rintf(ang * 0.15915494309189535f); float r = fmaf(-n, 6.2831854820251465f, ang); r = fmaf(-n, -1.7484556e-7f, r); s = __sinf(r); c = __cosf(r); }
DI int crow(int reg, int hh) { return (reg & 3) + 8 * (reg >> 2) + 4 * hh; }
template <int S> DI bf16x8 pack_step(const f32x16& x) {
    u32x4 p; p.x = pk2(x[8 * S + 0], x[8 * S + 1]); p.y = pk2(x[8 * S + 2], x[8 * S + 3]); p.z = pk2(x[8 * S + 4], x[8 * S + 5]); p.w = pk2(x[8 * S + 6], x[8 * S + 7]);
    return __builtin_bit_cast(bf16x8, p);
}

struct Args { const float* in[27]; float* out; unsigned char* ws; int l0, l1, j0, j1, ph_lo, ph_hi, one_launch, dbg; };
typedef const __attribute__((address_space(4))) Args CArgs;
struct Frame {
    LAS unsigned char* lds; volatile LAS unsigned* MISC; gu32* ctl;
    int tid, lane, wave, G, bid;
    unsigned char* ws;
};
struct JobGeo { int row0, nseq, seqlen; };
DI JobGeo job_geo(int job) { JobGeo g; g.row0 = job * JR; g.nseq = job == 0 ? 1 : 2; g.seqlen = job == 0 ? 16384 : 8192; return g; }
DI int up_dst(int sc) { return sc < DFF ? (sc >> 7) * 256 + (sc & 127) : ((sc - DFF) >> 7) * 256 + 128 + ((sc - DFF) & 127); }
DI int win_dst(int sc) {
    if (sc < 4096) return sc;
    if (sc < 4128) return 8704 + (sc - 4096);
    if (sc < 8736) return 4096 + (sc - 4128);
    return 8960 + (sc - 8736);
}
DI void transpose_item(const float* W, int K, int N, bf16* WT, int remap, LAS float* scr, int item, int lane, const float* gk = nullptr) {
    const int nblk = N / 32, kb = item / nblk, nb = item % nblk, k0 = 64 * kb, n0 = 32 * nb;
    float wv[32];
#pragma unroll
    for (int i = 0; i < 32; ++i) { const int kk = 2 * i + (lane >> 5); wv[i] = W[(size_t)(k0 + kk) * N + n0 + (lane & 31)]; }
#pragma unroll
    for (int i = 0; i < 32; ++i) { const int kk = 2 * i + (lane >> 5); scr[kk * 33 + (lane & 31)] = gk ? wv[i] * gk[k0 + kk] : wv[i]; }
    asm volatile("s_waitcnt lgkmcnt(0)" ::: "memory");
    const int c = lane & 7; const int d0 = remap == 1 ? win_dst(n0) : (remap == 2 ? up_dst(n0) : n0);
#pragma unroll
    for (int j = 0; j < 4; ++j) { const int n = (lane >> 3) + 8 * j; const LAS float* s = scr + (8 * c) * 33 + n;
        u32x4 o; o.x = pk2(s[0 * 33], s[1 * 33]); o.y = pk2(s[2 * 33], s[3 * 33]); o.z = pk2(s[4 * 33], s[5 * 33]); o.w = pk2(s[6 * 33], s[7 * 33]);
        *(u32x4*)(WT + (size_t)(d0 + n) * K + k0 + 8 * c) = o; }
    asm volatile("s_waitcnt lgkmcnt(0)" ::: "memory");
}
DI void phase_weights(Frame& F, CArgs* a, int layer) {
    LAS float* scr = (LAS float*)(F.lds + F.wave * 16384);
    const int gw = F.bid * NWAVES + F.wave, NGW = F.G * NWAVES;
    unsigned char* ws = F.ws;
    const float* w_in = a->in[5] + (size_t)layer * DM * N_IN;
    const float* w_oa = a->in[16] + (size_t)layer * 1024 * DM; const float* w_ob = a->in[17] + (size_t)layer * 1024 * DM; const float* w_oc = a->in[18] + (size_t)layer * 1024 * DM;
    const float* w_out = a->in[19] + (size_t)layer * DM * DM; const float* w_up = a->in[21] + (size_t)layer * DM * NUP; const float* w_down = a->in[24] + (size_t)layer * DFF * DM;
    const float* w_ple = a->in[25] + (size_t)layer * PLE * DM; const float* w_pg = a->in[26] + (size_t)layer * DM * DM;
    constexpr int I_IN = (DM / 64) * (N_IN / 32), I_O = (1024 / 64) * (DM / 32), I_OUT = (DM / 64) * (DM / 32), I_UP = (DM / 64) * (NUP / 32), I_DN = (DFF / 64) * (DM / 32), I_PLE = (PLE / 64) * (DM / 32);
    constexpr int NITEMS = I_IN + 3 * I_O + I_OUT + I_UP + I_DN + I_PLE + I_OUT;
    for (int it = gw; it < NITEMS; it += NGW) {
        int r = it;
        if (r < I_IN) { transpose_item(w_in, DM, N_IN, (bf16*)(ws + WS_WIN), 1, scr, r, F.lane); continue; } r -= I_IN;
        if (r < I_O) { transpose_item(w_oa, 1024, DM, (bf16*)(ws + WS_WOA), 0, scr, r, F.lane); continue; } r -= I_O;
        if (r < I_O) { transpose_item(w_ob, 1024, DM, (bf16*)(ws + WS_WOB), 0, scr, r, F.lane); continue; } r -= I_O;
        if (r < I_O) { transpose_item(w_oc, 1024, DM, (bf16*)(ws + WS_WOC), 0, scr, r, F.lane); continue; } r -= I_O;
        if (r < I_OUT) { transpose_item(w_out, DM, DM, (bf16*)(ws + WS_WOUT), 0, scr, r, F.lane); continue; } r -= I_OUT;
        if (r < I_UP) { transpose_item(w_up, DM, NUP, (bf16*)(ws + WS_WUP), 2, scr, r, F.lane); continue; } r -= I_UP;
        if (r < I_DN) { transpose_item(w_down, DFF, DM, (bf16*)(ws + WS_WDOWN), 0, scr, r, F.lane); continue; } r -= I_DN;
        if (r < I_PLE) { transpose_item(w_ple, PLE, DM, (bf16*)(ws + WS_WPLE), 0, scr, r, F.lane); continue; } r -= I_PLE;
        transpose_item(w_pg, DM, DM, (bf16*)(ws + WS_WPG), 0, scr, r, F.lane);
    }
    u32x4* z = (u32x4*)((bf16*)(ws + WS_WIN) + (size_t)8736 * DM);
    unsigned zz = 0u; asm volatile("" : "+v"(zz));
    for (int i = F.bid * NTHREADS + F.tid; i < 224 * DM / 8; i += F.G * NTHREADS) z[i] = (u32x4){zz, zz, zz, zz};
}
DI void rms_row_2048(const float* xrow, const float* g, bf16* orow, int lane) {
    const f32x4* xr = (const f32x4*)xrow + lane; f32x4 v[8]; float s = 0.f;
#pragma unroll
    for (int j = 0; j < 8; ++j) { v[j] = xr[64 * j]; s += (v[j].x * v[j].x + v[j].y * v[j].y) + (v[j].z * v[j].z + v[j].w * v[j].w); }
    const float r = rsqrtf(wave_sum(s) * (1.f / DM) + EPS);
    const f32x4* gr = (const f32x4*)g + lane; u32x2* o8 = (u32x2*)orow + lane;
#pragma unroll
    for (int j = 0; j < 8; ++j) { const f32x4 gg = gr[64 * j]; u32x2 w; w.x = pk2(v[j].x * r * gg.x, v[j].y * r * gg.y); w.y = pk2(v[j].z * r * gg.z, v[j].w * r * gg.w); o8[64 * j] = w; }
}
DI void rms_row_2048_b(const bf16* xrow, const float* g, bf16* orow, int lane) {
    const u32x4* xr = (const u32x4*)xrow + lane; u32x4 v[4]; float s = 0.f;
#pragma unroll
    for (int j = 0; j < 4; ++j) { v[j] = xr[64 * j];
#pragma unroll
        for (int k = 0; k < 4; ++k) { const float a = bflo(v[j][k]), b = bfhi(v[j][k]); s += a * a + b * b; } }
    const float r = rsqrtf(wave_sum(s) * (1.f / DM) + EPS);
    const f32x4* gr = (const f32x4*)g + 2 * lane; u32x4* o8 = (u32x4*)orow + lane;
#pragma unroll
    for (int j = 0; j < 4; ++j) { const f32x4 g0 = gr[128 * j], g1 = gr[128 * j + 1]; u32x4 w;
        w.x = pk2(bflo(v[j].x) * r * g0.x, bfhi(v[j].x) * r * g0.y); w.y = pk2(bflo(v[j].y) * r * g0.z, bfhi(v[j].y) * r * g0.w);
        w.z = pk2(bflo(v[j].z) * r * g1.x, bfhi(v[j].z) * r * g1.y); w.w = pk2(bflo(v[j].w) * r * g1.z, bfhi(v[j].w) * r * g1.w); o8[64 * j] = w; }
}
DI void phase_rms_b(Frame& F, const bf16* X, const float* g, bf16* HB) {
    const int gw = F.bid * NWAVES + F.wave, NGW = F.G * NWAVES;
    for (int m = gw; m < JR; m += NGW) rms_row_2048_b(X + (size_t)m * DM, g, HB + (size_t)m * DM, F.lane);
}
DI void phase_rms(Frame& F, const float* X, const float* g, bf16* HB) {
    const int gw = F.bid * NWAVES + F.wave, NGW = F.G * NWAVES;
    for (int m = gw; m < JR; m += NGW) rms_row_2048(X + (size_t)m * DM, g, HB + (size_t)m * DM, F.lane);
}
DI void prepB_math(float& a, float& b, const float ga, const float gb, float cr, float sr, float cc, float sc, int lane, float osc) {
    const float r = rsqrtf(wave_sum(a * a + b * b) * (1.f / 128.f) + EPS);
    a = a * r * ga; b = b * r * gb;
    const float pa = __shfl_xor(a, 32), pb = __shfl_xor(b, 32);
    a = (lane < 32 ? a * cr - pa * sr : a * cr + pa * sr) * osc;
    b = (lane < 32 ? b * cc - pb * sc : b * cc + pb * sc) * osc;
}
DI void prepC_math(float& a, float& b, const float g, float c, float s, int lane, float osc) {
    const float ra = rsqrtf(wave_sum(a * a) * (1.f / 64.f) + EPS), rb = rsqrtf(wave_sum(b * b) * (1.f / 64.f) + EPS);
    a = a * ra * g; b = b * rb * g;
    const float pa = __shfl_xor(a, 8), pb = __shfl_xor(b, 8);
    if (lane < 16) { a = lane < 8 ? a * c - pa * s : a * c + pa * s; b = lane < 8 ? b * c - pb * s : b * c + pb * s; }
    a *= osc; b *= osc;
}
template <int CTRL, int BANK> DI float dpp_f(float old, float v) { return __builtin_bit_cast(float, __builtin_amdgcn_update_dpp(__builtin_bit_cast(int, old), __builtin_bit_cast(int, v), CTRL, 0xF, BANK, false)); }
#define DPP_XOR1(v) __builtin_bit_cast(float, __builtin_amdgcn_update_dpp(0, __builtin_bit_cast(int, (v)), 0xB1, 0xF, 0xF, false))
#define DPP_XOR2(v) __builtin_bit_cast(float, __builtin_amdgcn_update_dpp(0, __builtin_bit_cast(int, (v)), 0x4E, 0xF, 0xF, false))
#define DPP_HMIR(v) __builtin_bit_cast(float, __builtin_amdgcn_update_dpp(0, __builtin_bit_cast(int, (v)), 0x141, 0xF, 0xF, false))
#define DPP_MIR(v)  __builtin_bit_cast(float, __builtin_amdgcn_update_dpp(0, __builtin_bit_cast(int, (v)), 0x140, 0xF, 0xF, false))
DI void phase_prep(Frame& F, CArgs* a, int layer, bf16* PJ, const JobGeo& jg) {
    const int gw = F.bid * NWAVES + F.wave, NGW = F.G * NWAVES, lane = F.lane, hs = lane >> 4, sub = lane & 15, s7 = sub & 7;
    const float* qn_b = a->in[10] + layer * 128; const float* kn_b = a->in[11] + layer * 128; const float* qn_c = a->in[12] + layer * 64; const float* kn_c = a->in[13] + layer * 64;
    constexpr float QSB = 0.088388347648318440f * 1.4426950408889634f, QSC = 0.125f * 1.4426950408889634f;
    float gqb[8], gkb[8], gqc[8], gkc[8], invB[8], invC[8];
#pragma unroll
    for (int k = 0; k < 8; ++k) { gqb[k] = qn_b[sub * 8 + k] * QSB; gkb[k] = kn_b[sub * 8 + k]; gqc[k] = qn_c[s7 * 8 + k] * QSC; gkc[k] = kn_c[s7 * 8 + k];
        invB[k] = exp2f(-(float)(2 * ((sub & 3) * 8 + k)) * (13.287712379549449f / 64.f));
        invC[k] = exp2f(-(float)(2 * k) * (18.931568569324174f / 16.f)); }
    const bool b_second = s7 >= 4;
    const bool c_rot = s7 < 2, c_second = (s7 & 1) != 0;
    for (int m = gw; m < JR; m += NGW) {
        const int pos = m % jg.seqlen; bf16* row = PJ + (size_t)m * LDPJ;
        u32x4 xb[3], xc[4];
#pragma unroll
        for (int g = 0; g < 3; ++g) { const int h = 4 * g + hs; xb[g] = *(const u32x4*)(row + PJ_BQ + (h < 10 ? h : 9) * 128 + sub * 8); }
#pragma unroll
        for (int g = 0; g < 4; ++g) xc[g] = *(const u32x4*)(row + PJ_CQ + (4 * g + hs) * 128 + sub * 8);
        float cB[8], sB[8], cC[8], sC[8]; const float angB = (float)((sub >> 3) ? (pos & 63) : (pos >> 6)), angC = (float)pos;
#pragma unroll
        for (int k = 0; k < 8; ++k) { sincos_(angB * invB[k], sB[k], cB[k]); sincos_(angC * invC[k], sC[k], cC[k]); if (!b_second) sB[k] = -sB[k]; if (!c_second) sC[k] = -sC[k]; }
#pragma unroll
        for (int g = 0; g < 3; ++g) {
            float x[8];
#pragma unroll
            for (int k = 0; k < 4; ++k) { x[2 * k] = bflo(xb[g][k]); x[2 * k + 1] = bfhi(xb[g][k]); }
            float sq = 0.f;
#pragma unroll
            for (int k = 0; k < 8; ++k) sq += x[k] * x[k];
            sq += DPP_XOR1(sq); sq += DPP_XOR2(sq); sq += DPP_HMIR(sq); sq += DPP_MIR(sq);
            const float r = rsqrtf(sq * (1.f / 128.f) + EPS);
            float o8[8];
#pragma unroll
            for (int k = 0; k < 8; ++k) { const float y = x[k] * r * (g < 2 ? gqb[k] : gkb[k]);
                float pr = dpp_f<0x104, 0x5>(0.f, y); pr = dpp_f<0x114, 0xA>(pr, y);
                o8[k] = y * cB[k] + pr * sB[k]; }
            const int h = 4 * g + hs;
            if (h < 10) { u32x4 w; w.x = pk2(o8[0], o8[1]); w.y = pk2(o8[2], o8[3]); w.z = pk2(o8[4], o8[5]); w.w = pk2(o8[6], o8[7]); *(u32x4*)(row + PJ_BQ + h * 128 + sub * 8) = w; }
        }
#pragma unroll
        for (int g = 0; g < 4; ++g) {
            float x[8];
#pragma unroll
            for (int k = 0; k < 4; ++k) { x[2 * k] = bflo(xc[g][k]); x[2 * k + 1] = bfhi(xc[g][k]); }
            float sq = 0.f;
#pragma unroll
            for (int k = 0; k < 8; ++k) sq += x[k] * x[k];
            sq += DPP_XOR1(sq); sq += DPP_XOR2(sq); sq += DPP_HMIR(sq);
            const float r = rsqrtf(sq * (1.f / 64.f) + EPS);
            float o8[8];
#pragma unroll
            for (int k = 0; k < 8; ++k) { const float y = x[k] * r * (g < 2 ? gqc[k] : gkc[k]); const float pr = DPP_XOR1(y); o8[k] = c_rot ? y * cC[k] + pr * sC[k] : y; }
            u32x4 w; w.x = pk2(o8[0], o8[1]); w.y = pk2(o8[2], o8[3]); w.z = pk2(o8[4], o8[5]); w.w = pk2(o8[6], o8[7]);
            *(u32x4*)(row + PJ_CQ + (4 * g + hs) * 128 + sub * 8) = w;
        }
    }
}
DI void phase_gdn_post(Frame& F, CArgs* a, int layer, bf16* OAF, const bf16* OAB, const bf16* PJ) {
    const int gw = F.bid * NWAVES + F.wave, NGW = F.G * NWAVES, hs = F.lane >> 4, sub = F.lane & 15; const float* nw = a->in[9] + layer * 128;
    float gn[8];
#pragma unroll
    for (int k = 0; k < 8; ++k) gn[k] = nw[sub * 8 + k];
    for (int m = gw; m < JR; m += NGW) {
        u32x4 wf[2], wb[2], wz[2];
#pragma unroll
        for (int g = 0; g < 2; ++g) { const int h = 4 * g + hs; wf[g] = *(const u32x4*)(OAF + (size_t)m * 1024 + h * 128 + sub * 8); wb[g] = *(const u32x4*)(OAB + (size_t)m * 1024 + h * 128 + sub * 8);
            wz[g] = *(const u32x4*)(PJ + (size_t)m * LDPJ + PJ_AZ + h * 128 + sub * 8); }
#pragma unroll
        for (int g = 0; g < 2; ++g) { float x[8], z[8];
#pragma unroll
            for (int k = 0; k < 4; ++k) { x[2 * k] = bflo(wf[g][k]) + bflo(wb[g][k]); x[2 * k + 1] = bfhi(wf[g][k]) + bfhi(wb[g][k]); z[2 * k] = bflo(wz[g][k]); z[2 * k + 1] = bfhi(wz[g][k]); }
            float sq = 0.f;
#pragma unroll
            for (int k = 0; k < 8; ++k) sq += x[k] * x[k];
            sq += DPP_XOR1(sq); sq += DPP_XOR2(sq); sq += DPP_HMIR(sq); sq += DPP_MIR(sq);
            const float r = rsqrtf(sq * (1.f / 128.f) + EPS);
            u32x4 w;
#pragma unroll
            for (int k = 0; k < 4; ++k) w[k] = pk2(x[2 * k] * r * gn[2 * k] * silu_(z[2 * k]), x[2 * k + 1] * r * gn[2 * k + 1] * silu_(z[2 * k + 1]));
            *(u32x4*)(OAF + (size_t)m * 1024 + (4 * g + hs) * 128 + sub * 8) = w; }
    }
}
DI void phase_diff_combine(Frame& F, CArgs* a, int layer, const bf16* OC2, bf16* OCP) {
    const int gw = F.bid * NWAVES + F.wave, NGW = F.G * NWAVES, hs = F.lane >> 4, sub = F.lane & 15;
    const float* lm = a->in[14] + layer * 256; const float* sub_g = a->in[15] + layer * 128;
    const float l01 = wave_sum(lm[F.lane] * lm[64 + F.lane]), l23 = wave_sum(lm[128 + F.lane] * lm[192 + F.lane]);
    const float linit = 0.8f - 0.6f * __expf(-0.3f * (float)layer), lam = __expf(l01) - __expf(l23) + linit, post = 1.f - linit;
    float gs[8];
#pragma unroll
    for (int k = 0; k < 8; ++k) gs[k] = sub_g[sub * 8 + k] * post;
    for (int m = gw; m < JR; m += NGW) {
        u32x4 w0[2], w1[2];
#pragma unroll
        for (int g = 0; g < 2; ++g) { const int h = 4 * g + hs; w0[g] = *(const u32x4*)(OC2 + (size_t)m * 2048 + (h * 2) * 128 + sub * 8); w1[g] = *(const u32x4*)(OC2 + (size_t)m * 2048 + (h * 2 + 1) * 128 + sub * 8); }
#pragma unroll
        for (int g = 0; g < 2; ++g) { float x[8];
#pragma unroll
            for (int k = 0; k < 4; ++k) { x[2 * k] = bflo(w0[g][k]) - lam * bflo(w1[g][k]); x[2 * k + 1] = bfhi(w0[g][k]) - lam * bfhi(w1[g][k]); }
            float sq = 0.f;
#pragma unroll
            for (int k = 0; k < 8; ++k) sq += x[k] * x[k];
            sq += DPP_XOR1(sq); sq += DPP_XOR2(sq); sq += DPP_HMIR(sq); sq += DPP_MIR(sq);
            const float r = rsqrtf(sq * (1.f / 128.f) + EPS);
            u32x4 w;
#pragma unroll
            for (int k = 0; k < 4; ++k) w[k] = pk2(x[2 * k] * r * gs[2 * k], x[2 * k + 1] * r * gs[2 * k + 1]);
            *(u32x4*)(OCP + (size_t)m * 1024 + (4 * g + hs) * 128 + sub * 8) = w; }
    }
}
DI void phase_conv_act(Frame& F, CArgs* a, int layer, const bf16* U, bf16* ACT, const JobGeo& jg) {
    const float* cw = a->in[22] + (size_t)layer * 3 * NUP; const float* cb = a->in[23] + (size_t)layer * NUP;
    constexpr int CPR = DFF / 8;
    for (int it = F.bid * NTHREADS + F.tid; it < (JR / 4) * CPR; it += F.G * NTHREADS) {
        const int m0 = (it / CPR) * 4, c = (it % CPR) * 8, pos0 = m0 % jg.seqlen;
        const bool okm = pos0 > 0, okp = pos0 + 4 < jg.seqlen;
        u32x4 xg[6], xv[6];
#pragma unroll
        for (int rr = 0; rr < 6; ++rr) { const int mr = m0 - 1 + rr; const int mc = (rr == 0 && !okm) ? m0 : ((rr == 5 && !okp) ? m0 + 3 : mr);
            xg[rr] = *(const u32x4*)(U + (size_t)mc * NUP + c); xv[rr] = *(const u32x4*)(U + (size_t)mc * NUP + DFF + c); }
        if (!okm) { xg[0] = xg[0] ^ xg[0]; xv[0] = xv[0] ^ xv[0]; }
        if (!okp) { xg[5] = xg[5] ^ xg[5]; xv[5] = xv[5] ^ xv[5]; }
        float acc[4][8];
#pragma unroll
        for (int half = 0; half < 2; ++half) { const int col = half * DFF + c;
            f32x4 w[3][2], bb[2];
#pragma unroll
            for (int tp = 0; tp < 3; ++tp) { w[tp][0] = *(const f32x4*)(cw + tp * NUP + col); w[tp][1] = *(const f32x4*)(cw + tp * NUP + col + 4); }
            bb[0] = *(const f32x4*)(cb + col); bb[1] = *(const f32x4*)(cb + col + 4);
#pragma unroll
            for (int rr = 0; rr < 4; ++rr)
#pragma unroll
                for (int k = 0; k < 4; ++k) { const unsigned wm = half ? xv[rr][k] : xg[rr][k], w0 = half ? xv[rr + 1][k] : xg[rr + 1][k], wp = half ? xv[rr + 2][k] : xg[rr + 2][k];
                    const int q = k >> 1, e = (2 * k) & 3;
                    const float yl = w[0][q][e] * bflo(wm) + w[1][q][e] * bflo(w0) + w[2][q][e] * bflo(wp) + bb[q][e];
                    const float yh = w[0][q][e + 1] * bfhi(wm) + w[1][q][e + 1] * bfhi(w0) + w[2][q][e + 1] * bfhi(wp) + bb[q][e + 1];
                    if (half == 0) { acc[rr][2 * k] = silu_(yl); acc[rr][2 * k + 1] = silu_(yh); } else { acc[rr][2 * k] *= yl; acc[rr][2 * k + 1] *= yh; } }
        }
#pragma unroll
        for (int rr = 0; rr < 4; ++rr) { u32x4 o; o.x = pk2(acc[rr][0], acc[rr][1]); o.y = pk2(acc[rr][2], acc[rr][3]); o.z = pk2(acc[rr][4], acc[rr][5]); o.w = pk2(acc[rr][6], acc[rr][7]);
            *(u32x4*)(ACT + ((size_t)(c >> 6) * JR + (m0 + rr)) * 64 + (c & 63)) = o; }
    }
}
DI void phase_conv_edges(Frame& F, CArgs* a, int layer, const bf16* UH, bf16* ACT, const JobGeo& jg) {
    const float* cw = a->in[22] + (size_t)layer * 3 * NUP; const float* cb = a->in[23] + (size_t)layer * NUP;
    constexpr int CPR = DFF / 8;
    for (int it = F.bid * NTHREADS + F.tid; it < 128 * CPR; it += F.G * NTHREADS) {
        const int e = it / CPR, c = (it % CPR) * 8, p = e >> 1, side = e & 1, row = 256 * p + (side ? 255 : 0), pos = row % jg.seqlen;
        const bool okm = pos > 0, okp = pos + 1 < jg.seqlen;
        const bf16* rm = side ? UH + (size_t)(p * 4 + 2) * NUP : UH + (size_t)((okm ? p - 1 : p) * 4 + 3) * NUP;
        const bf16* r0 = UH + (size_t)(p * 4 + (side ? 3 : 0)) * NUP;
        const bf16* rp = side ? UH + (size_t)((okp ? p + 1 : p) * 4 + 0) * NUP : UH + (size_t)(p * 4 + 1) * NUP;
        float acc[8];
#pragma unroll
        for (int half = 0; half < 2; ++half) { const int col = half * DFF + c;
            u32x4 xm = *(const u32x4*)(rm + col), x0 = *(const u32x4*)(r0 + col), xp = *(const u32x4*)(rp + col);
            if (!side && !okm) xm = xm ^ xm;
            if (side && !okp) xp = xp ^ xp;
            f32x4 w[3][2], bb[2];
#pragma unroll
            for (int tp = 0; tp < 3; ++tp) { w[tp][0] = *(const f32x4*)(cw + tp * NUP + col); w[tp][1] = *(const f32x4*)(cw + tp * NUP + col + 4); }
            bb[0] = *(const f32x4*)(cb + col); bb[1] = *(const f32x4*)(cb + col + 4);
#pragma unroll
            for (int k = 0; k < 4; ++k) { const int q = k >> 1, e2 = (2 * k) & 3;
                const float yl = w[0][q][e2] * bflo(xm[k]) + w[1][q][e2] * bflo(x0[k]) + w[2][q][e2] * bflo(xp[k]) + bb[q][e2];
                const float yh = w[0][q][e2 + 1] * bfhi(xm[k]) + w[1][q][e2 + 1] * bfhi(x0[k]) + w[2][q][e2 + 1] * bfhi(xp[k]) + bb[q][e2 + 1];
                if (half == 0) { acc[2 * k] = silu_(yl); acc[2 * k + 1] = silu_(yh); } else { acc[2 * k] *= yl; acc[2 * k + 1] *= yh; } }
        }
        u32x4 o; o.x = pk2(acc[0], acc[1]); o.y = pk2(acc[2], acc[3]); o.z = pk2(acc[4], acc[5]); o.w = pk2(acc[6], acc[7]);
        *(u32x4*)(ACT + ((size_t)(c >> 6) * JR + row) * 64 + (c & 63)) = o;
    }
}
DI void phase_pconvert(Frame& F, const float* P, bf16* PB) {
    for (int it = F.bid * NTHREADS + F.tid; it < JR * PLE / 8; it += F.G * NTHREADS) { const f32x4 a = *((const f32x4*)P + 2 * it), b = *((const f32x4*)P + 2 * it + 1);
        *((u32x4*)PB + it) = pg8::pack8(a, b); }
}
constexpr int G1_LF = 0, G1_TU = 17408, G1_TW = 26624, G1_TAB = 35840, G1_CW = 36864, G1_LB = 41472, G1_T1T = 44032, G1_T2R = 46592, G1_QN = 49152, G1_KN = 66560, G1_KT = 83968, G1_VT = 102400;
DI bf16x8 ldsfrag(const LAS unsigned char* p) { return *(const LAS bf16x8*)p; }
DI int kt_swz(int row) { return ((row >> 4) & 7) << 3; }
DI void phase_g1(Frame& F, CArgs* a, int layer, const bf16* PJ, const float* AB, unsigned char* G1B, float* GL, const JobGeo& jg) {
    const int wave = F.wave;
    LAS unsigned char* L = F.lds;
    LAS bf16* QN = (LAS bf16*)(L + G1_QN); LAS bf16* KN = (LAS bf16*)(L + G1_KN); LAS bf16* KT = (LAS bf16*)(L + G1_KT); LAS bf16* VT = (LAS bf16*)(L + G1_VT);
    LAS float* LF = (LAS float*)(L + G1_LF); LAS bf16* TU = (LAS bf16*)(L + G1_TU); LAS bf16* TW = (LAS bf16*)(L + G1_TW);
    LAS float* T_GC = (LAS float*)(L + G1_TAB); LAS float* T_BETA = T_GC + 64; LAS float* T_EGC = T_GC + 128; LAS float* T_EKD = T_GC + 192;
    LAS float* CW = (LAS float*)(L + G1_CW);
    LAS bf16* LB = (LAS bf16*)(L + G1_LB);
    LAS bf16* T1T = (LAS bf16*)(L + G1_T1T);
    LAS bf16* T2R = (LAS bf16*)(L + G1_T2R);
    u32x4 xr[18]; float pal = 0.f, pbl = 0.f; int hd_loaded = -1;
#define G1_PREFETCH(UU) do { const int dir_ = (UU) & 1, h_ = ((UU) >> 1) & 7, n_ = (UU) >> 4; const int t_ = n_ * 64 + (dir_ ? 63 - ci : ci); \
        const int s0_ = ((n_ * 64) / jg.seqlen) * jg.seqlen; const int om_ = t_ > s0_ ? LDPJ : 0, op_ = t_ < s0_ + jg.seqlen - 1 ? LDPJ : 0; \
        _Pragma("unroll") for (int part = 0; part < 3; ++part) { const bf16* p_ = PJ + (size_t)t_ * LDPJ + part * 1024 + h_ * 128 + cc; \
            xr[part * 6 + 0] = *(const u32x4*)p_; xr[part * 6 + 1] = *(const u32x4*)(p_ + 8); xr[part * 6 + 2] = *(const u32x4*)(p_ - om_); xr[part * 6 + 3] = *(const u32x4*)(p_ - om_ + 8); \
            xr[part * 6 + 4] = *(const u32x4*)(p_ + op_); xr[part * 6 + 5] = *(const u32x4*)(p_ + op_ + 8); } \
        if (wave == 0) { const int tl_ = n_ * 64 + (dir_ ? 63 - lane : lane); pal = AB[(size_t)tl_ * 32 + dir_ * 8 + h_]; pbl = AB[(size_t)tl_ * 32 + 16 + dir_ * 8 + h_]; } } while (0)
    int u = F.bid;
    { const int tid = F.tid, lane = F.lane, ci = tid >> 3, cc = (tid & 7) * 16; if (u < 4096) G1_PREFETCH(u); }
    for (; u < 4096; u += F.G) {
        int tid_o = F.tid; asm volatile("" : "+v"(tid_o));
        const int tid = tid_o, lane = tid & 63, r = lane & 31, hh = lane >> 5, ci = tid >> 3, cc = (tid & 7) * 16;
        const int dir = u & 1, h = (u >> 1) & 7, n = u >> 4;
        unsigned char* outb = G1B + (size_t)u * G1_UNIT_BYTES;
        if ((u & 15) != hd_loaded) {
            __syncthreads();
            if (tid < 288) { const int row = tid >> 5, d4 = (tid & 31) * 4, part = row / 3, tap = row % 3;
                *(LAS f32x4*)(CW + row * 128 + d4) = *(const f32x4*)(a->in[6] + (size_t)layer * 9216 + tap * 3072 + part * 1024 + h * 128 + d4); }
            hd_loaded = u & 15;
            __syncthreads();
        }
        if (wave == 0) {
            const float alog = a->in[7][layer * 16 + dir * 8 + h], dtb = a->in[8][layer * 16 + dir * 8 + h];
            float g = -__expf(alog) * softplus_(pal + dtb);
#pragma unroll
            for (int o = 1; o < 64; o <<= 1) { const float v = __shfl_up(g, o); if (lane >= o) g += v; }
            const float gl = __shfl(g, 63);
            T_GC[lane] = g; T_BETA[lane] = sigmoidf_(pbl); T_EGC[lane] = __expf(g); T_EKD[lane] = __expf(gl - g);
            if (lane == 0) GL[u] = __expf(gl);
        }
        {
            const int t = n * 64 + (dir ? 63 - ci : ci); const int s0 = ((n * 64) / jg.seqlen) * jg.seqlen; const bool okm = t > s0, okp = t < s0 + jg.seqlen - 1;
#pragma unroll
            for (int part = 0; part < 3; ++part) {
                float y[16];
#pragma unroll
                for (int hf = 0; hf < 2; ++hf) {
                    u32x4 c0 = xr[part * 6 + hf], m0 = xr[part * 6 + 2 + hf], n0 = xr[part * 6 + 4 + hf];
                    if (!okm) m0 = m0 ^ m0; if (!okp) n0 = n0 ^ n0;
                    const LAS float* w = CW + part * 384 + cc + 8 * hf;
                    const f32x4 wa0 = *(const LAS f32x4*)w, wa1 = *(const LAS f32x4*)(w + 4), wb0 = *(const LAS f32x4*)(w + 128), wb1 = *(const LAS f32x4*)(w + 132), wc0 = *(const LAS f32x4*)(w + 256), wc1 = *(const LAS f32x4*)(w + 260);
#pragma unroll
                    for (int k = 0; k < 4; ++k) { const float wl0 = k < 2 ? wa0[2 * k] : wa1[2 * k - 4], wh0 = k < 2 ? wa0[2 * k + 1] : wa1[2 * k - 3];
                        const float wl1 = k < 2 ? wb0[2 * k] : wb1[2 * k - 4], wh1 = k < 2 ? wb0[2 * k + 1] : wb1[2 * k - 3];
                        const float wl2 = k < 2 ? wc0[2 * k] : wc1[2 * k - 4], wh2 = k < 2 ? wc0[2 * k + 1] : wc1[2 * k - 3];
                        y[8 * hf + 2 * k] = silu_(wl0 * bflo(m0[k]) + wl1 * bflo(c0[k]) + wl2 * bflo(n0[k]));
                        y[8 * hf + 2 * k + 1] = silu_(wh0 * bfhi(m0[k]) + wh1 * bfhi(c0[k]) + wh2 * bfhi(n0[k])); }
                }
                float rs = 1.f;
                if (part < 2) { float sq = 0.f;
#pragma unroll
                    for (int e = 0; e < 16; ++e) sq += y[e] * y[e];
                    sq += __shfl_xor(sq, 1); sq += __shfl_xor(sq, 2); sq += __shfl_xor(sq, 4);
                    rs = rsqrtf(sq + EPS) * (part == 0 ? 0.088388347648318440f : 1.f); }
                if (part < 2) { LAS bf16* dst = part == 0 ? QN : KN; u32x4 q0, q1;
#pragma unroll
                    for (int k = 0; k < 4; ++k) { q0[k] = pk2(y[2 * k] * rs, y[2 * k + 1] * rs); q1[k] = pk2(y[8 + 2 * k] * rs, y[8 + 2 * k + 1] * rs); }
                    *(LAS u32x4*)(dst + ci * 136 + cc) = q0; *(LAS u32x4*)(dst + ci * 136 + cc + 8) = q1; }
                if (part >= 1) { LAS bf16* dT = part == 1 ? KT : VT; const int sw = kt_swz(cc);
#pragma unroll
                    for (int e = 0; e < 16; ++e) dT[(cc + e) * 72 + (ci ^ sw)] = f2bf(y[e] * rs); }
            }
        }
        if (u + F.G < 4096) G1_PREFETCH(u + F.G);
        __syncthreads();
        if (wave < 4) {
            const int it = wave >> 1, jt = wave & 1; f32x16 acc = {};
            if (!(it == 0 && jt == 1)) {
#pragma unroll
                for (int ks = 0; ks < 8; ++ks) acc = MFMA32(ldsfrag((const LAS unsigned char*)KN + (32 * it + r) * 272 + (16 * ks + 8 * hh) * 2), ldsfrag((const LAS unsigned char*)KN + (32 * jt + r) * 272 + (16 * ks + 8 * hh) * 2), acc);
            }
            const int j = 32 * jt + r; const float gcj = T_GC[j];
#pragma unroll
            for (int reg = 0; reg < 16; ++reg) { const int i = 32 * it + crow(reg, hh); const float v = (i > j) ? acc[reg] * T_BETA[i] * __expf(T_GC[i] - gcj) : 0.f;
                LF[i * 68 + j] = v; if (it == 1 && jt == 0) LB[crow(reg, hh) * 40 + r] = f2bf(v); }
        } else {
            const int w4 = wave - 4, ct = w4 >> 1, it = w4 & 1; f32x16 acc = {};
            if (!(it == 0 && ct == 1)) {
#pragma unroll
                for (int ks = 0; ks < 8; ++ks) acc = MFMA32(ldsfrag((const LAS unsigned char*)KN + (32 * ct + r) * 272 + (16 * ks + 8 * hh) * 2), ldsfrag((const LAS unsigned char*)QN + (32 * it + r) * 272 + (16 * ks + 8 * hh) * 2), acc);
            }
            const int i = 32 * it + r; const float gci = T_GC[i];
#pragma unroll
            for (int reg = 0; reg < 16; ++reg) { const int c = 32 * ct + crow(reg, hh); acc[reg] = (i >= c) ? acc[reg] * __expf(gci - T_GC[c]) : 0.f; }
            *(bf16x8*)(outb + G1_IN + ((it * 4 + 2 * ct + 0) * 64 + lane) * 16) = pack_step<0>(acc);
            *(bf16x8*)(outb + G1_IN + ((it * 4 + 2 * ct + 1) * 64 + lane) * 16) = pack_step<1>(acc);
        }
        __syncthreads();
        if (wave < 2) {
            const int b0 = wave * 32;
            float t[32]; const float lanef = (float)lane;
            const LAS float* lp = LF + b0 * 68 + b0;
            f32x4 lcur[8], lnxt[8];
#pragma unroll
            for (int q = 0; q < 8; ++q) { lcur[q] = (f32x4){0.f, 0.f, 0.f, 0.f}; lnxt[q] = (f32x4){0.f, 0.f, 0.f, 0.f}; }
#pragma unroll
            for (int c = 0; c < 32; ++c) {
                if (c + 1 < 32) {
#pragma unroll
                    for (int q = 0; q < 8; ++q) if (4 * q < c + 1) lnxt[q] = *(const LAS f32x4*)(lp + (c + 1) * 68 + 4 * q); }
                float a0 = fmaxf(0.f, 1.f - fabsf(lanef - (float)c)), a1 = 0.f;
#pragma unroll
                for (int q = 0; q < 8; ++q) if (4 * q < c) { const f32x4 l = lcur[q]; const int s4 = 4 * q;
                    a0 -= l[0] * t[s4]; if (s4 + 1 < c) a1 -= l[1] * t[s4 + 1]; if (s4 + 2 < c) a0 -= l[2] * t[s4 + 2]; if (s4 + 3 < c) a1 -= l[3] * t[s4 + 3]; }
                t[c] = a0 + a1; asm volatile("" : "+v"(t[c]), "+v"(lp));
#pragma unroll
                for (int q = 0; q < 8; ++q) lcur[q] = lnxt[q]; }
            if (lane < 32) {
                const int j = b0 + lane; const float bj = T_BETA[j], bej = bj * T_EGC[j];
#pragma unroll
                for (int c = 0; c < 32; ++c) { TU[(b0 + c) * 72 + j] = f2bf(t[c] * bj); TW[(b0 + c) * 72 + j] = f2bf(t[c] * bej); }
                if (wave == 0) {
#pragma unroll
                    for (int q = 0; q < 4; ++q) { u32x4 w; w.x = pk2(t[8 * q], t[8 * q + 1]); w.y = pk2(t[8 * q + 2], t[8 * q + 3]); w.z = pk2(t[8 * q + 4], t[8 * q + 5]); w.w = pk2(t[8 * q + 6], t[8 * q + 7]);
                        *(LAS u32x4*)(T1T + lane * 40 + 8 * q) = w; }
                } else {
#pragma unroll
                    for (int c = 0; c < 32; ++c) { T2R[c * 40 + lane] = f2bf(t[c]); TU[c * 72 + j] = 0; TW[c * 72 + j] = 0; }
                }
            }
        } else {
            for (int f = wave - 2; f < 32; f += 6) {
                if (f < 16) { const int mt = f >> 3, ks = f & 7, dt = ks >> 1, s = ks & 1; const int i = 32 * mt + r, d0 = 32 * dt + 16 * s + 4 * hh; const float e = T_EGC[i];
                    const u32x2 lo = *(const LAS u32x2*)(QN + i * 136 + d0), hi = *(const LAS u32x2*)(QN + i * 136 + d0 + 8);
                    u32x4 o; o.x = pk2(bflo(lo.x) * e, bfhi(lo.x) * e); o.y = pk2(bflo(lo.y) * e, bfhi(lo.y) * e); o.z = pk2(bflo(hi.x) * e, bfhi(hi.x) * e); o.w = pk2(bflo(hi.y) * e, bfhi(hi.y) * e);
                    *(u32x4*)(outb + G1_QD + (f * 64 + lane) * 16) = o;
                } else { const int g = f - 16, dt = g >> 2, ks = g & 3, ct = ks >> 1, s = ks & 1; const int d = 32 * dt + r, c0 = 32 * ct + 16 * s + 4 * hh, sw = kt_swz(d);
                    const u32x2 lo = *(const LAS u32x2*)(KT + d * 72 + (c0 ^ sw)), hi = *(const LAS u32x2*)(KT + d * 72 + ((c0 + 8) ^ sw));
                    const f32x4 e0 = *(const LAS f32x4*)(T_EKD + c0), e1 = *(const LAS f32x4*)(T_EKD + c0 + 8);
                    u32x4 o; o.x = pk2(bflo(lo.x) * e0[0], bfhi(lo.x) * e0[1]); o.y = pk2(bflo(lo.y) * e0[2], bfhi(lo.y) * e0[3]); o.z = pk2(bflo(hi.x) * e1[0], bfhi(hi.x) * e1[1]); o.w = pk2(bflo(hi.y) * e1[2], bfhi(hi.y) * e1[3]);
                    *(u32x4*)(outb + G1_KD + (g * 64 + lane) * 16) = o; }
            }
        }
        __syncthreads();
        if (wave == 0) {
            f32x16 x = {};
#pragma unroll
            for (int ks = 0; ks < 2; ++ks) x = MFMA32(ldsfrag((const LAS unsigned char*)LB + r * 80 + (16 * ks + 8 * hh) * 2), ldsfrag((const LAS unsigned char*)T1T + r * 80 + (16 * ks + 8 * hh) * 2), x);
            f32x16 t21 = {};
            { const u32x2 lo = *(const LAS u32x2*)(T2R + r * 40 + 4 * hh), hi = *(const LAS u32x2*)(T2R + r * 40 + 8 + 4 * hh); const u32x4 af = {lo.x, lo.y, hi.x, hi.y};
              t21 = MFMA32(__builtin_bit_cast(bf16x8, af), pack_step<0>(x), t21); }
            { const u32x2 lo = *(const LAS u32x2*)(T2R + r * 40 + 16 + 4 * hh), hi = *(const LAS u32x2*)(T2R + r * 40 + 24 + 4 * hh); const u32x4 af = {lo.x, lo.y, hi.x, hi.y};
              t21 = MFMA32(__builtin_bit_cast(bf16x8, af), pack_step<1>(x), t21); }
            const float bj = T_BETA[r], bej = bj * T_EGC[r];
#pragma unroll
            for (int reg = 0; reg < 16; ++reg) { const int i = 32 + crow(reg, hh); TU[i * 72 + r] = f2bf(-t21[reg] * bj); TW[i * 72 + r] = f2bf(-t21[reg] * bej); }
        }
        __syncthreads();
        {
            const int dt = wave >> 1, it = wave & 1; f32x16 acc = {};
#pragma unroll
            for (int ks = 0; ks < 4; ++ks) acc = MFMA32(ldsfrag((const LAS unsigned char*)KT + (32 * dt + r) * 144 + ((16 * ks + 8 * hh) ^ kt_swz(32 * dt + r)) * 2), ldsfrag((const LAS unsigned char*)TW + (32 * it + r) * 144 + (16 * ks + 8 * hh) * 2), acc);
            *(bf16x8*)(outb + G1_W + ((it * 8 + 2 * dt + 0) * 64 + lane) * 16) = pack_step<0>(acc);
            *(bf16x8*)(outb + G1_W + ((it * 8 + 2 * dt + 1) * 64 + lane) * 16) = pack_step<1>(acc);
            const int et = wave >> 1; f32x16 au = {};
#pragma unroll
            for (int ks = 0; ks < 4; ++ks) au = MFMA32(ldsfrag((const LAS unsigned char*)TU + (32 * it + r) * 144 + (16 * ks + 8 * hh) * 2), ldsfrag((const LAS unsigned char*)VT + (32 * et + r) * 144 + ((16 * ks + 8 * hh) ^ kt_swz(32 * et + r)) * 2), au);
            *(bf16x8*)(outb + G1_U + ((et * 2 + it) * 64 + lane) * 32) = pack_step<0>(au);
            *(bf16x8*)(outb + G1_U + ((et * 2 + it) * 64 + lane) * 32 + 16) = pack_step<1>(au);
        }
        __syncthreads();
    }
#undef G1_PREFETCH
}
DI void scan_unit(Frame& F, const unsigned char* G1B, const float* GL, bf16* OAF, bf16* OAB, int sid, const JobGeo& jg) {
    const int seq = sid >> 4, h = (sid >> 1) & 7, dir = sid & 1, N = jg.seqlen >> 6;
    const int tid = F.tid, lane = F.lane, wave = F.wave, r = lane & 31, hh = lane >> 5;
    bf16* OUT = dir ? OAB : OAF;
    f32x16 S0 = {}, S1 = {}, S2 = {}, S3 = {};
    const int lt = tid - 256;
    if (wave >= 4) {
        const int n = seq * N + (dir ? N - 1 : 0); const unsigned char* up = G1B + ((size_t)(n * 8 + h) * 2 + dir) * G1_UNIT_BYTES;
        u32x4 stg[14];
#pragma unroll
        for (int k = 0; k < 14; ++k) stg[k] = *(const u32x4*)(up + lt * 16 + k * 4096);
#pragma unroll
        for (int k = 0; k < 14; ++k) *(LAS u32x4*)(F.lds + lt * 16 + k * 4096) = stg[k];
    }
    __syncthreads();
    for (int st = 0; st < N; ++st) {
        const int n = seq * N + (dir ? N - 1 - st : st); const int unit = (n * 8 + h) * 2 + dir;
        const unsigned char* up = G1B + (size_t)unit * G1_UNIT_BYTES;
        if (wave < 4) {
            const LAS unsigned char* sl = F.lds + (st & 1) * G1_STAGE + lane * 16;
            const unsigned char* uu = up + G1_U + ((wave * 2) * 64 + lane) * 32;
            const u32x4 u0a = *(const u32x4*)uu, u0b = *(const u32x4*)(uu + 16), u1a = *(const u32x4*)(uu + 2048), u1b = *(const u32x4*)(uu + 2048 + 16);
            const float egl = GL[unit];
            f32x16 ws0 = {}, ws1 = {}, o0 = {}, o1 = {};
#define SCAN_STEP1(SX, DT) do { { const bf16x8 fr = pack_step<0>(SX); const int ks = 2 * (DT); \
                ws0 = MFMA32(ldsfrag(sl + G1_W + ks * 1024), fr, ws0); ws1 = MFMA32(ldsfrag(sl + G1_W + (8 + ks) * 1024), fr, ws1); \
                o0 = MFMA32(ldsfrag(sl + G1_QD + ks * 1024), fr, o0); o1 = MFMA32(ldsfrag(sl + G1_QD + (8 + ks) * 1024), fr, o1); } asm volatile("" ::: "memory"); \
              { const bf16x8 fr = pack_step<1>(SX); const int ks = 2 * (DT) + 1; \
                ws0 = MFMA32(ldsfrag(sl + G1_W + ks * 1024), fr, ws0); ws1 = MFMA32(ldsfrag(sl + G1_W + (8 + ks) * 1024), fr, ws1); \
                o0 = MFMA32(ldsfrag(sl + G1_QD + ks * 1024), fr, o0); o1 = MFMA32(ldsfrag(sl + G1_QD + (8 + ks) * 1024), fr, o1); } asm volatile("" ::: "memory"); } while (0)
            SCAN_STEP1(S0, 0); SCAN_STEP1(S1, 1); SCAN_STEP1(S2, 2); SCAN_STEP1(S3, 3);
#undef SCAN_STEP1
            f32x16 vn0, vn1;
#pragma unroll
            for (int k = 0; k < 4; ++k) { vn0[2 * k] = bflo(u0a[k]) - ws0[2 * k]; vn0[2 * k + 1] = bfhi(u0a[k]) - ws0[2 * k + 1]; vn0[8 + 2 * k] = bflo(u0b[k]) - ws0[8 + 2 * k]; vn0[8 + 2 * k + 1] = bfhi(u0b[k]) - ws0[8 + 2 * k + 1];
                vn1[2 * k] = bflo(u1a[k]) - ws1[2 * k]; vn1[2 * k + 1] = bfhi(u1a[k]) - ws1[2 * k + 1]; vn1[8 + 2 * k] = bflo(u1b[k]) - ws1[8 + 2 * k]; vn1[8 + 2 * k + 1] = bfhi(u1b[k]) - ws1[8 + 2 * k + 1]; }
            S0 *= egl; S1 *= egl; S2 *= egl; S3 *= egl;
#define SCAN_STEP2(VN, CT, SS) do { const bf16x8 vf = pack_step<SS>(VN); const int ks = 2 * (CT) + (SS); \
                o0 = MFMA32(ldsfrag(sl + G1_IN + ks * 1024), vf, o0); o1 = MFMA32(ldsfrag(sl + G1_IN + (4 + ks) * 1024), vf, o1); \
                S0 = MFMA32(ldsfrag(sl + G1_KD + (0 + ks) * 1024), vf, S0); S1 = MFMA32(ldsfrag(sl + G1_KD + (4 + ks) * 1024), vf, S1); \
                S2 = MFMA32(ldsfrag(sl + G1_KD + (8 + ks) * 1024), vf, S2); S3 = MFMA32(ldsfrag(sl + G1_KD + (12 + ks) * 1024), vf, S3); asm volatile("" ::: "memory"); } while (0)
            SCAN_STEP2(vn0, 0, 0); SCAN_STEP2(vn0, 0, 1); SCAN_STEP2(vn1, 1, 0); SCAN_STEP2(vn1, 1, 1);
#undef SCAN_STEP2
            const long rs = dir ? -1024 : 1024;
            bf16* ob = OUT + (size_t)(n * 64 + (dir ? 63 : 0)) * 1024 + h * 128 + 32 * wave + r + (long)(4 * hh) * rs;
#pragma unroll
            for (int reg = 0; reg < 16; ++reg) { ob[0] = f2bf(o0[reg]); ob[32 * rs] = f2bf(o1[reg]);
                ob += ((reg & 3) == 3 ? 5 : 1) * rs; asm volatile("" : "+v"(ob)); }
        }
        if (wave >= 4 && st + 1 < N) {
            const int n2 = seq * N + (dir ? N - 2 - st : st + 1); const unsigned char* up2 = G1B + ((size_t)(n2 * 8 + h) * 2 + dir) * G1_UNIT_BYTES;
            u32x4 stg[14];
#pragma unroll
            for (int k = 0; k < 14; ++k) stg[k] = *(const u32x4*)(up2 + lt * 16 + k * 4096);
#pragma unroll
            for (int k = 0; k < 14; ++k) *(LAS u32x4*)(F.lds + ((st + 1) & 1) * G1_STAGE + lt * 16 + k * 4096) = stg[k];
        }
        __syncthreads();
    }
}
constexpr int NPHASE = 16;
#ifndef ATTN_BODY
#define ATTN_BODY attn_dma_body
#endif
#ifndef PG8_SP2
#define PG8_SP2 true
#endif
#ifndef PG8_ALIGN
#define PG8_ALIGN true
#endif
__global__ void __launch_bounds__(NTHREADS, 2) fwd_kernel(Args a) {
    extern __shared__ __attribute__((aligned(16))) unsigned char lds_raw[];
    Frame F;
    F.lds = (LAS unsigned char*)lds_raw; F.MISC = (volatile LAS unsigned*)(F.lds + MISC_OFF);
    F.tid = threadIdx.x; F.lane = F.tid & 63; F.wave = __builtin_amdgcn_readfirstlane(F.tid >> 6); F.G = gridDim.x; F.bid = blockIdx.x;
    const int wave0 = F.wave;
    CArgs* ap = (CArgs*)__builtin_amdgcn_kernarg_segment_ptr();
    F.ws = ap->ws; F.ctl = (gu32*)(ap->ws + WS_CTL);
    const int one_launch = ap->one_launch, ph_lo = ap->ph_lo, ph_hi = ap->ph_hi;
    for (int u = F.tid; u < (LDS_BYTES - LDSCTL_OFF) / 4; u += NTHREADS) ((LAS unsigned*)(F.lds + LDSCTL_OFF))[u] = 0u;
    __syncthreads();
    XcdBarrier bar; bar.bar = (unsigned*)(F.ctl + CW_BAR); bar.x = 0; bar.st = nullptr;
    if (one_launch) bar = xcd_barrier_post((unsigned*)(F.ctl + CW_BAR), F.MISC + 8);
#ifndef PROBE_MASK
#define PROBE_MASK 0
#endif
#ifndef PROBE_BID
#define PROBE_BID 0
#endif
    unsigned long long pr_acc = 0, pr_t0 = 0; (void)pr_t0;
#define PSTART() do { if (PROBE_MASK) pr_t0 = __builtin_amdgcn_s_memrealtime(); } while (0)
#define PEND(k) do { if (PROBE_MASK && ((PROBE_MASK >> (k)) & 1)) pr_acc += __builtin_amdgcn_s_memrealtime() - pr_t0; } while (0)
#define SEAM() do { if (one_launch) { XcdBarrier b2_ = bar; asm volatile("" : "+s"(b2_.bar), "+s"(b2_.x)); xcd_barrier(b2_, F.wave == 0 && __builtin_amdgcn_mbcnt_hi(~0u, __builtin_amdgcn_mbcnt_lo(~0u, 0u)) == 0u); } } while (0)
#define REFRESH() int layer = layer_i, job = job_i; asm volatile("" : "+s"(layer), "+s"(job)); const JobGeo jg = job_geo(job); (void)jg; do { int w_ = wave0; asm volatile("" : "+s"(w_)); int t_ = (w_ << 6) | (int)__builtin_amdgcn_mbcnt_hi(~0u, __builtin_amdgcn_mbcnt_lo(~0u, 0u)); asm volatile("" : "+v"(t_)); F.tid = t_; F.lane = t_ & 63; F.wave = __builtin_amdgcn_readfirstlane(t_ >> 6); asm volatile("" : "+s"(ap)); F.ws = ap->ws; F.ctl = (gu32*)(F.ws + OPQ(WS_CTL)); int b_ = blockIdx.x, g_ = gridDim.x; asm volatile("" : "+s"(b_), "+s"(g_)); F.bid = b_; F.G = g_; } while (0)
#ifndef PH4MASK
#define PH4MASK 7
#endif
#ifndef PHMASK
#define PHMASK 0xffff
#endif
#define IN(k) (((PHMASK >> (k)) & 1) && ({ int lo_ = ph_lo, hi_ = ph_hi; asm volatile("" : "+s"(lo_), "+s"(hi_)); lo_ <= (k) && (k) < hi_; }))
#define OPQ(x) ({ size_t c_ = (x); asm volatile("" : "+s"(c_)); c_; })
#define XIN0 (job == 0 ? ap->in[0] : ap->in[1] + (size_t)(job - 1) * JR * DM)
#define HB ((bf16*)(F.ws + OPQ(WS_HB)))
#define AB ((float*)(F.ws + OPQ(WS_AB)))
#define PB ((bf16*)(F.ws + OPQ(WS_PB)))
#define GL ((float*)(F.ws + OPQ(WS_GL)))
#define OAF ((bf16*)(F.ws + OPQ(WS_OAF)))
#define OAB ((bf16*)(F.ws + OPQ(WS_OAB)))
#define OB ((bf16*)(F.ws + OPQ(WS_OB)))
#define OC2 ((bf16*)(F.ws + OPQ(WS_OC2)))
#define OCP ((bf16*)(F.ws + OPQ(WS_OCP)))
#define XLB ((bf16*)(ap->out + (size_t)jg.row0 * DM))
#define X9B ((bf16*)(F.ws + OPQ(WS_OC2)))
#define PJ ((bf16*)(F.ws + OPQ(WS_PJ)))
#define G1B (F.ws + OPQ(WS_G1))
#define GT ((bf16*)(F.ws + OPQ(WS_GT)))
#define MG ((bf16*)(F.ws + OPQ(WS_MG)))
#define UB ((bf16*)(F.ws + OPQ(WS_U)))
#define ACT ((bf16*)(F.ws + OPQ(WS_ACT)))
#define PL ((bf16*)(F.ws + OPQ(WS_PL)))
#define Win_t ((const bf16*)(F.ws + OPQ(WS_WIN)))
    const int l0 = ap->l0, l1 = ap->l1, j0 = ap->j0, j1 = ap->j1;
    for (int layer_i = l0; layer_i < l1; ++layer_i) { const int job_i = 0;
        if (IN(0)) { REFRESH(); PSTART(); phase_weights(F, ap, layer); if (!one_launch) { SEAM(); } PEND(0); }
        for (int job_i = j0; job_i < j1; ++job_i) {

            if (IN(1)) { REFRESH(); PSTART(); if (layer == 0) phase_rms(F, XIN0, ap->in[4] + layer * DM, HB); else phase_rms_b(F, XLB, ap->in[4] + layer * DM, HB); SEAM(); PEND(1); }
            if (IN(2)) { REFRESH(); PSTART();
                pg8::Gemm g{HB, Win_t, JR, NP1, DM, DM, DM, 128}; pg8::StaticOrder S; S.init(JR, NP1, F.G, F.bid);
                pg8::EpiProj E{PJ, AB};
                pg8::gemm_phase<pg8::EpiProj, pg8::StaticOrder, PG8_ALIGN, PG8_SP2>(F.lds, g, S, E, F.wave);
                SEAM(); PEND(2);
            }
            if (IN(3)) { REFRESH(); PSTART();
                phase_g1(F, ap, layer, PJ, AB, G1B, GL, jg);
#if PROBE_MASK == 0x10000
                pr_acc += __builtin_amdgcn_s_memrealtime() - pr_t0;
#endif
#if PROBE_MASK == 0x100000
                pr_t0 = __builtin_amdgcn_s_memrealtime();
#endif
                phase_prep(F, ap, layer, PJ, jg);
#if PROBE_MASK == 0x100000
                pr_acc += __builtin_amdgcn_s_memrealtime() - pr_t0;
#endif
                { const float* P = job == 0 ? ap->in[2] + (size_t)layer * 16384 * PLE : ap->in[3] + ((size_t)layer * 32768 + (size_t)(job - 1) * 16384) * PLE;
                  phase_pconvert(F, P, PB); }
                SEAM(); PEND(3);
            }
            if (IN(4)) { REFRESH(); PSTART();
                gu32* qh = F.ctl + CW_Q + 64 * (layer * NJOB + job);
                const int nscan = jg.nseq * 16, ntot = nscan + 512 + 1024;
#define QNEXT() do { __syncthreads(); if (F.tid == 0) F.MISC[16] = __hip_atomic_fetch_add(qh, 1u, RLX_AGENT); __syncthreads(); u = (int)F.MISC[16]; } while (0)
                int u; QNEXT();
#if (PH4MASK & 1)
                while (u < nscan) { scan_unit(F, G1B, GL, OAF, OAB, u, jg); __syncthreads(); if (F.tid == 0) __hip_atomic_fetch_add(qh + 2, 1u, __ATOMIC_RELEASE, __HIP_MEMORY_SCOPE_AGENT); QNEXT(); }
#endif
                bool fastB, fastC;
                { const float* qb_ = ap->in[10] + layer * 128; const float* kb_ = ap->in[11] + layer * 128; const float* qc_ = ap->in[12] + layer * 64; const float* kc_ = ap->in[13] + layer * 64;
                  float g1 = fmaxf(fabsf(qb_[F.lane]), fabsf(qb_[64 + F.lane])), g2 = fmaxf(fabsf(kb_[F.lane]), fabsf(kb_[64 + F.lane])), g3 = fabsf(qc_[F.lane]), g4 = fabsf(kc_[F.lane]);
#pragma unroll
                  for (int o = 1; o < 64; o <<= 1) { g1 = fmaxf(g1, __shfl_xor(g1, o)); g2 = fmaxf(g2, __shfl_xor(g2, o)); g3 = fmaxf(g3, __shfl_xor(g3, o)); g4 = fmaxf(g4, __shfl_xor(g4, o)); }
                  fastB = __builtin_amdgcn_readfirstlane((int)(1.4426950408889634f * 11.313708498984761f * g1 * g2 <= 60.f)) != 0;
                  fastC = __builtin_amdgcn_readfirstlane((int)(1.4426950408889634f * 8.f * g3 * g4 <= 60.f)) != 0; }
#define ATT_B(FASTV) do { unsigned long long tb_ = 0; if (PROBE_MASK == 0x20000) tb_ = __builtin_amdgcn_s_memrealtime(); const int v = u - nscan, hq = v >> 6, qb = v & 63, s0 = ((qb * 256) / jg.seqlen) * jg.seqlen; \
                    att::ATTN_BODY<LDPJ, LDPJ, 1024, 8, FASTV>(PJ + (size_t)(qb * 256) * LDPJ + PJ_BQ + hq * 128, PJ + (size_t)s0 * LDPJ + PJ_BK + (hq >> 2) * 128, PJ + (size_t)s0 * LDPJ + PJ_BV + (hq >> 2) * 128, \
                                                                 OB + (size_t)(qb * 256) * 1024 + hq * 128, jg.seqlen, 0, (char*)lds_raw, F.tid, (unsigned*)qh, F.MISC + 16); if (PROBE_MASK == 0x20000 && pr_acc == 0 && layer == 0 && job == 0) pr_acc = 16ull * (__builtin_amdgcn_s_memrealtime() - tb_); u = (int)F.MISC[16]; } while (0)
#define ATT_C(FASTV) do { unsigned long long tb_ = 0; if (PROBE_MASK == 0x40000) tb_ = __builtin_amdgcn_s_memrealtime(); const int v = u - nscan - 512, hc = v >> 6, qb = v & 63, h = hc >> 1, comp = hc & 1, s0 = ((qb * 256) / jg.seqlen) * jg.seqlen; \
                    att::ATTN_BODY<LDPJ, LDPJ, 2048, 4, FASTV>(PJ + (size_t)(qb * 256) * LDPJ + PJ_CQ + h * 128, PJ + (size_t)s0 * LDPJ + PJ_CK + h * 128, PJ + (size_t)s0 * LDPJ + PJ_CV + h * 128, \
                                                                 OC2 + (size_t)(qb * 256) * 2048 + hc * 128, jg.seqlen, comp * 4, (char*)lds_raw, F.tid, (unsigned*)qh, F.MISC + 16); if (PROBE_MASK == 0x40000 && pr_acc == 0 && layer == 0 && job == 0) pr_acc = 16ull * (__builtin_amdgcn_s_memrealtime() - tb_); u = (int)F.MISC[16]; } while (0)
#if (PH4MASK & 2)
                if (fastB) { while (u < nscan + 512) ATT_B(true); } else { while (u < nscan + 512) ATT_B(false); }
#endif
#if (PH4MASK & 4)
                if (fastC) { while (u < ntot) ATT_C(true); } else { while (u < ntot) ATT_C(false); }
#endif
#undef ATT_B
#undef ATT_C
                if (u < ntot + 1536 + 256) { if (F.tid == 0) { while (__hip_atomic_load(qh + 2, __ATOMIC_RELAXED, __HIP_MEMORY_SCOPE_AGENT) < (unsigned)nscan) __builtin_amdgcn_s_sleep(8); } __syncthreads(); }
                { pg8::Gemm g{HB, Win_t + (size_t)NP1 * DM, JR, 2048, DM, DM, DM, 128}; pg8::EpiSigmoid E{PJ + PJ_AQ, LDPJ};
                  while (u < ntot + 512) { pg8::OneTile S; S.init(JR, 2048, 1, u - ntot);
                      pg8::gemm_phase<pg8::EpiSigmoid, pg8::OneTile, PG8_ALIGN, PG8_SP2>(F.lds, g, S, E, F.wave); QNEXT(); } }
                { pg8::Gemm g{HB, Win_t + (size_t)(NP1 + 2048) * DM, JR, NGT - 2048, DM, DM, DM, 128}; pg8::EpiSigmoid E{GT + 2048, NGT};
                  while (u < ntot + 1536) { pg8::OneTile S; S.init(JR, NGT - 2048, 1, u - ntot - 512);
                      pg8::gemm_phase<pg8::EpiSigmoid, pg8::OneTile, PG8_ALIGN, PG8_SP2>(F.lds, g, S, E, F.wave); QNEXT(); } }
                if (u < ntot + 1536 + 256) { if (F.tid == 0) (void)__hip_atomic_load(qh + 2, __ATOMIC_ACQUIRE, __HIP_MEMORY_SCOPE_AGENT); __syncthreads(); }
                while (u < ntot + 1536 + 256) { Frame F2 = F; F2.bid = u - ntot - 1536; F2.G = 256; phase_gdn_post(F2, ap, layer, OAF, OAB, PJ); QNEXT(); }
#undef QNEXT
#if PROBE_MASK == 0x200000
                pr_t0 = __builtin_amdgcn_s_memrealtime();
#endif
                SEAM(); PEND(4);
#if PROBE_MASK == 0x200000
                pr_acc += __builtin_amdgcn_s_memrealtime() - pr_t0;
#endif
            }
            if (IN(5)) { REFRESH(); PSTART();
                phase_diff_combine(F, ap, layer, OC2, OCP);
#if PROBE_MASK == 0x80000
                pr_acc += __builtin_amdgcn_s_memrealtime() - pr_t0;
#endif
                SEAM(); PEND(5);
            }
            if (IN(6)) { REFRESH(); PSTART();
                { pg8::Gemm g{OAF, (const bf16*)(F.ws + OPQ(WS_WOA)), JR, DM, 1024, 1024, 1024, 128}; pg8::MultiOrder<3> S; S.init(JR, DM, F.G, F.bid);
                  static_assert(WS_WOB - WS_WOA == WS_WOC - WS_WOB, "merge weights must be equally spaced");
                  pg8::EpiMerge3 E{MG, GT, NGT, PJ + PJ_AQ, LDPJ, OAF, (const bf16*)(F.ws + OPQ(WS_WOA)), (long)((WS_OB - WS_OAF) / 2), (long)((WS_OCP - WS_OB) / 2) - (long)((WS_OB - WS_OAF) / 2), (long)((WS_WOB - WS_WOA) / 2)};
                  pg8::gemm_phase<pg8::EpiMerge3, pg8::MultiOrder<3>, PG8_ALIGN, PG8_SP2>(F.lds, g, S, E, F.wave); }
                SEAM(); PEND(6);
            }
            if (IN(9)) { REFRESH(); PSTART();
                pg8::Gemm g{MG, (const bf16*)(F.ws + OPQ(WS_WOUT)), JR, DM, DM, DM, DM, 128}; pg8::StaticOrder S; S.init(JR, DM, F.G, F.bid);
                if (layer == 0) { pg8::EpiResidToB E{X9B, XIN0}; pg8::gemm_phase<pg8::EpiResidToB, pg8::StaticOrder, PG8_ALIGN, PG8_SP2>(F.lds, g, S, E, F.wave); }
                else { pg8::EpiResidBB E{X9B, XLB}; pg8::gemm_phase<pg8::EpiResidBB, pg8::StaticOrder, PG8_ALIGN, PG8_SP2>(F.lds, g, S, E, F.wave); }
                SEAM(); PEND(9);
            }
            if (IN(10)) { REFRESH(); PSTART(); phase_rms_b(F, X9B, ap->in[20] + layer * DM, HB); SEAM(); PEND(10); }
            if (IN(11)) { REFRESH(); PSTART();
                pg8::Gemm g{HB, (const bf16*)(F.ws + OPQ(WS_WUP)), JR, NUP, DM, DM, DM, 128}; pg8::StaticOrder S; S.init(JR, NUP, F.G, F.bid);
                pg8::EpiConvAct E{ACT, UB, ap->in[22] + (size_t)layer * 3 * NUP, ap->in[23] + (size_t)layer * NUP, (PG8_LAS float*)(F.lds + LDSCTL_OFF + 2048)};
                pg8::gemm_phase<pg8::EpiConvAct, pg8::StaticOrder, PG8_ALIGN, PG8_SP2>(F.lds, g, S, E, F.wave);
                SEAM(); PEND(11);
            }
            if (IN(12)) { REFRESH(); PSTART();
                phase_conv_edges(F, ap, layer, UB, ACT, jg);
                __syncthreads();
                { pg8::Gemm g{PB, (const bf16*)(F.ws + OPQ(WS_WPLE)), JR, DM, PLE, PLE, PLE, 128}; pg8::StaticOrder S; S.init(JR, DM, F.G, F.bid);
                  pg8::EpiStoreBf16 E{PL, DM};
                  pg8::gemm_phase<pg8::EpiStoreBf16, pg8::StaticOrder, PG8_ALIGN, PG8_SP2>(F.lds, g, S, E, F.wave); }
                SEAM(); PEND(12);
            }
            if (IN(13)) { REFRESH(); PSTART();
                pg8::Gemm g{ACT, (const bf16*)(F.ws + OPQ(WS_WDOWN)), JR, DM, DFF, 64, DFF, (size_t)JR * 128};   pg8::StaticOrder S; S.init(JR, DM, F.G, F.bid);
                pg8::EpiResidBB E{X9B, X9B};
                pg8::gemm_phase<pg8::EpiResidBB, pg8::StaticOrder, PG8_ALIGN, PG8_SP2>(F.lds, g, S, E, F.wave);
                SEAM(); PEND(13);
            }
            if (IN(15)) { REFRESH(); PSTART();
                pg8::Gemm g{X9B, (const bf16*)(F.ws + OPQ(WS_WPG)), JR, DM, DM, DM, DM, 128}; pg8::StaticOrder S; S.init(JR, DM, F.G, F.bid);
                if (layer == NLAYER - 1) { pg8::EpiPleB E{ap->out + (size_t)jg.row0 * DM, X9B, PL}; pg8::gemm_phase<pg8::EpiPleB, pg8::StaticOrder, PG8_ALIGN, PG8_SP2>(F.lds, g, S, E, F.wave); }
                else { pg8::EpiPleBB E{XLB, X9B, PL}; pg8::gemm_phase<pg8::EpiPleBB, pg8::StaticOrder, PG8_ALIGN, PG8_SP2>(F.lds, g, S, E, F.wave); }
                if (job == NJOB - 1) { SEAM(); }
                PEND(15);
            }
        }
    }
    if (PROBE_MASK && F.bid == PROBE_BID) { const unsigned long long t0 = __builtin_amdgcn_s_memrealtime(); while (__builtin_amdgcn_s_memrealtime() - t0 < 4ull * pr_acc) __builtin_amdgcn_s_sleep(16); }
#undef SEAM
#undef IN
#undef HB
#undef XIN0
#undef AB
#undef PB
#undef GL
#undef OAF
#undef OAB
#undef OB
#undef OC2
#undef OCP
#undef X9B
#undef XLB
#undef PJ
#undef G1B
#undef GT
#undef MG
#undef UB
#undef ACT
#undef PL
#undef Win_t
}

#ifndef MK_ONE_LAUNCH
#define MK_ONE_LAUNCH 1
#endif
extern "C" void kernel_launch(void* const* d_in, const int* in_sizes, int n_in, void* d_out, int out_size, void* d_ws, size_t ws_size, hipStream_t stream) {
    static int grid = 0;
    if (grid == 0) {
        if (n_in != 27 || out_size != MALL * DM || ws_size < WS_END) { fprintf(stderr, "kernel_launch: unexpected shapes: n_in %d out %d ws %zu (need %zu)\n", n_in, out_size, ws_size, (size_t)WS_END); grid = -1; return; }
        int dev = 0, cus = 0, per_cu = 0;
        if (hipGetDevice(&dev) != hipSuccess || hipDeviceGetAttribute(&cus, hipDeviceAttributeMultiprocessorCount, dev) != hipSuccess) { grid = -1; return; }
        if (hipFuncSetAttribute((const void*)fwd_kernel, hipFuncAttributeMaxDynamicSharedMemorySize, LDS_BYTES) != hipSuccess) { fprintf(stderr, "kernel_launch: hipFuncSetAttribute failed\n"); grid = -1; return; }
        if (hipOccupancyMaxActiveBlocksPerMultiprocessor(&per_cu, (const void*)fwd_kernel, NTHREADS, LDS_BYTES) != hipSuccess || per_cu < 1) fprintf(stderr, "kernel_launch: occupancy query says %d\n", per_cu);
        (void)hipGetLastError();
        grid = cus;
    }
    if (grid < 0) return;
    (void)hipMemsetAsync((char*)d_ws + WS_CTL, 0, CTL_ZERO_BYTES, stream);
    Args a{};
    for (int i = 0; i < 27; ++i) a.in[i] = (const float*)d_in[i];
    a.out = (float*)d_out; a.ws = (unsigned char*)d_ws; a.dbg = 0;
#if MK_ONE_LAUNCH
    a.l0 = 0; a.l1 = NLAYER; a.j0 = 0; a.j1 = NJOB; a.ph_lo = 0; a.ph_hi = NPHASE; a.one_launch = 1;
    hipLaunchKernelGGL(fwd_kernel, dim3(grid), dim3(NTHREADS), LDS_BYTES, stream, a);
#else
    a.one_launch = 0;
    for (int l = 0; l < NLAYER; ++l) {
        a.l0 = l; a.l1 = l + 1; a.j0 = 0; a.j1 = 0; a.ph_lo = 0; a.ph_hi = 1;
        hipLaunchKernelGGL(fwd_kernel, dim3(grid), dim3(NTHREADS), LDS_BYTES, stream, a);
        for (int j = 0; j < NJOB; ++j) for (int p = 1; p < NPHASE; ++p) { a.j0 = j; a.j1 = j + 1; a.ph_lo = p; a.ph_hi = p + 1;
            hipLaunchKernelGGL(fwd_kernel, dim3(grid), dim3(NTHREADS), LDS_BYTES, stream, a); }
    }
#endif
    const hipError_t le = hipPeekAtLastError();
    if (le != hipSuccess) fprintf(stderr, "kernel_launch: launch failed: %s\n", hipGetErrorName(le));
}
```

```cpp
#include <hip/hip_runtime.h>
#include <cstdio>
#include <cstdint>
namespace pg8 {
#define PG8_LAS __attribute__((address_space(3)))
typedef unsigned short bf16_t;
typedef short bf16x8 __attribute__((ext_vector_type(8)));
typedef float f32x4 __attribute__((ext_vector_type(4)));
typedef unsigned u32x4 __attribute__((ext_vector_type(4)));
constexpr int BM = 256, BK = 64, HALF = 128, HTB = HALF * BK * 2  , STAGE_BYTES = 8 * HTB, NXCD = 8, WGM = 4;

__host__ __device__ __forceinline__ int lds_byte(int r, int c) { const int st = (r >> 4) * 2 + (c >> 5), rr = r & 15, cc = c & 31, ob = rr * 64 + cc * 2; return st * 1024 + (ob ^ (((ob >> 9) & 1) << 5)); }
__host__ __device__ __forceinline__ void stage_rc(int b, int& R, int& C) { const int st = b / 1024, sb = b % 1024, swz = sb ^ (((sb >> 9) & 1) << 5); R = (st >> 1) * 16 + swz / 64; C = (st & 1) * 32 + (swz % 64) / 2; }
__host__ __device__ __forceinline__ int perm32(int rho) { const int n = rho >> 4, i = rho & 15; return 8 * (i >> 2) + 4 * n + (i & 3); }

struct Unit { int pm, pn, x; };
struct Gemm { const bf16_t* A; const bf16_t* Bt; int M, N, K, lda, ldb; size_t ksa; };

struct StaticOrder {
    int nM, nN, nwg, G, c;
    __host__ __device__ void init(int M, int N, int G_, int c_) { nM = M / BM; nN = N / BM; nwg = nM * nN; G = G_; c = c_; }
    __host__ __device__ bool next(int i, Unit& u) const {
        const long L = (long)i * G + c; if (L >= nwg) return false;
        int wgid = (int)L; { const int q = nwg / NXCD, r = nwg % NXCD, xcd = wgid % NXCD, off = wgid / NXCD; wgid = (xcd < r ? xcd * (q + 1) : r * (q + 1) + (xcd - r) * q) + off; }
        const int nig = WGM * nN, gid = wgid / nig, fm = gid * WGM, gsz = (nM - fm) < WGM ? (nM - fm) : WGM;
        u.pm = fm + ((wgid % nig) % gsz); u.pn = (wgid % nig) / gsz; u.x = 0; return true;
    }
    __device__ __forceinline__ void a_ready(const Unit&) const {}
    __device__ __forceinline__ void done(const Unit&) const {}
};
template <class Epi> __device__ __forceinline__ const char* pg8_base_a(const Epi& E, const Gemm& g, const Unit& u) { if constexpr (Epi::MULTI) return (const char*)E.opA(u.x); else return (const char*)g.A; }
template <class Epi> __device__ __forceinline__ const char* pg8_base_b(const Epi& E, const Gemm& g, const Unit& u) { if constexpr (Epi::MULTI) return (const char*)E.opB(u.x); else return (const char*)g.Bt; }
template <class Epi, class Sched, bool ALIGN_EPI = false, bool SP2 = false>
__device__ __forceinline__ void gemm_phase(PG8_LAS unsigned char* lds, const Gemm g, const Sched& S, const Epi& E, int wave_in) {
    int tid_ = (wave_in << 6) | (int)__builtin_amdgcn_mbcnt_hi(~0u, __builtin_amdgcn_mbcnt_lo(~0u, 0u)); asm volatile("" : "+v"(tid_));
    const int tid = tid_, wid = __builtin_amdgcn_readfirstlane(tid >> 6), lane = tid & 63, wr = wid >> 2, wc = wid & 3, fr = lane & 15, fq = lane >> 4;
    const int K = g.K, nt = K / BK;
    unsigned voffA[2], voffB[2];
#pragma unroll
    for (int i = 0; i < 2; ++i) { int R, C; stage_rc(tid * 16 + i * 8192, R, C); const int Rb = Epi::PERM ? ((R & ~31) + perm32(R & 31)) : R;
        const int Ra = Epi::APERM ? ((R & ~63) + 4 * (R & 15) + ((R >> 4) & 3)) : R;
        voffA[i] = (unsigned)(Ra * g.lda + C) * 2u; voffB[i] = (unsigned)(Rb * g.ldb + C) * 2u; }
    const size_t kstep = (size_t)(BK * 2), kstepA = g.ksa;
    const size_t hstepA = (size_t)HALF * g.lda * 2, hstepB = (size_t)HALF * g.ldb * 2;
    const size_t tstepA = 2 * hstepA, tstepB = 2 * hstepB;
    const unsigned ldsw = (unsigned)wid * 1024u;
    const int aoff = lds_byte(wr * 64 + fr, fq * 8), boff = lds_byte(wc * 32 + fr, fq * 8);
#define PG8_SA(b, h) (((b) * 2 + (h)) * HTB)
#define PG8_SB(b, h) ((4 + (b) * 2 + (h)) * HTB)
#define PG8_STAGE(bufoff, gbase, voff) do { _Pragma("unroll") for (int _i = 0; _i < 2; ++_i) \
        __builtin_amdgcn_global_load_lds((const unsigned*)((const char*)(gbase) + (voff)[_i]), (PG8_LAS unsigned*)(lds + (bufoff) + ldsw + _i * 8192), 16, 0, 0); } while (0)
#define PG8_LDA(dst, b, h) do { _Pragma("unroll") for (int m = 0; m < 4; ++m) _Pragma("unroll") for (int k = 0; k < 2; ++k) dst[m][k] = *(const PG8_LAS bf16x8*)(lds + PG8_SA(b, h) + aoff + m * 2048 + k * 1024); } while (0)
#define PG8_LDB(dst, b, h) do { _Pragma("unroll") for (int n = 0; n < 2; ++n) _Pragma("unroll") for (int k = 0; k < 2; ++k) dst[n][k] = *(const PG8_LAS bf16x8*)(lds + PG8_SB(b, h) + boff + n * 2048 + k * 1024); } while (0)
#define PG8_MMA(ai, bj, At, Bt) do { __builtin_amdgcn_s_setprio(1); _Pragma("unroll") for (int m = 0; m < 4; ++m) _Pragma("unroll") for (int n = 0; n < 2; ++n) _Pragma("unroll") for (int k = 0; k < 2; ++k) \
        acc[ai][bj][m][n] = __builtin_amdgcn_mfma_f32_16x16x32_bf16(Bt[n][k], At[m][k], acc[ai][bj][m][n], 0, 0, 0); __builtin_amdgcn_s_setprio(0); } while (0)
#define PG8_WAIT_V(n) asm volatile("s_waitcnt vmcnt(" #n ")" ::: "memory")
#define PG8_WAIT_L(n) asm volatile("s_waitcnt lgkmcnt(" #n ")" ::: "memory")
#define PG8_BAR __builtin_amdgcn_s_barrier()
#define PG8_SCHED __builtin_amdgcn_sched_barrier(0)
    Unit cur, nxt; int ui = 0;
    if (!S.next(0, cur)) return;
    f32x4 acc[2][2][4][2];
#pragma unroll
    for (int a = 0; a < 2; ++a)
#pragma unroll
        for (int b = 0; b < 2; ++b)
#pragma unroll
            for (int m = 0; m < 4; ++m)
#pragma unroll
                for (int n = 0; n < 2; ++n) acc[a][b][m][n] = (f32x4){0.f, 0.f, 0.f, 0.f};
    bf16x8 At[4][2], B0[2][2], B1[2][2];
#define PG8_BASEA(u_) pg8_base_a(E, g, (u_))
#define PG8_BASEB(u_) pg8_base_b(E, g, (u_))
    const char* cA = PG8_BASEA(cur) + (size_t)cur.pm * tstepA; const char* cB = PG8_BASEB(cur) + (size_t)cur.pn * tstepB;
    S.a_ready(cur);
    if constexpr (SP2) {
        PG8_STAGE(PG8_SB(0, 0), cB, voffB); PG8_STAGE(PG8_SB(0, 1), cB + hstepB, voffB); PG8_STAGE(PG8_SA(0, 0), cA, voffA); PG8_STAGE(PG8_SA(0, 1), cA + hstepA, voffA);
        if (wr == 1) PG8_BAR;
        PG8_WAIT_V(2); PG8_BAR;
        PG8_STAGE(PG8_SB(1, 0), cB + kstep, voffB); PG8_STAGE(PG8_SA(1, 0), cA + kstepA, voffA); PG8_STAGE(PG8_SB(1, 1), cB + hstepB + kstep, voffB);
        PG8_WAIT_V(6); PG8_BAR;
    } else {
        PG8_STAGE(PG8_SB(0, 0), cB, voffB); PG8_STAGE(PG8_SA(0, 0), cA, voffA); PG8_STAGE(PG8_SB(0, 1), cB + hstepB, voffB); PG8_STAGE(PG8_SA(0, 1), cA + hstepA, voffA);
        if (wr == 1) PG8_BAR;
        PG8_WAIT_V(4); PG8_BAR;
        PG8_STAGE(PG8_SB(1, 0), cB + kstep, voffB); PG8_STAGE(PG8_SA(1, 0), cA + kstepA, voffA); PG8_STAGE(PG8_SB(1, 1), cB + hstepB + kstep, voffB);
        PG8_WAIT_V(6); PG8_BAR;
    }
    for (;;) {
        const bool has_next = S.next(ui + 1, nxt);
        const char* nA = has_next ? PG8_BASEA(nxt) + (size_t)nxt.pm * tstepA : cA; const char* nB = has_next ? PG8_BASEB(nxt) + (size_t)nxt.pn * tstepB : cB;
        for (int t = 0; t < nt; t += 2) {
            const bool last = (t == nt - 2);
            const char* a1 = cA + (size_t)(t + 1) * kstepA;
            const char* a2 = last ? nA : cA + (size_t)(t + 2) * kstepA; const char* b2 = last ? nB : cB + (size_t)(t + 2) * kstep;
            const char* a3 = a2 + kstepA; const char* b3 = b2 + kstep;
            if (last && has_next) S.a_ready(nxt);
            if constexpr (SP2) {
            PG8_LDB(B0, 0, 0); PG8_LDB(B1, 0, 1); PG8_SCHED; PG8_LDA(At, 0, 0); PG8_STAGE(PG8_SA(1, 1), a1 + hstepA, voffA);
            PG8_WAIT_V(8); PG8_WAIT_L(0); PG8_BAR; PG8_MMA(0, 0, At, B0); PG8_MMA(0, 1, At, B1); PG8_BAR; PG8_SCHED;
            PG8_LDA(At, 0, 1); PG8_STAGE(PG8_SB(0, 0), b2, voffB); PG8_STAGE(PG8_SB(0, 1), b2 + hstepB, voffB); PG8_STAGE(PG8_SA(0, 0), a2, voffA);
            PG8_WAIT_V(8); PG8_WAIT_L(0); PG8_BAR; PG8_MMA(1, 0, At, B0); PG8_MMA(1, 1, At, B1); PG8_BAR; PG8_SCHED;
            PG8_LDB(B0, 1, 0); PG8_LDB(B1, 1, 1); PG8_SCHED; PG8_LDA(At, 1, 0); PG8_STAGE(PG8_SA(0, 1), a2 + hstepA, voffA);
            PG8_WAIT_V(8); PG8_WAIT_L(0); PG8_BAR; PG8_MMA(0, 0, At, B0); PG8_MMA(0, 1, At, B1); PG8_BAR; PG8_SCHED;
            PG8_LDA(At, 1, 1); PG8_STAGE(PG8_SB(1, 0), b3, voffB); PG8_STAGE(PG8_SB(1, 1), b3 + hstepB, voffB); PG8_STAGE(PG8_SA(1, 0), a3, voffA);
            PG8_WAIT_V(8); PG8_WAIT_L(0); PG8_BAR; PG8_MMA(1, 0, At, B0); PG8_MMA(1, 1, At, B1); PG8_BAR; PG8_SCHED;
            } else {
            PG8_LDB(B0, 0, 0); PG8_SCHED; PG8_LDA(At, 0, 0); PG8_STAGE(PG8_SA(1, 1), a1 + hstepA, voffA);
            PG8_WAIT_L(8); PG8_BAR; PG8_WAIT_L(0); PG8_MMA(0, 0, At, B0); PG8_BAR; PG8_SCHED;
            PG8_LDB(B1, 0, 1); PG8_STAGE(PG8_SB(0, 0), b2, voffB);
            PG8_BAR; PG8_WAIT_L(0); PG8_MMA(0, 1, At, B1); PG8_BAR;
            PG8_LDA(At, 0, 1); PG8_STAGE(PG8_SA(0, 0), a2, voffA);
            PG8_BAR; PG8_WAIT_L(0); PG8_MMA(1, 0, At, B0); PG8_BAR; PG8_SCHED;
            PG8_STAGE(PG8_SB(0, 1), b2 + hstepB, voffB);
            PG8_WAIT_V(6); PG8_BAR; PG8_MMA(1, 1, At, B1); PG8_BAR;
            PG8_LDB(B0, 1, 0); PG8_SCHED; PG8_LDA(At, 1, 0); PG8_STAGE(PG8_SA(0, 1), a2 + hstepA, voffA);
            PG8_WAIT_L(8); PG8_BAR; PG8_WAIT_L(0); PG8_MMA(0, 0, At, B0); PG8_BAR; PG8_SCHED;
            PG8_LDB(B1, 1, 1); PG8_STAGE(PG8_SB(1, 0), b3, voffB);
            PG8_BAR; PG8_WAIT_L(0); PG8_MMA(0, 1, At, B1); PG8_BAR;
            PG8_LDA(At, 1, 1); PG8_STAGE(PG8_SA(1, 0), a3, voffA);
            PG8_BAR; PG8_WAIT_L(0); PG8_MMA(1, 0, At, B0); PG8_BAR; PG8_SCHED;
            PG8_STAGE(PG8_SB(1, 1), b3 + hstepB, voffB);
            PG8_WAIT_V(6); PG8_BAR; PG8_MMA(1, 1, At, B1); PG8_BAR;
            }
        }
        if constexpr (ALIGN_EPI) { if (wr == 0) PG8_BAR; }
        bool keep_acc = false;
        int te_ = (int)__builtin_amdgcn_mbcnt_hi(~0u, __builtin_amdgcn_mbcnt_lo(~0u, 0u)); asm volatile("" : "+v"(te_)); const int fr_e = te_ & 15, fq_e = (te_ & 63) >> 4;
        if constexpr (Epi::MULTI) { if (cur.x < Epi::NSUB - 1) { E.rescale(acc, cur, wr, wc, fr_e, fq_e); keep_acc = true; } else E(acc, cur, wr, wc, fr_e, fq_e); }
        else if constexpr (!Epi::AFTER_DRAIN) { E(acc, cur, wr, wc, fr_e, fq_e); S.done(cur); }
        if (!has_next) break;
        if (!keep_acc) {
#pragma unroll
        for (int a = 0; a < 2; ++a)
#pragma unroll
            for (int b = 0; b < 2; ++b)
#pragma unroll
                for (int m = 0; m < 4; ++m)
#pragma unroll
                    for (int n = 0; n < 2; ++n) acc[a][b][m][n] = (f32x4){0.f, 0.f, 0.f, 0.f}; }
        cur = nxt; cA = nA; cB = nB; ++ui;
        if constexpr (ALIGN_EPI) { if (wr == 1) PG8_BAR; }
    }
    PG8_WAIT_V(0);
    if constexpr (!ALIGN_EPI) { if (wr == 0) PG8_BAR; }
    PG8_BAR;
    if constexpr (Epi::AFTER_DRAIN) { E.fused(acc, cur, wr, wc, fr, fq, lds, wid, lane); S.done(cur); }
#undef PG8_BASEA
#undef PG8_BASEB
#undef PG8_SA
#undef PG8_SB
#undef PG8_STAGE
#undef PG8_LDA
#undef PG8_LDB
#undef PG8_MMA
#undef PG8_WAIT_V
#undef PG8_WAIT_L
#undef PG8_BAR
#undef PG8_SCHED
}
typedef __bf16 hbf2_t __attribute__((ext_vector_type(2)));
typedef float f32x2_t __attribute__((ext_vector_type(2)));
typedef unsigned u32x2 __attribute__((ext_vector_type(2)));
__device__ __forceinline__ unsigned pk2(float lo, float hi) { hbf2_t r = __builtin_convertvector((f32x2_t){lo, hi}, hbf2_t); return __builtin_bit_cast(unsigned, r); }
__device__ __forceinline__ float bflo(unsigned w) { return __uint_as_float(w << 16); }
__device__ __forceinline__ float bfhi(unsigned w) { return __uint_as_float(w & 0xffff0000u); }
__device__ __forceinline__ float sigmoidf_(float x) { return __builtin_amdgcn_rcpf(1.0f + __expf(-x)); }
__device__ __forceinline__ u32x4 pack8(const f32x4& a, const f32x4& b) { u32x4 w; w.x = pk2(a[0], a[1]); w.y = pk2(a[2], a[3]); w.z = pk2(b[0], b[1]); w.w = pk2(b[2], b[3]); return w; }
#define PG8_EPI_ARGS const f32x4 (&acc)[2][2][4][2], const Unit& u, int wr, int wc, int fr, int fq

struct EpiStoreBf16 { static constexpr bool PERM = true, AFTER_DRAIN = false, MULTI = false, APERM = false; bf16_t* O; int ldc;
    __device__ __forceinline__ void operator()(PG8_EPI_ARGS) const {
        const int row0 = u.pm * BM + wr * 64 + fr, col0 = u.pn * BM + wc * 32 + 8 * fq;
#pragma unroll
        for (int ai = 0; ai < 2; ++ai)
#pragma unroll
            for (int m = 0; m < 4; ++m) { bf16_t* rowp = O + (size_t)(row0 + ai * HALF + m * 16) * ldc + col0;
#pragma unroll
                for (int bj = 0; bj < 2; ++bj) *(u32x4*)(rowp + bj * HALF) = pack8(acc[ai][bj][m][0], acc[ai][bj][m][1]); }
    }
};
struct EpiProj { static constexpr bool PERM = true, AFTER_DRAIN = false, MULTI = false, APERM = false; bf16_t* PJ; float* AB;
    __device__ __forceinline__ void operator()(PG8_EPI_ARGS) const {
        const int row0 = u.pm * BM + wr * 64 + fr;
        if (u.pn < 34) { const int col0 = u.pn * BM + wc * 32 + 8 * fq;
#pragma unroll
            for (int ai = 0; ai < 2; ++ai)
#pragma unroll
                for (int m = 0; m < 4; ++m) { bf16_t* rowp = PJ + (size_t)(row0 + ai * HALF + m * 16) * 8704 + col0;
#pragma unroll
                    for (int bj = 0; bj < 2; ++bj) *(u32x4*)(rowp + bj * HALF) = pack8(acc[ai][bj][m][0], acc[ai][bj][m][1]); }
        } else if (wc == 0) {
#pragma unroll
            for (int ai = 0; ai < 2; ++ai)
#pragma unroll
                for (int m = 0; m < 4; ++m) { float* rp = AB + (size_t)(row0 + ai * HALF + m * 16) * 32 + 8 * fq;
                    *(f32x4*)rp = acc[ai][0][m][0]; *(f32x4*)(rp + 4) = acc[ai][0][m][1]; }
        }
    }
};
struct EpiSigmoid { static constexpr bool PERM = true, AFTER_DRAIN = false, MULTI = false, APERM = false; bf16_t* O; int ldc;
    __device__ __forceinline__ void operator()(PG8_EPI_ARGS) const {
        const int row0 = u.pm * BM + wr * 64 + fr, col0 = u.pn * BM + wc * 32 + 8 * fq;
#pragma unroll
        for (int ai = 0; ai < 2; ++ai)
#pragma unroll
            for (int m = 0; m < 4; ++m) { bf16_t* rowp = O + (size_t)(row0 + ai * HALF + m * 16) * ldc + col0;
#pragma unroll
                for (int bj = 0; bj < 2; ++bj) { f32x4 a = acc[ai][bj][m][0], b = acc[ai][bj][m][1];
#pragma unroll
                    for (int j = 0; j < 4; ++j) { a[j] = sigmoidf_(a[j]); b[j] = sigmoidf_(b[j]); }
                    *(u32x4*)(rowp + bj * HALF) = pack8(a, b); } }
    }
};
template <bool FIRST> struct EpiMerge { static constexpr bool PERM = true, AFTER_DRAIN = false, MULTI = false, APERM = false; bf16_t* MG; const bf16_t* G; int ldg;
    __device__ __forceinline__ void operator()(PG8_EPI_ARGS) const {
        const int row0 = u.pm * BM + wr * 64 + fr, col0 = u.pn * BM + wc * 32 + 8 * fq;
#pragma unroll
        for (int ai = 0; ai < 2; ++ai)
#pragma unroll
            for (int m = 0; m < 4; ++m) { const size_t r = (size_t)(row0 + ai * HALF + m * 16); bf16_t* mp = MG + r * 2048 + col0; const bf16_t* gp = G + r * ldg + col0;
#pragma unroll
                for (int bj = 0; bj < 2; ++bj) { const u32x4 gw = *(const u32x4*)(gp + bj * HALF); f32x4 a = acc[ai][bj][m][0], b = acc[ai][bj][m][1];
                    a[0] *= bflo(gw.x); a[1] *= bfhi(gw.x); a[2] *= bflo(gw.y); a[3] *= bfhi(gw.y); b[0] *= bflo(gw.z); b[1] *= bfhi(gw.z); b[2] *= bflo(gw.w); b[3] *= bfhi(gw.w);
                    if (!FIRST) { const u32x4 ow = *(const u32x4*)(mp + bj * HALF);
                        a[0] += bflo(ow.x); a[1] += bfhi(ow.x); a[2] += bflo(ow.y); a[3] += bfhi(ow.y); b[0] += bflo(ow.z); b[1] += bfhi(ow.z); b[2] += bflo(ow.w); b[3] += bfhi(ow.w); }
                    *(u32x4*)(mp + bj * HALF) = pack8(a, b); } }
    }
};
template <bool WRITE_XB> struct EpiResid { static constexpr bool PERM = false, AFTER_DRAIN = false, MULTI = false, APERM = false; float* X; bf16_t* XB; const float* Xin;
    __device__ __forceinline__ void operator()(PG8_EPI_ARGS) const {
        const int row0 = u.pm * BM + wr * 64 + fr, col0 = u.pn * BM + wc * 32 + 4 * fq;
#pragma unroll
        for (int ai = 0; ai < 2; ++ai)
#pragma unroll
            for (int m = 0; m < 4; ++m) { const size_t off = (size_t)(row0 + ai * HALF + m * 16) * 2048 + col0;
#pragma unroll
                for (int bj = 0; bj < 2; ++bj)
#pragma unroll
                    for (int n = 0; n < 2; ++n) { const size_t o = off + bj * HALF + n * 16; const f32x4 v = *(const f32x4*)(Xin + o) + acc[ai][bj][m][n]; *(f32x4*)(X + o) = v;
                        if (WRITE_XB) { u32x2 w; w.x = pk2(v[0], v[1]); w.y = pk2(v[2], v[3]); *(u32x2*)(XB + o) = w; } } }
    }
};
struct EpiPle { static constexpr bool PERM = false, AFTER_DRAIN = false, MULTI = false, APERM = false; float* X; const bf16_t* PL;
    __device__ __forceinline__ void operator()(PG8_EPI_ARGS) const {
        const int row0 = u.pm * BM + wr * 64 + fr, col0 = u.pn * BM + wc * 32 + 4 * fq;
#pragma unroll
        for (int ai = 0; ai < 2; ++ai)
#pragma unroll
            for (int m = 0; m < 4; ++m) { const size_t off = (size_t)(row0 + ai * HALF + m * 16) * 2048 + col0;
#pragma unroll
                for (int bj = 0; bj < 2; ++bj)
#pragma unroll
                    for (int n = 0; n < 2; ++n) { const size_t o = off + bj * HALF + n * 16; const u32x2 pw = *(const u32x2*)(PL + o); const f32x4 a = acc[ai][bj][m][n]; f32x4 v = *(const f32x4*)(X + o);
                        v[0] += sigmoidf_(a[0]) * bflo(pw.x); v[1] += sigmoidf_(a[1]) * bfhi(pw.x); v[2] += sigmoidf_(a[2]) * bflo(pw.y); v[3] += sigmoidf_(a[3]) * bfhi(pw.y);
                        *(f32x4*)(X + o) = v; } }
    }
};
struct EpiResidToB { static constexpr bool PERM = true, AFTER_DRAIN = false, MULTI = false, APERM = false; bf16_t* XB; const float* Xin;
    __device__ __forceinline__ void operator()(PG8_EPI_ARGS) const {
        const int row0 = u.pm * BM + wr * 64 + fr, col0 = u.pn * BM + wc * 32 + 8 * fq;
#pragma unroll
        for (int ai = 0; ai < 2; ++ai)
#pragma unroll
            for (int m = 0; m < 4; ++m) { const size_t off = (size_t)(row0 + ai * HALF + m * 16) * 2048 + col0;
#pragma unroll
                for (int bj = 0; bj < 2; ++bj) { const size_t o = off + bj * HALF; const f32x4 a = *(const f32x4*)(Xin + o) + acc[ai][bj][m][0], b = *(const f32x4*)(Xin + o + 4) + acc[ai][bj][m][1];
                    *(u32x4*)(XB + o) = pack8(a, b); } }
    }
};
struct EpiResidBB { static constexpr bool PERM = true, AFTER_DRAIN = false, MULTI = false, APERM = false; bf16_t* XBo; const bf16_t* XBi;
    __device__ __forceinline__ void operator()(PG8_EPI_ARGS) const {
        const int row0 = u.pm * BM + wr * 64 + fr, col0 = u.pn * BM + wc * 32 + 8 * fq;
#pragma unroll
        for (int ai = 0; ai < 2; ++ai)
#pragma unroll
            for (int m = 0; m < 4; ++m) { const size_t off = (size_t)(row0 + ai * HALF + m * 16) * 2048 + col0;
#pragma unroll
                for (int bj = 0; bj < 2; ++bj) { const size_t o = off + bj * HALF; const u32x4 w = *(const u32x4*)(XBi + o); f32x4 a = acc[ai][bj][m][0], b = acc[ai][bj][m][1];
                    a[0] += bflo(w.x); a[1] += bfhi(w.x); a[2] += bflo(w.y); a[3] += bfhi(w.y); b[0] += bflo(w.z); b[1] += bfhi(w.z); b[2] += bflo(w.w); b[3] += bfhi(w.w);
                    *(u32x4*)(XBo + o) = pack8(a, b); } }
    }
};
struct EpiPleB { static constexpr bool PERM = true, AFTER_DRAIN = false, MULTI = false, APERM = false; float* X; const bf16_t* XB; const bf16_t* PL;
    __device__ __forceinline__ void operator()(PG8_EPI_ARGS) const {
        const int row0 = u.pm * BM + wr * 64 + fr, col0 = u.pn * BM + wc * 32 + 8 * fq;
#pragma unroll
        for (int ai = 0; ai < 2; ++ai)
#pragma unroll
            for (int m = 0; m < 4; ++m) { const size_t off = (size_t)(row0 + ai * HALF + m * 16) * 2048 + col0;
#pragma unroll
                for (int bj = 0; bj < 2; ++bj) { const size_t o = off + bj * HALF; const u32x4 xw = *(const u32x4*)(XB + o), pw = *(const u32x4*)(PL + o); const f32x4 a = acc[ai][bj][m][0], b = acc[ai][bj][m][1]; f32x4 v0, v1;
                    v0[0] = bflo(xw.x) + sigmoidf_(a[0]) * bflo(pw.x); v0[1] = bfhi(xw.x) + sigmoidf_(a[1]) * bfhi(pw.x); v0[2] = bflo(xw.y) + sigmoidf_(a[2]) * bflo(pw.y); v0[3] = bfhi(xw.y) + sigmoidf_(a[3]) * bfhi(pw.y);
                    v1[0] = bflo(xw.z) + sigmoidf_(b[0]) * bflo(pw.z); v1[1] = bfhi(xw.z) + sigmoidf_(b[1]) * bfhi(pw.z); v1[2] = bflo(xw.w) + sigmoidf_(b[2]) * bflo(pw.w); v1[3] = bfhi(xw.w) + sigmoidf_(b[3]) * bfhi(pw.w);
                    *(f32x4*)(X + o) = v0; *(f32x4*)(X + o + 4) = v1; } }
    }
};
struct EpiPleBB { static constexpr bool PERM = true, AFTER_DRAIN = false, MULTI = false, APERM = false; bf16_t* XBo; const bf16_t* XB; const bf16_t* PL;
    __device__ __forceinline__ void operator()(PG8_EPI_ARGS) const {
        const int row0 = u.pm * BM + wr * 64 + fr, col0 = u.pn * BM + wc * 32 + 8 * fq;
#pragma unroll
        for (int ai = 0; ai < 2; ++ai)
#pragma unroll
            for (int m = 0; m < 4; ++m) { const size_t off = (size_t)(row0 + ai * HALF + m * 16) * 2048 + col0;
#pragma unroll
                for (int bj = 0; bj < 2; ++bj) { const size_t o = off + bj * HALF; const u32x4 xw = *(const u32x4*)(XB + o), pw = *(const u32x4*)(PL + o); const f32x4 a = acc[ai][bj][m][0], b = acc[ai][bj][m][1]; f32x4 v0, v1;
                    v0[0] = bflo(xw.x) + sigmoidf_(a[0]) * bflo(pw.x); v0[1] = bfhi(xw.x) + sigmoidf_(a[1]) * bfhi(pw.x); v0[2] = bflo(xw.y) + sigmoidf_(a[2]) * bflo(pw.y); v0[3] = bfhi(xw.y) + sigmoidf_(a[3]) * bfhi(pw.y);
                    v1[0] = bflo(xw.z) + sigmoidf_(b[0]) * bflo(pw.z); v1[1] = bfhi(xw.z) + sigmoidf_(b[1]) * bfhi(pw.z); v1[2] = bflo(xw.w) + sigmoidf_(b[2]) * bflo(pw.w); v1[3] = bfhi(xw.w) + sigmoidf_(b[3]) * bfhi(pw.w);
                    *(u32x4*)(XBo + o) = pack8(v0, v1); } }
    }
};
constexpr int CA_NUP = 11264, CA_DFF = 5632, CA_JR = 16384;
template <int CTRL> __device__ __forceinline__ float dppf(float old, float v) { return __builtin_bit_cast(float, __builtin_amdgcn_update_dpp(__builtin_bit_cast(int, old), __builtin_bit_cast(int, v), CTRL, 0xF, 0xF, false)); }
struct EpiConvAct { static constexpr bool PERM = true, AFTER_DRAIN = false, MULTI = false, APERM = true; bf16_t* ACT; bf16_t* UH; const float* cw; const float* cb; PG8_LAS float* xl;
    __device__ __forceinline__ void operator()(PG8_EPI_ARGS) const {
        const int wv = wr * 4 + wc, cg = u.pn * 128 + wc * 32 + 8 * fq;
#pragma unroll
        for (int ai = 0; ai < 2; ++ai)
#pragma unroll
            for (int bj = 0; bj < 2; ++bj) {
                if (fr == 0) { PG8_LAS float* p = xl + ((((wv * 2 + ai) * 2 + 0) * 2 + bj) * 4 + fq) * 8; *(PG8_LAS f32x4*)p = acc[ai][bj][0][0]; *(PG8_LAS f32x4*)(p + 4) = acc[ai][bj][0][1]; }
                if (fr == 15) { PG8_LAS float* p = xl + ((((wv * 2 + ai) * 2 + 1) * 2 + bj) * 4 + fq) * 8; *(PG8_LAS f32x4*)p = acc[ai][bj][3][0]; *(PG8_LAS f32x4*)(p + 4) = acc[ai][bj][3][1]; } }
        asm volatile("s_waitcnt lgkmcnt(0)" ::: "memory"); __builtin_amdgcn_s_barrier(); asm volatile("" ::: "memory");
        { const bool top = (wr == 0) && (fr == 0), bot = (wr == 1) && (fr == 15);
          if (top) { bf16_t* hp = UH + (size_t)(u.pm * 4) * CA_NUP + cg;
              *(u32x4*)hp = pack8(acc[0][0][0][0], acc[0][0][0][1]); *(u32x4*)(hp + CA_DFF) = pack8(acc[0][1][0][0], acc[0][1][0][1]);
              *(u32x4*)(hp + CA_NUP) = pack8(acc[0][0][1][0], acc[0][0][1][1]); *(u32x4*)(hp + CA_NUP + CA_DFF) = pack8(acc[0][1][1][0], acc[0][1][1][1]); }
          if (bot) { bf16_t* hp = UH + (size_t)(u.pm * 4 + 2) * CA_NUP + cg;
              *(u32x4*)hp = pack8(acc[1][0][2][0], acc[1][0][2][1]); *(u32x4*)(hp + CA_DFF) = pack8(acc[1][1][2][0], acc[1][1][2][1]);
              *(u32x4*)(hp + CA_NUP) = pack8(acc[1][0][3][0], acc[1][0][3][1]); *(u32x4*)(hp + CA_NUP + CA_DFF) = pack8(acc[1][1][3][0], acc[1][1][3][1]); } }
#pragma unroll
        for (int n = 0; n < 2; ++n) {
            f32x4 wg[3], wvv[3];
#pragma unroll
            for (int tp = 0; tp < 3; ++tp) { wg[tp] = *(const f32x4*)(cw + (size_t)tp * CA_NUP + cg + 4 * n); wvv[tp] = *(const f32x4*)(cw + (size_t)tp * CA_NUP + CA_DFF + cg + 4 * n); }
            const f32x4 bg = *(const f32x4*)(cb + cg + 4 * n), bv = *(const f32x4*)(cb + CA_DFF + cg + 4 * n);
#pragma unroll
            for (int ai = 0; ai < 2; ++ai) {
                const int pw_ = (wr == 1) ? wc : 4 + wc, pa_ = (wr == 1) ? ai : 0;
                const int nw_ = (wr == 0) ? 4 + wc : wc, na_ = (wr == 0) ? ai : 1;
#pragma unroll
                for (int m = 0; m < 4; ++m) {
                    __builtin_amdgcn_sched_barrier(0);
                    f32x4 y[2];
#pragma unroll
                    for (int bj = 0; bj < 2; ++bj) {
                        f32x4 xe = {0.f, 0.f, 0.f, 0.f};
                        if (m == 0) xe = *(const PG8_LAS f32x4*)(xl + ((((pw_ * 2 + pa_) * 2 + 1) * 2 + bj) * 4 + fq) * 8 + 4 * n);
                        if (m == 3) xe = *(const PG8_LAS f32x4*)(xl + ((((nw_ * 2 + na_) * 2 + 0) * 2 + bj) * 4 + fq) * 8 + 4 * n);
#pragma unroll
                        for (int j = 0; j < 4; ++j) { const float cur = acc[ai][bj][m][n][j];
                            const float pv = (m > 0) ? acc[ai][bj][m > 0 ? m - 1 : 0][n][j] : dppf<0x111>(xe[j], acc[ai][bj][3][n][j]);
                            const float nv = (m < 3) ? acc[ai][bj][m < 3 ? m + 1 : 3][n][j] : dppf<0x101>(xe[j], acc[ai][bj][0][n][j]);
                            const f32x4& w0 = bj ? wvv[0] : wg[0]; const f32x4& w1 = bj ? wvv[1] : wg[1]; const f32x4& w2 = bj ? wvv[2] : wg[2]; const f32x4& bb = bj ? bv : bg;
                            y[bj][j] = w0[j] * pv + w1[j] * cur + w2[j] * nv + bb[j]; } }
                    f32x4 o;
#pragma unroll
                    for (int j = 0; j < 4; ++j) o[j] = y[0][j] * sigmoidf_(y[0][j]) * y[1][j];
                    const int tr = 128 * ai + 64 * wr + 4 * fr + m;
                    if (tr != 0 && tr != 255) { u32x2 w; w.x = pk2(o[0], o[1]); w.y = pk2(o[2], o[3]);
                        *(u32x2*)(ACT + ((size_t)(cg >> 6) * CA_JR + (size_t)(u.pm * BM + tr)) * 64 + (cg & 63) + 4 * n) = w; }
                }
            }
        }
    }
};
struct EpiStoreBf16RS { static constexpr bool PERM = true, AFTER_DRAIN = false, MULTI = false, APERM = false; bf16_t* O; int ldc; const float* SS;
    __device__ __forceinline__ void operator()(PG8_EPI_ARGS) const {
        const int row0 = u.pm * BM + wr * 64 + fr, col0 = u.pn * BM + wc * 32 + 8 * fq;
#pragma unroll
        for (int ai = 0; ai < 2; ++ai)
#pragma unroll
            for (int m = 0; m < 4; ++m) { asm volatile("" ::: "memory");
                const int row = row0 + ai * HALF + m * 16; const float rs = rsqrtf(SS[row] * (1.0f / 2048.0f) + 1e-6f); bf16_t* rowp = O + (size_t)row * ldc + col0;
#pragma unroll
                for (int bj = 0; bj < 2; ++bj) *(u32x4*)(rowp + bj * HALF) = pack8(acc[ai][bj][m][0] * rs, acc[ai][bj][m][1] * rs); }
    }
};
struct EpiResidSS { static constexpr bool PERM = false, AFTER_DRAIN = false, MULTI = false, APERM = false; float* X; bf16_t* XB; float* SS;
    __device__ __forceinline__ void operator()(PG8_EPI_ARGS) const {
        const int row0 = u.pm * BM + wr * 64 + fr, col0 = u.pn * BM + wc * 32 + 4 * fq;
        float sqv[8];
#pragma unroll
        for (int ai = 0; ai < 2; ++ai)
#pragma unroll
            for (int m = 0; m < 4; ++m) { const int row = row0 + ai * HALF + m * 16; const size_t off = (size_t)row * 2048 + col0; float sq = 0.f;
#pragma unroll
                for (int bj = 0; bj < 2; ++bj)
#pragma unroll
                    for (int n = 0; n < 2; ++n) { const size_t o = off + bj * HALF + n * 16; const f32x4 v = *(const f32x4*)(X + o) + acc[ai][bj][m][n]; *(f32x4*)(X + o) = v;
                        u32x2 w; w.x = pk2(v[0], v[1]); w.y = pk2(v[2], v[3]); *(u32x2*)(XB + o) = w; sq += (v[0] * v[0] + v[1] * v[1]) + (v[2] * v[2] + v[3] * v[3]); }
                sq += __shfl_xor(sq, 16); sq += __shfl_xor(sq, 32); sqv[ai * 4 + m] = sq; }
        if (fq == 0) {
#pragma unroll
            for (int q = 0; q < 8; ++q) atomicAdd(SS + row0 + (q >> 2) * HALF + (q & 3) * 16, sqv[q]); }
    }
};
struct EpiMerge3 { static constexpr bool PERM = true, AFTER_DRAIN = false, MULTI = true, APERM = false; static constexpr int NSUB = 3;
    bf16_t* MG; const bf16_t* G; int ldg; const bf16_t* Ga; int ldga; const bf16_t* A0; const bf16_t* B0; long dA, ddA, dB;
    __device__ __forceinline__ const bf16_t* opA(int x) const { return A0 + (long)x * dA + (long)((x * (x - 1)) >> 1) * ddA; }
    __device__ __forceinline__ const bf16_t* opB(int x) const { return B0 + (long)x * dB; }
    __device__ __forceinline__ void rescale(f32x4 (&acc)[2][2][4][2], const Unit& u, int wr, int wc, int fr, int fq) const {
        const int row0 = u.pm * BM + wr * 64 + fr, col0 = u.pn * BM + wc * 32 + 8 * fq;
        const bool first = u.x == 0; const bf16_t* nb = first ? Ga : G + u.x * 2048; const size_t nld = first ? (size_t)ldga : (size_t)ldg;
#pragma unroll
        for (int ai = 0; ai < 2; ++ai)
#pragma unroll
            for (int m = 0; m < 4; ++m) { const size_t r = (size_t)(row0 + ai * HALF + m * 16); const bf16_t* gp = G + r * ldg + u.x * 2048 + col0; const bf16_t* np = nb + r * nld + col0;
#pragma unroll
                for (int bj = 0; bj < 2; ++bj) { const u32x4 gn = *(const u32x4*)(np + bj * HALF), gd = *(const u32x4*)(gp + 2048 + bj * HALF);
#define R_(num, den) (fmaxf(num, 1e-30f) * __builtin_amdgcn_rcpf(fmaxf(den, 1e-30f)))
                    f32x4 a = acc[ai][bj][m][0], b = acc[ai][bj][m][1];
                    a[0] *= R_(bflo(gn.x), bflo(gd.x)); a[1] *= R_(bfhi(gn.x), bfhi(gd.x)); a[2] *= R_(bflo(gn.y), bflo(gd.y)); a[3] *= R_(bfhi(gn.y), bfhi(gd.y));
                    b[0] *= R_(bflo(gn.z), bflo(gd.z)); b[1] *= R_(bfhi(gn.z), bfhi(gd.z)); b[2] *= R_(bflo(gn.w), bflo(gd.w)); b[3] *= R_(bfhi(gn.w), bfhi(gd.w));
                    acc[ai][bj][m][0] = a; acc[ai][bj][m][1] = b;
#undef R_
                } }
    }
    __device__ __forceinline__ void operator()(PG8_EPI_ARGS) const {
        const int row0 = u.pm * BM + wr * 64 + fr, col0 = u.pn * BM + wc * 32 + 8 * fq;
#pragma unroll
        for (int ai = 0; ai < 2; ++ai)
#pragma unroll
            for (int m = 0; m < 4; ++m) { const size_t r = (size_t)(row0 + ai * HALF + m * 16); bf16_t* mp = MG + r * 2048 + col0; const bf16_t* gp = G + r * ldg + 4096 + col0;
#pragma unroll
                for (int bj = 0; bj < 2; ++bj) { const u32x4 gw = *(const u32x4*)(gp + bj * HALF); f32x4 a = acc[ai][bj][m][0], b = acc[ai][bj][m][1];
                    a[0] *= fmaxf(bflo(gw.x), 1e-30f); a[1] *= fmaxf(bfhi(gw.x), 1e-30f); a[2] *= fmaxf(bflo(gw.y), 1e-30f); a[3] *= fmaxf(bfhi(gw.y), 1e-30f);
                    b[0] *= fmaxf(bflo(gw.z), 1e-30f); b[1] *= fmaxf(bfhi(gw.z), 1e-30f); b[2] *= fmaxf(bflo(gw.w), 1e-30f); b[3] *= fmaxf(bfhi(gw.w), 1e-30f);
                    *(u32x4*)(mp + bj * HALF) = pack8(a, b); } }
    }
};
template <int NSUB_> struct MultiOrder : StaticOrder {
    __host__ __device__ bool next(int i, Unit& u) const { if (!StaticOrder::next(i / NSUB_, u)) return false; u.x = i % NSUB_; return true; }
};
struct OneTile : StaticOrder {
    __host__ __device__ bool next(int i, Unit& u) const { return i == 0 && StaticOrder::next(0, u); }
};
}
namespace att {
typedef unsigned short bf16;
constexpr int D = 128, NW = 8, QBLK = 32, KVBLK = 64;
constexpr float THR = 8.f;
constexpr size_t SHM_V = KVBLK * D * 2, SHM_K = KVBLK * D * 2, SHM_ATTN = 2 * SHM_V + 2 * SHM_K + NW * 64 * 4;
using bf16x8 = __attribute__((ext_vector_type(8))) short;
using s16x4  = __attribute__((ext_vector_type(4))) short;
using f32x16 = __attribute__((ext_vector_type(16))) float;
using u32x4  = __attribute__((ext_vector_type(4))) unsigned;
#define KSWZ(row, colB) ((row) * 256 + ((colB) ^ (((row) & 7) << 4)))
#define SBAR() __builtin_amdgcn_sched_barrier(0)
__device__ __forceinline__ int crow(int r, int hi) { return (r & 3) + 8 * (r >> 2) + 4 * hi; }
__device__ __forceinline__ unsigned cvtpk(float lo, float hi) { return pg8::pk2(lo, hi); }
__device__ __forceinline__ void partialSM(f32x16& p0, f32x16& p1, float& m_reg, float& mn, float& alpha) {
  constexpr float THR2 = THR * 1.4426950408889634f;
  float pmax = p0[0];
#pragma unroll
  for (int r = 1; r < 16; ++r) pmax = fmaxf(pmax, p0[r]);
#pragma unroll
  for (int r = 0; r < 16; ++r) pmax = fmaxf(pmax, p1[r]);
  { auto rr = __builtin_amdgcn_permlane32_swap(__float_as_uint(pmax), __float_as_uint(pmax), false, false);
    pmax = fmaxf(__uint_as_float(rr[0]), __uint_as_float(rr[1])); }
  if (__builtin_expect(__all(pmax - m_reg <= THR2), 1)) { mn = m_reg; alpha = 1.f; }
  else { mn = fmaxf(m_reg, pmax); alpha = __builtin_amdgcn_exp2f(m_reg - mn); m_reg = mn; }
#pragma unroll
  for (int r = 0; r < 16; ++r) p0[r] = p0[r] - mn;
#pragma unroll
  for (int r = 0; r < 16; ++r) p1[r] = p1[r] - mn;
#pragma unroll
  for (int r = 0; r < 16; ++r) p0[r] = __builtin_amdgcn_exp2f(p0[r]);
}
__device__ __forceinline__ void partialSM_fast(f32x16& p0) {
#pragma unroll
  for (int r = 0; r < 16; ++r) p0[r] = __builtin_amdgcn_exp2f(p0[r]);
}
__device__ __forceinline__ void finishSM(f32x16& p0, f32x16& p1, float alpha, float& l_reg, bf16x8& pa0, bf16x8& pa1, bf16x8& pa2, bf16x8& pa3) {
#pragma unroll
  for (int r = 0; r < 16; ++r) p1[r] = __builtin_amdgcn_exp2f(p1[r]);
  float ps, ps0 = 0, ps1 = 0, ps2 = 0, ps3 = 0;
#pragma unroll
  for (int r = 0; r < 16; r += 4) { ps0 += p0[r]; ps1 += p0[r + 1]; ps2 += p0[r + 2]; ps3 += p0[r + 3]; }
#pragma unroll
  for (int r = 0; r < 16; r += 4) { ps0 += p1[r]; ps1 += p1[r + 1]; ps2 += p1[r + 2]; ps3 += p1[r + 3]; }
  ps = (ps0 + ps1) + (ps2 + ps3);
  { auto rr = __builtin_amdgcn_permlane32_swap(__float_as_uint(ps), __float_as_uint(ps), false, false);
    ps = __uint_as_float(rr[0]) + __uint_as_float(rr[1]); }
  l_reg = l_reg * alpha + ps;
#define PK4(P, BASE, OUT) do { unsigned a0 = cvtpk(P[BASE + 0], P[BASE + 1]), a1 = cvtpk(P[BASE + 2], P[BASE + 3]);   \
    unsigned b0 = cvtpk(P[BASE + 4], P[BASE + 5]), b1 = cvtpk(P[BASE + 6], P[BASE + 7]);                              \
    auto r0 = __builtin_amdgcn_permlane32_swap(a0, b0, false, false); auto r1 = __builtin_amdgcn_permlane32_swap(a1, b1, false, false); \
    u32x4 w = {r0[0], r1[0], r0[1], r1[1]}; OUT = *reinterpret_cast<bf16x8*>(&w); } while (0)
  PK4(p0, 0, pa0); PK4(p0, 8, pa1); PK4(p1, 0, pa2); PK4(p1, 8, pa3);
#undef PK4
}
__device__ __forceinline__ void finishSM_np(f32x16& p0, f32x16& p1, float alpha, float& l_reg, bf16x8& pa0, bf16x8& pa1, bf16x8& pa2, bf16x8& pa3) {
#pragma unroll
  for (int r = 0; r < 16; ++r) p1[r] = __builtin_amdgcn_exp2f(p1[r]);
  float ps, ps0 = 0, ps1 = 0, ps2 = 0, ps3 = 0;
#pragma unroll
  for (int r = 0; r < 16; r += 4) { ps0 += p0[r]; ps1 += p0[r + 1]; ps2 += p0[r + 2]; ps3 += p0[r + 3]; }
#pragma unroll
  for (int r = 0; r < 16; r += 4) { ps0 += p1[r]; ps1 += p1[r + 1]; ps2 += p1[r + 2]; ps3 += p1[r + 3]; }
  ps = (ps0 + ps1) + (ps2 + ps3);
  { auto rr = __builtin_amdgcn_permlane32_swap(__float_as_uint(ps), __float_as_uint(ps), false, false);
    ps = __uint_as_float(rr[0]) + __uint_as_float(rr[1]); }
  l_reg = l_reg * alpha + ps;
#define PK8(P, BASE, OUT) do { u32x4 w = {cvtpk(P[BASE + 0], P[BASE + 1]), cvtpk(P[BASE + 2], P[BASE + 3]), cvtpk(P[BASE + 4], P[BASE + 5]), cvtpk(P[BASE + 6], P[BASE + 7])}; OUT = *reinterpret_cast<bf16x8*>(&w); } while (0)
  PK8(p0, 0, pa0); PK8(p0, 8, pa1); PK8(p1, 0, pa2); PK8(p1, 8, pa3);
#undef PK8
}
template <int ND0> __device__ __forceinline__ void qkt(f32x16& p0, f32x16& p1, const bf16* Ks, const bf16x8* qr, int r32, int hi, int d0b) {
  p0 = f32x16{}; p1 = f32x16{};
#pragma unroll
  for (int d0 = 0; d0 < ND0; ++d0) { int cb = ((d0b + d0) * 16 + hi * 8) * 2;
    bf16x8 b0 = *reinterpret_cast<const bf16x8*>((const char*)Ks + KSWZ(r32, cb));
    bf16x8 b1 = *reinterpret_cast<const bf16x8*>((const char*)Ks + KSWZ(32 + r32, cb));
    p0 = __builtin_amdgcn_mfma_f32_32x32x16_bf16(b0, qr[d0], p0, 0, 0, 0);
    p1 = __builtin_amdgcn_mfma_f32_32x32x16_bf16(b1, qr[d0], p1, 0, 0, 0); }
}
__device__ __forceinline__ int v_st(int k, int c) { const int kk = (k & ~0xC) | ((k & 4) << 1) | ((k & 8) >> 1); return ((kk >> 3) * 4 + (c >> 5)) * 512 + ((kk & 7) * 32 + (c & 31)) * 2; }
__device__ __forceinline__ int v_rd_base(int lane) { return ((lane & 3) << 3) | (((lane >> 2) & 3) << 6) | (((lane >> 4) & 1) << 5) | (((lane >> 5) & 1) << 8); }
constexpr int v_rd_off(int d0, int ks, int half) { return d0 * 512 + ks * 4096 + half * 2048; }
template <int OFF> __device__ __forceinline__ s16x4 tr_read(int vb) {
  s16x4 r; asm volatile("ds_read_b64_tr_b16 %0, %1 offset:%2" : "=&v"(r) : "v"(vb), "i"(OFF) : "memory"); return r;
}
struct VFrag { s16x4 l0, h0, l1, h1, l2, h2, l3, h3; };
template <int D0> __device__ __forceinline__ void tr8(VFrag& v, int vb) {
  v.l0 = tr_read<v_rd_off(D0, 0, 0)>(vb); v.h0 = tr_read<v_rd_off(D0, 0, 1)>(vb); v.l1 = tr_read<v_rd_off(D0, 1, 0)>(vb); v.h1 = tr_read<v_rd_off(D0, 1, 1)>(vb);
  v.l2 = tr_read<v_rd_off(D0, 2, 0)>(vb); v.h2 = tr_read<v_rd_off(D0, 2, 1)>(vb); v.l3 = tr_read<v_rd_off(D0, 3, 0)>(vb); v.h3 = tr_read<v_rd_off(D0, 3, 1)>(vb);
}
__device__ __forceinline__ void mma4(f32x16& od, const VFrag& v, bf16x8 pa0, bf16x8 pa1, bf16x8 pa2, bf16x8 pa3) {
#define PK(L, H) (bf16x8){L[0], L[1], L[2], L[3], H[0], H[1], H[2], H[3]}
  od = __builtin_amdgcn_mfma_f32_32x32x16_bf16(pa0, PK(v.l0, v.h0), od, 0, 0, 0);
  od = __builtin_amdgcn_mfma_f32_32x32x16_bf16(pa1, PK(v.l1, v.h1), od, 0, 0, 0);
  od = __builtin_amdgcn_mfma_f32_32x32x16_bf16(pa2, PK(v.l2, v.h2), od, 0, 0, 0);
  od = __builtin_amdgcn_mfma_f32_32x32x16_bf16(pa3, PK(v.l3, v.h3), od, 0, 0, 0);
#undef PK
}
__device__ __forceinline__ void pv_d0(f32x16* o, int vb, bf16x8 pa0, bf16x8 pa1, bf16x8 pa2, bf16x8 pa3) {
  VFrag A, B;
  tr8<0>(A, vb); tr8<1>(B, vb);
  asm volatile("s_waitcnt lgkmcnt(8)" ::: "memory"); SBAR();
  mma4(o[0], A, pa0, pa1, pa2, pa3); SBAR();
  tr8<2>(A, vb);
  asm volatile("s_waitcnt lgkmcnt(8)" ::: "memory"); SBAR();
  mma4(o[1], B, pa0, pa1, pa2, pa3); SBAR();
  tr8<3>(B, vb);
  asm volatile("s_waitcnt lgkmcnt(8)" ::: "memory"); SBAR();
  mma4(o[2], A, pa0, pa1, pa2, pa3); SBAR();
  asm volatile("s_waitcnt lgkmcnt(0)" ::: "memory"); SBAR();
  mma4(o[3], B, pa0, pa1, pa2, pa3);
}
template <int LDQ, int LDK, int LDO, int ND0, bool FAST>
__device__ __forceinline__ void attn_dense_body(const bf16* Qb, const bf16* Kh, const bf16* Vh, bf16* Ob, int seq, int d0b, char* lds, int tid_in) {
  int tid_ = tid_in; asm volatile("" : "+v"(tid_));
  const int tid = tid_, wid = tid >> 6, lane = tid & 63, r32 = lane & 31, hi = lane >> 5;
  bf16* V_lds = (bf16*)lds; bf16* K_lds = (bf16*)(lds + 2 * SHM_V);
  float* ws = (float*)(lds + 2 * SHM_V + 2 * SHM_K) + wid * 64; float* li_l = ws; float* al_l = ws + 32;
  float m_reg = -1e30f, l_reg = 0; f32x16 o[4] = {}; bf16x8 qr[ND0];
  const bf16* Qw = Qb + (long)(wid * QBLK + r32) * LDQ + hi * 8 + d0b * 16;
#pragma unroll
  for (int d0 = 0; d0 < ND0; ++d0) qr[d0] = *reinterpret_cast<const bf16x8*>(Qw + d0 * 16);
  const int sr = tid >> 4, sc = (tid & 15) * 8, vst0 = v_st(sr, sc), vst1 = v_st(32 + sr, sc);
  const int vb0 = (int)(uintptr_t)V_lds + v_rd_base(lane);
  struct { bf16x8 vs0, vs1, ks0, ks1; } sr_[2];
#define SLOAD(i, k0) do { sr_[i].vs0 = *reinterpret_cast<const bf16x8*>(&Vh[(long)((k0) + sr) * LDK + sc]); sr_[i].vs1 = *reinterpret_cast<const bf16x8*>(&Vh[(long)((k0) + 32 + sr) * LDK + sc]); \
    sr_[i].ks0 = *reinterpret_cast<const bf16x8*>(&Kh[(long)((k0) + sr) * LDK + sc]); sr_[i].ks1 = *reinterpret_cast<const bf16x8*>(&Kh[(long)((k0) + 32 + sr) * LDK + sc]); } while (0)
#define SWRITE(b, i) do { *(bf16x8*)((char*)V_lds + (b) * SHM_V + vst0) = sr_[i].vs0;          \
    *(bf16x8*)((char*)V_lds + (b) * SHM_V + vst1) = sr_[i].vs1; int kc = sc * 2;               \
    *(bf16x8*)((char*)K_lds + (b) * SHM_K + KSWZ(sr, kc)) = sr_[i].ks0;                       \
    *(bf16x8*)((char*)K_lds + (b) * SHM_K + KSWZ(32 + sr, kc)) = sr_[i].ks1; } while (0)
#define SWAIT() asm volatile("s_waitcnt vmcnt(4)" ::: "memory")
#define PSM(P0, P1, MN, AL) do { if constexpr (FAST) { partialSM_fast(P0); AL = 1.f; MN = 0.f; } else partialSM(P0, P1, m_reg, MN, AL); } while (0)
#define RESC(a) do { if constexpr (!FAST) if (__any((a) < 1.f)) { if (hi == 0) al_l[r32] = (a); asm volatile("s_waitcnt lgkmcnt(0)" ::: "memory"); \
    _Pragma("unroll") for (int d = 0; d < 4; ++d) _Pragma("unroll") for (int r = 0; r < 16; ++r) o[d][r] *= al_l[crow(r, hi)]; } } while (0)
  f32x16 pA0, pA1, pB0, pB1; float mnA, mnB, alA, alB; bf16x8 pa0, pa1, pa2, pa3; const int NT = seq / KVBLK;
  constexpr int SE = 0, SO = 1;
  SLOAD(SE, 0); asm volatile("s_waitcnt vmcnt(0)" ::: "memory"); SWRITE(0, SE); __syncthreads();
  qkt<ND0>(pA0, pA1, K_lds, qr, r32, hi, d0b); PSM(pA0, pA1, mnA, alA);
  SLOAD(SO, KVBLK); if (2 < NT) SLOAD(SE, 2 * KVBLK);
  SWAIT(); SWRITE(1, SO); __syncthreads();
  for (int j = 1; j + 1 < NT; j += 2) {
    SBAR(); qkt<ND0>(pB0, pB1, (bf16*)((char*)K_lds + SHM_K), qr, r32, hi, d0b);
    finishSM(pA0, pA1, alA, l_reg, pa0, pa1, pa2, pa3); SBAR();
    SLOAD(SO, (j + 2) * KVBLK); SBAR();
    pv_d0(o, vb0, pa0, pa1, pa2, pa3); PSM(pB0, pB1, mnB, alB);
    __syncthreads(); SWAIT(); SWRITE(0, SE);
    RESC(alB); __syncthreads();
    SBAR(); qkt<ND0>(pA0, pA1, K_lds, qr, r32, hi, d0b);
    finishSM(pB0, pB1, alB, l_reg, pa0, pa1, pa2, pa3); SBAR();
    if (j + 3 < NT) SLOAD(SE, (j + 3) * KVBLK); SBAR();
    pv_d0(o, vb0 + (int)SHM_V, pa0, pa1, pa2, pa3); PSM(pA0, pA1, mnA, alA);
    __syncthreads(); SWAIT(); SWRITE(1, SO);
    RESC(alA); __syncthreads();
  }
  SBAR(); qkt<ND0>(pB0, pB1, (bf16*)((char*)K_lds + SHM_K), qr, r32, hi, d0b);
  finishSM(pA0, pA1, alA, l_reg, pa0, pa1, pa2, pa3); SBAR();
  pv_d0(o, vb0, pa0, pa1, pa2, pa3); PSM(pB0, pB1, mnB, alB);
  __syncthreads(); RESC(alB);
  finishSM(pB0, pB1, alB, l_reg, pa0, pa1, pa2, pa3); SBAR();
  pv_d0(o, vb0 + (int)SHM_V, pa0, pa1, pa2, pa3);
  if (hi == 0) li_l[r32] = l_reg; asm volatile("s_waitcnt lgkmcnt(0)" ::: "memory");
  float rli[16];
#pragma unroll
  for (int r = 0; r < 16; ++r) rli[r] = __builtin_amdgcn_rcpf(li_l[crow(r, hi)]);
  bf16* Ow = Ob + (long)(wid * QBLK) * LDO;
#pragma unroll
  for (int r = 0; r < 16; ++r) { int orow = crow(r, hi);
#pragma unroll
    for (int d0 = 0; d0 < 4; ++d0) Ow[(long)orow * LDO + d0 * 32 + r32] = (bf16)(cvtpk(o[d0][r] * rli[r], 0.f) & 0xffffu); }
  __syncthreads();
#undef SLOAD
#undef SWRITE
#undef SWAIT
#undef RESC
#undef PSM
}
template <int LDQ, int LDK, int LDO, int ND0, bool FAST>
__device__ __forceinline__ void attn_stag_body(const bf16* Qb, const bf16* Kh, const bf16* Vh, bf16* Ob, int seq, int d0b, char* lds, int tid_in) {
  int tid_ = tid_in; asm volatile("" : "+v"(tid_));
  const int tid = tid_, wid = __builtin_amdgcn_readfirstlane(tid >> 6), lane = tid & 63, r32 = lane & 31, hi = lane >> 5, half = wid >> 2, ht = tid & 255;
  bf16* V_lds = (bf16*)lds; bf16* K_lds = (bf16*)(lds + 2 * SHM_V);
  float* ws = (float*)(lds + 2 * SHM_V + 2 * SHM_K) + wid * 64; float* li_l = ws; float* al_l = ws + 32;
  float m_reg = -1e30f, l_reg = 0; f32x16 o[4] = {}; bf16x8 qr[ND0];
  const bf16* Qw = Qb + (long)(wid * QBLK + r32) * LDQ + hi * 8 + d0b * 16;
#pragma unroll
  for (int d0 = 0; d0 < ND0; ++d0) qr[d0] = *reinterpret_cast<const bf16x8*>(Qw + d0 * 16);
  const bf16* Sh = half ? Vh : Kh; int soff[4]; long goff[4];
#pragma unroll
  for (int i = 0; i < 4; ++i) { const int idx = ht + 256 * i, row = idx >> 4, ch = idx & 15; goff[i] = (long)row * LDK + ch * 8;
    soff[i] = half ? v_st(row, ch * 8) : (int)(2 * SHM_V) + KSWZ(row, ch * 16); }
  const int vb0 = (int)(uintptr_t)V_lds + v_rd_base(lane);
  bf16x8 sg0[4], sg1[4];
#define GLOAD(SG, k0) do { _Pragma("unroll") for (int i = 0; i < 4; ++i) SG[i] = *reinterpret_cast<const bf16x8*>(Sh + (long)(k0) * LDK + goff[i]); } while (0)
#define LWRITE(b, SG) do { _Pragma("unroll") for (int i = 0; i < 4; ++i) *(bf16x8*)(lds + (b) * (int)SHM_V + soff[i]) = SG[i]; } while (0)
#define XBAR() do { asm volatile("s_waitcnt lgkmcnt(0)" ::: "memory"); __builtin_amdgcn_s_barrier(); asm volatile("" ::: "memory"); } while (0)
#define RESC(a) do { if constexpr (!FAST) if (__any((a) < 1.f)) { if (hi == 0) al_l[r32] = (a); asm volatile("s_waitcnt lgkmcnt(0)" ::: "memory"); \
    _Pragma("unroll") for (int d = 0; d < 4; ++d) _Pragma("unroll") for (int r = 0; r < 16; ++r) o[d][r] *= al_l[crow(r, hi)]; } } while (0)
  f32x16 p0, p1; float mn, al; bf16x8 pa0, pa1, pa2, pa3; const int NT = seq / KVBLK;
  GLOAD(sg0, 0); LWRITE(0, sg0); GLOAD(sg1, KVBLK); if (2 < NT) GLOAD(sg0, 2 * KVBLK);
  XBAR();
  if (half == 1) __builtin_amdgcn_s_barrier();
#define TILE(J, BUF, SGN, SGNN) do { \
    SBAR(); qkt<ND0>(p0, p1, (bf16*)((char*)K_lds + (BUF) * SHM_K), qr, r32, hi, d0b); SBAR(); \
    XBAR(); \
    if constexpr (FAST) { partialSM_fast(p0); al = 1.f; mn = 0.f; } else partialSM(p0, p1, m_reg, mn, al); \
    RESC(al); \
    finishSM(p0, p1, al, l_reg, pa0, pa1, pa2, pa3); \
    if ((J) + 1 < NT) { LWRITE((BUF) ^ 1, SGN); if ((J) + 3 < NT) GLOAD(SGN, ((J) + 3) * KVBLK); } \
    XBAR(); \
    SBAR(); pv_d0(o, vb0 + (BUF) * (int)SHM_V, pa0, pa1, pa2, pa3); SBAR(); \
    XBAR(); } while (0)
  for (int j = 0; j < NT; j += 2) { TILE(j, 0, sg1, sg1); TILE(j + 1, 1, sg0, sg0); }
#undef TILE
  if (half == 0) __builtin_amdgcn_s_barrier();
  if (hi == 0) li_l[r32] = l_reg; asm volatile("s_waitcnt lgkmcnt(0)" ::: "memory");
  float rli[16];
#pragma unroll
  for (int r = 0; r < 16; ++r) rli[r] = __builtin_amdgcn_rcpf(li_l[crow(r, hi)]);
  bf16* Ow = Ob + (long)(wid * QBLK) * LDO;
#pragma unroll
  for (int r = 0; r < 16; ++r) { int orow = crow(r, hi);
#pragma unroll
    for (int d0 = 0; d0 < 4; ++d0) Ow[(long)orow * LDO + d0 * 32 + r32] = (bf16)(cvtpk(o[d0][r] * rli[r], 0.f) & 0xffffu); }
  __syncthreads();
#undef GLOAD
#undef LWRITE
#undef XBAR
#undef RESC
}
constexpr size_t DMA_K0 = 0, DMA_V0 = 3 * SHM_K, DMA_WS = 3 * SHM_K + 4 * SHM_V, SHM_ATTN_DMA = DMA_WS + NW * 64 * 4;
template <int LDQ, int LDK, int LDO, int ND0, bool FAST>
__device__ __forceinline__ void attn_dma_body(const bf16* Qb, const bf16* Kh, const bf16* Vh, bf16* Ob, int seq, int d0b, char* lds, int tid_in, unsigned* qhead, volatile __attribute__((address_space(3))) unsigned* qslot) {
  int tid_ = tid_in; asm volatile("" : "+v"(tid_));
  const int tid = tid_, wid = __builtin_amdgcn_readfirstlane(tid >> 6), lane = tid & 63, r32 = lane & 31, hi = lane >> 5;
  bf16* K_lds = (bf16*)(lds + DMA_K0); bf16* V_lds = (bf16*)(lds + DMA_V0);
  float* ws = (float*)(lds + DMA_WS) + wid * 64; float* li_l = ws; float* al_l = ws + 32;
  float m_reg = -1e30f, l_reg = 0; f32x16 o[4] = {}; bf16x8 qr[ND0];
  const bf16* Qw = Qb + (long)(wid * QBLK + r32) * LDQ + hi * 8 + d0b * 16;
#pragma unroll
  for (int d0 = 0; d0 < ND0; ++d0) qr[d0] = *reinterpret_cast<const bf16x8*>(Qw + d0 * 16);
  long kso[2], vso[2];
#pragma unroll
  for (int i = 0; i < 2; ++i) { const int c = 2 * wid + i;
    { const int row = 4 * c + (lane >> 4), colB = ((lane & 15) * 16) ^ ((row & 7) << 4); kso[i] = (long)row * LDK + (colB >> 1); }
    { const int st = 2 * c + (lane >> 5), kk = (st >> 2) * 8 + ((lane & 31) >> 2), k = kk  , col = (st & 3) * 32 + (lane & 3) * 8; vso[i] = (long)k * LDK + col; } }
  const int vb0 = (int)(uintptr_t)V_lds + v_rd_base(lane);
#define LDSP(off) ((__attribute__((address_space(3))) unsigned*)(uintptr_t)(unsigned)(uintptr_t)(lds + (off)))
#define DMA(T, KS, VS) do { const long tb_ = (long)(T) * KVBLK * LDK; _Pragma("unroll") for (int i = 0; i < 2; ++i) { \
      __builtin_amdgcn_global_load_lds((const unsigned*)(Kh + tb_ + kso[i]), LDSP(DMA_K0 + (KS) * SHM_K + (2 * wid + i) * 1024), 16, 0, 0); \
      __builtin_amdgcn_global_load_lds((const unsigned*)(Vh + tb_ + vso[i]), LDSP(DMA_V0 + (VS) * SHM_V + (2 * wid + i) * 1024), 16, 0, 0); } } while (0)
#define XBAR() do { asm volatile("s_waitcnt lgkmcnt(0)" ::: "memory"); __builtin_amdgcn_s_barrier(); asm volatile("" ::: "memory"); } while (0)
#define PSM(P0, P1, MN, AL) do { if constexpr (FAST) { partialSM_fast(P0); AL = 1.f; MN = 0.f; } else partialSM(P0, P1, m_reg, MN, AL); } while (0)
#define RESC(a) do { if constexpr (!FAST) if (__any((a) < 1.f)) { if (hi == 0) al_l[r32] = (a); asm volatile("s_waitcnt lgkmcnt(0)" ::: "memory"); \
    _Pragma("unroll") for (int d = 0; d < 4; ++d) _Pragma("unroll") for (int r = 0; r < 16; ++r) o[d][r] *= al_l[crow(r, hi)]; } } while (0)
  f32x16 pA0, pA1, pB0, pB1; float mnA, mnB, alA, alB; bf16x8 pa0, pa1, pa2, pa3; const int NT = seq / KVBLK;
  DMA(0, 0, 0); DMA(1, 1, 1);
  asm volatile("s_waitcnt vmcnt(4)" ::: "memory"); XBAR();
  qkt<ND0>(pA0, pA1, K_lds, qr, r32, hi, d0b); PSM(pA0, pA1, mnA, alA);
  if (2 < NT) { DMA(2, 2, 2); asm volatile("s_waitcnt vmcnt(4)" ::: "memory"); } else asm volatile("s_waitcnt vmcnt(0)" ::: "memory");
  XBAR();
  int kb = 1, vbi = 1;
#define QKC(C, P0, P1, KS) do { _Pragma("unroll") for (int dd_ = 0; dd_ < ND0 / 4; ++dd_) { const int d0_ = (C) * (ND0 / 4) + dd_; const int cb_ = ((d0b + d0_) * 16 + hi * 8) * 2; \
      const bf16x8 b0_ = *reinterpret_cast<const bf16x8*>((const char*)(KS) + KSWZ(r32, cb_)); const bf16x8 b1_ = *reinterpret_cast<const bf16x8*>((const char*)(KS) + KSWZ(32 + r32, cb_)); \
      P0 = __builtin_amdgcn_mfma_f32_32x32x16_bf16(b0_, qr[d0_], P0, 0, 0, 0); P1 = __builtin_amdgcn_mfma_f32_32x32x16_bf16(b1_, qr[d0_], P1, 0, 0, 0); } } while (0)
#define PK8(P, BASE, OUT) do { u32x4 w_ = {cvtpk(P[BASE + 0], P[BASE + 1]), cvtpk(P[BASE + 2], P[BASE + 3]), cvtpk(P[BASE + 4], P[BASE + 5]), cvtpk(P[BASE + 6], P[BASE + 7])}; OUT = *reinterpret_cast<bf16x8*>(&w_); } while (0)
#define STEP(PC0, PC1, MNC, ALC, PP0, PP1, ALP, KS, VB, DMA_STMT) do { \
    if constexpr (FAST) { \
      float q0_ = 0.f, q1_ = 0.f, q2_ = 0.f, q3_ = 0.f; PC0 = f32x16{}; PC1 = f32x16{}; \
      SBAR(); QKC(0, PC0, PC1, KS); \
      _Pragma("unroll") for (int r_ = 0; r_ < 8; ++r_) PP1[r_] = __builtin_amdgcn_exp2f(PP1[r_]); \
      _Pragma("unroll") for (int r_ = 0; r_ < 16; r_ += 4) { q0_ += PP0[r_]; q1_ += PP0[r_ + 1]; q2_ += PP0[r_ + 2]; q3_ += PP0[r_ + 3]; } \
      asm volatile("" : "+v"(q0_), "+v"(q1_), "+v"(q2_), "+v"(q3_));     \
      SBAR(); QKC(1, PC0, PC1, KS); \
      _Pragma("unroll") for (int r_ = 8; r_ < 16; ++r_) PP1[r_] = __builtin_amdgcn_exp2f(PP1[r_]); \
      PK8(PP0, 0, pa0); PK8(PP0, 8, pa1); asm volatile("" : "+v"(pa0), "+v"(pa1)); \
      SBAR(); QKC(2, PC0, PC1, KS); \
      _Pragma("unroll") for (int r_ = 0; r_ < 16; r_ += 4) { q0_ += PP1[r_]; q1_ += PP1[r_ + 1]; q2_ += PP1[r_ + 2]; q3_ += PP1[r_ + 3]; } \
      asm volatile("" : "+v"(q0_), "+v"(q1_), "+v"(q2_), "+v"(q3_)); \
      SBAR(); QKC(3, PC0, PC1, KS); \
      PK8(PP1, 0, pa2); PK8(PP1, 8, pa3); asm volatile("" : "+v"(pa2), "+v"(pa3)); \
      { float ps_ = (q0_ + q1_) + (q2_ + q3_); auto rr_ = __builtin_amdgcn_permlane32_swap(__float_as_uint(ps_), __float_as_uint(ps_), false, false); l_reg += __uint_as_float(rr_[0]) + __uint_as_float(rr_[1]); } \
      SBAR(); DMA_STMT; SBAR(); \
      { VFrag A_, B_; const int vb_ = (VB); tr8<0>(A_, vb_); tr8<1>(B_, vb_); \
        asm volatile("s_waitcnt lgkmcnt(8)" ::: "memory"); SBAR(); mma4(o[0], A_, pa0, pa1, pa2, pa3); \
        _Pragma("unroll") for (int r_ = 0; r_ < 4; ++r_) PC0[r_] = __builtin_amdgcn_exp2f(PC0[r_]); \
        SBAR(); tr8<2>(A_, vb_); asm volatile("s_waitcnt lgkmcnt(8)" ::: "memory"); SBAR(); mma4(o[1], B_, pa0, pa1, pa2, pa3); \
        _Pragma("unroll") for (int r_ = 4; r_ < 8; ++r_) PC0[r_] = __builtin_amdgcn_exp2f(PC0[r_]); \
        SBAR(); tr8<3>(B_, vb_); asm volatile("s_waitcnt lgkmcnt(8)" ::: "memory"); SBAR(); mma4(o[2], A_, pa0, pa1, pa2, pa3); \
        _Pragma("unroll") for (int r_ = 8; r_ < 12; ++r_) PC0[r_] = __builtin_amdgcn_exp2f(PC0[r_]); \
        SBAR(); asm volatile("s_waitcnt lgkmcnt(0)" ::: "memory"); SBAR(); mma4(o[3], B_, pa0, pa1, pa2, pa3); \
        _Pragma("unroll") for (int r_ = 12; r_ < 16; ++r_) PC0[r_] = __builtin_amdgcn_exp2f(PC0[r_]); } \
      ALC = 1.f; MNC = 0.f; \
    } else { \
      SBAR(); qkt<ND0>(PC0, PC1, (bf16*)(KS), qr, r32, hi, d0b); \
      finishSM_np(PP0, PP1, ALP, l_reg, pa0, pa1, pa2, pa3); SBAR(); \
      DMA_STMT; SBAR(); \
      pv_d0(o, (VB), pa0, pa1, pa2, pa3); partialSM(PC0, PC1, m_reg, MNC, ALC); \
      RESC(ALC); \
    } } while (0)
  for (int j = 1; j + 1 < NT; j += 2) {
    const int kb1 = kb == 2 ? 0 : kb + 1, kb2 = kb == 0 ? 2 : kb - 1;
    const int vp = (vbi + 3) & 3, v2 = (vbi + 2) & 3, v3 = (vbi + 3) & 3;
    STEP(pB0, pB1, mnB, alB, pA0, pA1, alA, (char*)K_lds + kb * SHM_K, vb0 + vp * (int)SHM_V, DMA(j + 2, kb2, v2));
    asm volatile("s_waitcnt vmcnt(4)" ::: "memory"); XBAR();
    STEP(pA0, pA1, mnA, alA, pB0, pB1, alB, (char*)K_lds + kb1 * SHM_K, vb0 + vbi * (int)SHM_V, if (j + 3 < NT) DMA(j + 3, kb, v3));
    if (j + 3 < NT) asm volatile("s_waitcnt vmcnt(4)" ::: "memory"); else asm volatile("s_waitcnt vmcnt(0)" ::: "memory");
    XBAR();
    kb = kb2; vbi = v2;
  }
  { const int vp = (vbi + 3) & 3;
  STEP(pB0, pB1, mnB, alB, pA0, pA1, alA, (char*)K_lds + kb * SHM_K, vb0 + vp * (int)SHM_V, (void)0);
  finishSM_np(pB0, pB1, alB, l_reg, pa0, pa1, pa2, pa3); SBAR();
  pv_d0(o, vb0 + vbi * (int)SHM_V, pa0, pa1, pa2, pa3); }
#undef STEP
#undef QKC
#undef PK8
  unsigned tk_ = 0u; if (tid == 0) tk_ = __hip_atomic_fetch_add(qhead, 1u, __ATOMIC_RELAXED, __HIP_MEMORY_SCOPE_AGENT);
  if (hi == 0) li_l[r32] = l_reg; asm volatile("s_waitcnt lgkmcnt(0)" ::: "memory");
  float rli[16];
#pragma unroll
  for (int r = 0; r < 16; ++r) rli[r] = __builtin_amdgcn_rcpf(li_l[crow(r, hi)]);
  bf16* Ow = Ob + (long)(wid * QBLK) * LDO;
#pragma unroll
  for (int r = 0; r < 16; ++r) { int orow = crow(r, hi);
#pragma unroll
    for (int d0 = 0; d0 < 4; ++d0) Ow[(long)orow * LDO + d0 * 32 + r32] = (bf16)(cvtpk(o[d0][r] * rli[r], 0.f) & 0xffffu); }
  if (tid == 0) qslot[0] = tk_;
  __syncthreads();
#undef LDSP
#undef DMA
#undef XBAR
#undef PSM
#undef RESC
}
#undef KSWZ
#undef SBAR
}
#define XB_TMO      128
#define XB_XCNT(j)  (256  + 64 * (j))
#define XB_XSUB(j)  (1280 + 64 * (j))
#define XB_XGEN(j)  (2304 + 64 * (j))
#define XB_TOP      3328
#define XB_TOPGEN   3392
#define XCD_BAR_WORDS 3456
#define XB_SPIN_CAP (1u << 22)
#define LAS __attribute__((address_space(3)))

__device__ __forceinline__ unsigned xb_ld(unsigned* p)              { return __hip_atomic_load(p, __ATOMIC_RELAXED, __HIP_MEMORY_SCOPE_AGENT); }
__device__ __forceinline__ unsigned xb_add(unsigned* p, unsigned v) { return __hip_atomic_fetch_add(p, v, __ATOMIC_RELAXED, __HIP_MEMORY_SCOPE_AGENT); }
__device__ __forceinline__ unsigned xb_xcc_id() { return (unsigned)__builtin_amdgcn_s_getreg((3 << 11) | 20) & 0xFu; }
#define XB_SPIN(cond, bar) do { unsigned _sp = 0; while (cond) { __builtin_amdgcn_s_sleep(1); \
    if ((++_sp & 255u) == 0u) { if (xb_ld(&(bar)[XB_TMO])) break; if (_sp > XB_SPIN_CAP) { atomicAdd(&(bar)[XB_TMO], 1u); break; } } } } while (0)

struct XcdBarrier {
    unsigned* bar; unsigned x;
    volatile LAS unsigned* st;
};

__device__ __forceinline__ XcdBarrier xcd_barrier_post(unsigned* bar, volatile LAS unsigned* st) {
    XcdBarrier b; b.bar = bar; b.x = xb_xcc_id(); b.st = st;
    if (threadIdx.x == 0) (void)xb_add(&bar[XB_XCNT(b.x)], 1u);
    return b;
}
__device__ __forceinline__ void xcd_barrier_complete(unsigned* bar, unsigned x, unsigned& nloc, unsigned& nx) {
    const unsigned G = gridDim.x * gridDim.y * gridDim.z;
    unsigned sum, cnt, mine, sp = 0u;
    for (;;) {
        sum = 0u; cnt = 0u; mine = 0u;
#pragma unroll
        for (unsigned j = 0; j < 16; ++j) { const unsigned c = xb_ld(&bar[XB_XCNT(j)]); sum += c; cnt += (c > 0u) ? 1u : 0u; mine = (j == x) ? c : mine; }
        if (sum == G) break;
        __builtin_amdgcn_s_sleep(1);
        if ((++sp & 255u) == 0u) { if (xb_ld(&bar[XB_TMO])) break; if (sp > XB_SPIN_CAP) { atomicAdd(&bar[XB_TMO], 1u); break; } }
    }
    nloc = mine > 0u ? mine : 1u; nx = cnt > 0u ? cnt : 1u;
}

__device__ __forceinline__ void xcd_barrier(const XcdBarrier& b, bool lead) {
    asm volatile("s_waitcnt vmcnt(0)" ::: "memory");
    __syncthreads();
    if (lead) {
        unsigned* bar = b.bar;
        __builtin_amdgcn_s_waitcnt(0);
        unsigned nloc = b.st[0], nx = b.st[1];
        if (nloc == 0u) { xcd_barrier_complete(bar, b.x, nloc, nx); b.st[0] = nloc; b.st[1] = nx; }
        const unsigned old = xb_add(&bar[XB_XSUB(b.x)], 1u);
        const unsigned gen = old / nloc;
        if (old + 1u == (gen + 1u) * nloc) {
            __builtin_amdgcn_fence(__ATOMIC_RELEASE, "agent");
            asm volatile("s_waitcnt vmcnt(0)" ::: "memory");
            const unsigned og = xb_add(&bar[XB_TOP], 1u);
            const unsigned tg = og / nx;
            __builtin_amdgcn_fence(__ATOMIC_ACQUIRE, "agent");
            if (og + 1u == (tg + 1u) * nx) xb_add(&bar[XB_TOPGEN], 1u);
            else XB_SPIN(xb_ld(&bar[XB_TOPGEN]) == tg, bar);
            xb_add(&bar[XB_XGEN(b.x)], 1u);
            asm volatile("s_waitcnt vmcnt(0)" ::: "memory");
        } else {
            __builtin_amdgcn_fence(__ATOMIC_ACQUIRE, "agent");
            XB_SPIN(xb_ld(&bar[XB_XGEN(b.x)]) == gen, bar);
            asm volatile("s_waitcnt vmcnt(0)" ::: "memory");
        }
    }
    __syncthreads();
}
#define DI __device__ __forceinline__
#define GAS __attribute__((address_space(1)))
typedef unsigned short bf16;
typedef float f32x4 __attribute__((ext_vector_type(4)));
typedef float f32x16 __attribute__((ext_vector_type(16)));
typedef short bf16x8 __attribute__((ext_vector_type(8)));
typedef unsigned u32x4 __attribute__((ext_vector_type(4)));
typedef unsigned u32x2 __attribute__((ext_vector_type(2)));
typedef GAS unsigned gu32;
using pg8::pk2; using pg8::bflo; using pg8::bfhi; using pg8::sigmoidf_;
#define MFMA32(a, b, c) __builtin_amdgcn_mfma_f32_32x32x16_bf16((a), (b), (c), 0, 0, 0)
#define RLX_AGENT __ATOMIC_RELAXED, __HIP_MEMORY_SCOPE_AGENT

constexpr int NWAVES = 8, NTHREADS = 512;
constexpr int DM = 2048, JR = 16384, NJOB = 3, NLAYER = 2, MALL = 49152;
constexpr int N_IN = 14880, NP1 = 8960, LDPJ = 8704, NGT = 6144, DFF = 5632, NUP = 11264, PLE = 256, NWIN = 15104;
constexpr int PJ_AQ = 0, PJ_AZ = 3072, PJ_BQ = 4096, PJ_BK = 5120, PJ_BV = 5376, PJ_CQ = 5632, PJ_CK = 6656, PJ_CV = 7680;
constexpr float EPS = 1e-6f;
constexpr int G1_UNIT_BYTES = 73728, G1_W = 0, G1_QD = 16384, G1_IN = 32768, G1_KD = 40960, G1_U = 57344, G1_STAGE = 57344;
constexpr size_t MiB = (size_t)1 << 20;
constexpr size_t WS_CTL = 0, CTL_ZERO_BYTES = 1 * MiB;
constexpr size_t WS_WIN = 1 * MiB, WS_WOA = 60 * MiB, WS_WOB = 64 * MiB, WS_WOC = 68 * MiB, WS_WOUT = 72 * MiB, WS_WUP = 80 * MiB, WS_WDOWN = 124 * MiB, WS_WPLE = 146 * MiB, WS_WPG = 147 * MiB;
constexpr size_t WS_HB = 156 * MiB, WS_AB = 220 * MiB, WS_PB = 222 * MiB, WS_GL = 230 * MiB, WS_SS2 = 231 * MiB, WS_OAF = 232 * MiB, WS_OAB = 264 * MiB, WS_OB = 296 * MiB, WS_OC2 = 328 * MiB, WS_OCP = 392 * MiB;
constexpr size_t WS_PJ = 424 * MiB, WS_G1 = 696 * MiB, WS_END = 984 * MiB;
constexpr size_t WS_GT = WS_G1, WS_MG = WS_HB, WS_U = WS_PJ, WS_ACT = WS_PJ + 352 * MiB, WS_PL = WS_OAF;
static_assert(pg8::CA_NUP == NUP && pg8::CA_DFF == DFF && pg8::CA_JR == JR, "conv epilogue constants");
static_assert(WS_WIN + (size_t)NWIN * DM * 2 <= WS_WOA && WS_WPG + 8 * MiB <= WS_HB && WS_G1 + (size_t)4096 * G1_UNIT_BYTES <= WS_END && WS_ACT + (size_t)JR * DFF * 2 <= WS_END && WS_PJ + (size_t)JR * LDPJ * 2 <= WS_G1, "ws map");
constexpr int CW_BAR = 4096, CW_Q = 16384;
constexpr int RING_BYTES = 131072, LDSCTL_OFF = RING_BYTES, MISC_OFF = LDSCTL_OFF + 320, LDS_BYTES = 147456;

DI float bf2f(bf16 b) { return __uint_as_float(((unsigned)b) << 16); }
DI bf16 f2bf(float f) { return (bf16)(pk2(f, 0.f) & 0xffffu); }
DI float wave_sum(float v) {
#pragma unroll
    for (int o = 1; o < 64; o <<= 1) v += __shfl_xor(v, o);
    return v;
}
DI float xchg32(float v, int lane) {
    const auto rr = __builtin_amdgcn_permlane32_swap(__float_as_uint(v), __float_as_uint(v), false, false);
    return __uint_as_float(lane < 32 ? rr[1] : rr[0]);
}
DI float silu_(float y) { return y * __builtin_amdgcn_rcpf(1.0f + __expf(-y)); }
DI float softplus_(float x) { return fmaxf(x, 0.f) + __logf(1.0f + __expf(-fabsf(x))); }
DI void sincos_(float ang, float& s, float& c) { const float n = rintf(ang * 0.15915494309189535f); float r = fmaf(-n, 6.2831854820251465f, ang); r = fmaf(-n, -1.7484556e-7f, r); s = __sinf(r); c = __cosf(r); }
DI int crow(int reg, int hh) { return (reg & 3) + 8 * (reg >> 2) + 4 * hh; }
template <int S> DI bf16x8 pack_step(const f32x16& x) {
    u32x4 p; p.x = pk2(x[8 * S + 0], x[8 * S + 1]); p.y = pk2(x[8 * S + 2], x[8 * S + 3]); p.z = pk2(x[8 * S + 4], x[8 * S + 5]); p.w = pk2(x[8 * S + 6], x[8 * S + 7]);
    return __builtin_bit_cast(bf16x8, p);
}

struct Args { const float* in[27]; float* out; unsigned char* ws; int l0, l1, j0, j1, ph_lo, ph_hi, one_launch, dbg; };
typedef const __attribute__((address_space(4))) Args CArgs;
struct Frame {
    LAS unsigned char* lds; volatile LAS unsigned* MISC; gu32* ctl;
    int tid, lane, wave, G, bid;
    unsigned char* ws;
};
struct JobGeo { int row0, nseq, seqlen; };
DI JobGeo job_geo(int job) { JobGeo g; g.row0 = job * JR; g.nseq = job == 0 ? 1 : 2; g.seqlen = job == 0 ? 16384 : 8192; return g; }
DI int up_dst(int sc) { return sc < DFF ? (sc >> 7) * 256 + (sc & 127) : ((sc - DFF) >> 7) * 256 + 128 + ((sc - DFF) & 127); }
DI int win_dst(int sc) {
    if (sc < 4096) return sc;
    if (sc < 4128) return 8704 + (sc - 4096);
    if (sc < 8736) return 4096 + (sc - 4128);
    return 8960 + (sc - 8736);
}
DI void transpose_item(const float* W, int K, int N, bf16* WT, int remap, LAS float* scr, int item, int lane, const float* gk = nullptr) {
    const int nblk = N / 32, kb = item / nblk, nb = item % nblk, k0 = 64 * kb, n0 = 32 * nb;
    float wv[32];
#pragma unroll
    for (int i = 0; i < 32; ++i) { const int kk = 2 * i + (lane >> 5); wv[i] = W[(size_t)(k0 + kk) * N + n0 + (lane & 31)]; }
#pragma unroll
    for (int i = 0; i < 32; ++i) { const int kk = 2 * i + (lane >> 5); scr[kk * 33 + (lane & 31)] = gk ? wv[i] * gk[k0 + kk] : wv[i]; }
    asm volatile("s_waitcnt lgkmcnt(0)" ::: "memory");
    const int c = lane & 7; const int d0 = remap == 1 ? win_dst(n0) : (remap == 2 ? up_dst(n0) : n0);
#pragma unroll
    for (int j = 0; j < 4; ++j) { const int n = (lane >> 3) + 8 * j; const LAS float* s = scr + (8 * c) * 33 + n;
        u32x4 o; o.x = pk2(s[0 * 33], s[1 * 33]); o.y = pk2(s[2 * 33], s[3 * 33]); o.z = pk2(s[4 * 33], s[5 * 33]); o.w = pk2(s[6 * 33], s[7 * 33]);
        *(u32x4*)(WT + (size_t)(d0 + n) * K + k0 + 8 * c) = o; }
    asm volatile("s_waitcnt lgkmcnt(0)" ::: "memory");
}
DI void phase_weights(Frame& F, CArgs* a, int layer) {
    LAS float* scr = (LAS float*)(F.lds + F.wave * 16384);
    const int gw = F.bid * NWAVES + F.wave, NGW = F.G * NWAVES;
    unsigned char* ws = F.ws;
    const float* w_in = a->in[5] + (size_t)layer * DM * N_IN;
    const float* w_oa = a->in[16] + (size_t)layer * 1024 * DM; const float* w_ob = a->in[17] + (size_t)layer * 1024 * DM; const float* w_oc = a->in[18] + (size_t)layer * 1024 * DM;
    const float* w_out = a->in[19] + (size_t)layer * DM * DM; const float* w_up = a->in[21] + (size_t)layer * DM * NUP; const float* w_down = a->in[24] + (size_t)layer * DFF * DM;
    const float* w_ple = a->in[25] + (size_t)layer * PLE * DM; const float* w_pg = a->in[26] + (size_t)layer * DM * DM;
    constexpr int I_IN = (DM / 64) * (N_IN / 32), I_O = (1024 / 64) * (DM / 32), I_OUT = (DM / 64) * (DM / 32), I_UP = (DM / 64) * (NUP / 32), I_DN = (DFF / 64) * (DM / 32), I_PLE = (PLE / 64) * (DM / 32);
    constexpr int NITEMS = I_IN + 3 * I_O + I_OUT + I_UP + I_DN + I_PLE + I_OUT;
    for (int it = gw; it < NITEMS; it += NGW) {
        int r = it;
        if (r < I_IN) { transpose_item(w_in, DM, N_IN, (bf16*)(ws + WS_WIN), 1, scr, r, F.lane); continue; } r -= I_IN;
        if (r < I_O) { transpose_item(w_oa, 1024, DM, (bf16*)(ws + WS_WOA), 0, scr, r, F.lane); continue; } r -= I_O;
        if (r < I_O) { transpose_item(w_ob, 1024, DM, (bf16*)(ws + WS_WOB), 0, scr, r, F.lane); continue; } r -= I_O;
        if (r < I_O) { transpose_item(w_oc, 1024, DM, (bf16*)(ws + WS_WOC), 0, scr, r, F.lane); continue; } r -= I_O;
        if (r < I_OUT) { transpose_item(w_out, DM, DM, (bf16*)(ws + WS_WOUT), 0, scr, r, F.lane); continue; } r -= I_OUT;
        if (r < I_UP) { transpose_item(w_up, DM, NUP, (bf16*)(ws + WS_WUP), 2, scr, r, F.lane); continue; } r -= I_UP;
        if (r < I_DN) { transpose_item(w_down, DFF, DM, (bf16*)(ws + WS_WDOWN), 0, scr, r, F.lane); continue; } r -= I_DN;
        if (r < I_PLE) { transpose_item(w_ple, PLE, DM, (bf16*)(ws + WS_WPLE), 0, scr, r, F.lane); continue; } r -= I_PLE;
        transpose_item(w_pg, DM, DM, (bf16*)(ws + WS_WPG), 0, scr, r, F.lane);
    }
    u32x4* z = (u32x4*)((bf16*)(ws + WS_WIN) + (size_t)8736 * DM);
    unsigned zz = 0u; asm volatile("" : "+v"(zz));
    for (int i = F.bid * NTHREADS + F.tid; i < 224 * DM / 8; i += F.G * NTHREADS) z[i] = (u32x4){zz, zz, zz, zz};
}
DI void rms_row_2048(const float* xrow, const float* g, bf16* orow, int lane) {
    const f32x4* xr = (const f32x4*)xrow + lane; f32x4 v[8]; float s = 0.f;
#pragma unroll
    for (int j = 0; j < 8; ++j) { v[j] = xr[64 * j]; s += (v[j].x * v[j].x + v[j].y * v[j].y) + (v[j].z * v[j].z + v[j].w * v[j].w); }
    const float r = rsqrtf(wave_sum(s) * (1.f / DM) + EPS);
    const f32x4* gr = (const f32x4*)g + lane; u32x2* o8 = (u32x2*)orow + lane;
#pragma unroll
    for (int j = 0; j < 8; ++j) { const f32x4 gg = gr[64 * j]; u32x2 w; w.x = pk2(v[j].x * r * gg.x, v[j].y * r * gg.y); w.y = pk2(v[j].z * r * gg.z, v[j].w * r * gg.w); o8[64 * j] = w; }
}
DI void rms_row_2048_b(const bf16* xrow, const float* g, bf16* orow, int lane) {
    const u32x4* xr = (const u32x4*)xrow + lane; u32x4 v[4]; float s = 0.f;
#pragma unroll
    for (int j = 0; j < 4; ++j) { v[j] = xr[64 * j];
#pragma unroll
        for (int k = 0; k < 4; ++k) { const float a = bflo(v[j][k]), b = bfhi(v[j][k]); s += a * a + b * b; } }
    const float r = rsqrtf(wave_sum(s) * (1.f / DM) + EPS);
    const f32x4* gr = (const f32x4*)g + 2 * lane; u32x4* o8 = (u32x4*)orow + lane;
#pragma unroll
    for (int j = 0; j < 4; ++j) { const f32x4 g0 = gr[128 * j], g1 = gr[128 * j + 1]; u32x4 w;
        w.x = pk2(bflo(v[j].x) * r * g0.x, bfhi(v[j].x) * r * g0.y); w.y = pk2(bflo(v[j].y) * r * g0.z, bfhi(v[j].y) * r * g0.w);
        w.z = pk2(bflo(v[j].z) * r * g1.x, bfhi(v[j].z) * r * g1.y); w.w = pk2(bflo(v[j].w) * r * g1.z, bfhi(v[j].w) * r * g1.w); o8[64 * j] = w; }
}
DI void phase_rms_b(Frame& F, const bf16* X, const float* g, bf16* HB) {
    const int gw = F.bid * NWAVES + F.wave, NGW = F.G * NWAVES;
    for (int m = gw; m < JR; m += NGW) rms_row_2048_b(X + (size_t)m * DM, g, HB + (size_t)m * DM, F.lane);
}
DI void phase_rms(Frame& F, const float* X, const float* g, bf16* HB) {
    const int gw = F.bid * NWAVES + F.wave, NGW = F.G * NWAVES;
    for (int m = gw; m < JR; m += NGW) rms_row_2048(X + (size_t)m * DM, g, HB + (size_t)m * DM, F.lane);
}
DI void prepB_math(float& a, float& b, const float ga, const float gb, float cr, float sr, float cc, float sc, int lane, float osc) {
    const float r = rsqrtf(wave_sum(a * a + b * b) * (1.f / 128.f) + EPS);
    a = a * r * ga; b = b * r * gb;
    const float pa = __shfl_xor(a, 32), pb = __shfl_xor(b, 32);
    a = (lane < 32 ? a * cr - pa * sr : a * cr + pa * sr) * osc;
    b = (lane < 32 ? b * cc - pb * sc : b * cc + pb * sc) * osc;
}
DI void prepC_math(float& a, float& b, const float g, float c, float s, int lane, float osc) {
    const float ra = rsqrtf(wave_sum(a * a) * (1.f / 64.f) + EPS), rb = rsqrtf(wave_sum(b * b) * (1.f / 64.f) + EPS);
    a = a * ra * g; b = b * rb * g;
    const float pa = __shfl_xor(a, 8), pb = __shfl_xor(b, 8);
    if (lane < 16) { a = lane < 8 ? a * c - pa * s : a * c + pa * s; b = lane < 8 ? b * c - pb * s : b * c + pb * s; }
    a *= osc; b *= osc;
}
template <int CTRL, int BANK> DI float dpp_f(float old, float v) { return __builtin_bit_cast(float, __builtin_amdgcn_update_dpp(__builtin_bit_cast(int, old), __builtin_bit_cast(int, v), CTRL, 0xF, BANK, false)); }
#define DPP_XOR1(v) __builtin_bit_cast(float, __builtin_amdgcn_update_dpp(0, __builtin_bit_cast(int, (v)), 0xB1, 0xF, 0xF, false))
#define DPP_XOR2(v) __builtin_bit_cast(float, __builtin_amdgcn_update_dpp(0, __builtin_bit_cast(int, (v)), 0x4E, 0xF, 0xF, false))
#define DPP_HMIR(v) __builtin_bit_cast(float, __builtin_amdgcn_update_dpp(0, __builtin_bit_cast(int, (v)), 0x141, 0xF, 0xF, false))
#define DPP_MIR(v)  __builtin_bit_cast(float, __builtin_amdgcn_update_dpp(0, __builtin_bit_cast(int, (v)), 0x140, 0xF, 0xF, false))
DI void phase_prep(Frame& F, CArgs* a, int layer, bf16* PJ, const JobGeo& jg) {
    const int gw = F.bid * NWAVES + F.wave, NGW = F.G * NWAVES, lane = F.lane, hs = lane >> 4, sub = lane & 15, s7 = sub & 7;
    const float* qn_b = a->in[10] + layer * 128; const float* kn_b = a->in[11] + layer * 128; const float* qn_c = a->in[12] + layer * 64; const float* kn_c = a->in[13] + layer * 64;
    constexpr float QSB = 0.088388347648318440f * 1.4426950408889634f, QSC = 0.125f * 1.4426950408889634f;
    float gqb[8], gkb[8], gqc[8], gkc[8], invB[8], invC[8];
#pragma unroll
    for (int k = 0; k < 8; ++k) { gqb[k] = qn_b[sub * 8 + k] * QSB; gkb[k] = kn_b[sub * 8 + k]; gqc[k] = qn_c[s7 * 8 + k] * QSC; gkc[k] = kn_c[s7 * 8 + k];
        invB[k] = exp2f(-(float)(2 * ((sub & 3) * 8 + k)) * (13.287712379549449f / 64.f));
        invC[k] = exp2f(-(float)(2 * k) * (18.931568569324174f / 16.f)); }
    const bool b_second = s7 >= 4;
    const bool c_rot = s7 < 2, c_second = (s7 & 1) != 0;
    for (int m = gw; m < JR; m += NGW) {
        const int pos = m % jg.seqlen; bf16* row = PJ + (size_t)m * LDPJ;
        u32x4 xb[3], xc[4];
#pragma unroll
        for (int g = 0; g < 3; ++g) { const int h = 4 * g + hs; xb[g] = *(const u32x4*)(row + PJ_BQ + (h < 10 ? h : 9) * 128 + sub * 8); }
#pragma unroll
        for (int g = 0; g < 4; ++g) xc[g] = *(const u32x4*)(row + PJ_CQ + (4 * g + hs) * 128 + sub * 8);
        float cB[8], sB[8], cC[8], sC[8]; const float angB = (float)((sub >> 3) ? (pos & 63) : (pos >> 6)), angC = (float)pos;
#pragma unroll
        for (int k = 0; k < 8; ++k) { sincos_(angB * invB[k], sB[k], cB[k]); sincos_(angC * invC[k], sC[k], cC[k]); if (!b_second) sB[k] = -sB[k]; if (!c_second) sC[k] = -sC[k]; }
#pragma unroll
        for (int g = 0; g < 3; ++g) {
            float x[8];
#pragma unroll
            for (int k = 0; k < 4; ++k) { x[2 * k] = bflo(xb[g][k]); x[2 * k + 1] = bfhi(xb[g][k]); }
            float sq = 0.f;
#pragma unroll
            for (int k = 0; k < 8; ++k) sq += x[k] * x[k];
            sq += DPP_XOR1(sq); sq += DPP_XOR2(sq); sq += DPP_HMIR(sq); sq += DPP_MIR(sq);
            const float r = rsqrtf(sq * (1.f / 128.f) + EPS);
            float o8[8];
#pragma unroll
            for (int k = 0; k < 8; ++k) { const float y = x[k] * r * (g < 2 ? gqb[k] : gkb[k]);
                float pr = dpp_f<0x104, 0x5>(0.f, y); pr = dpp_f<0x114, 0xA>(pr, y);
                o8[k] = y * cB[k] + pr * sB[k]; }
            const int h = 4 * g + hs;
            if (h < 10) { u32x4 w; w.x = pk2(o8[0], o8[1]); w.y = pk2(o8[2], o8[3]); w.z = pk2(o8[4], o8[5]); w.w = pk2(o8[6], o8[7]); *(u32x4*)(row + PJ_BQ + h * 128 + sub * 8) = w; }
        }
#pragma unroll
        for (int g = 0; g < 4; ++g) {
            float x[8];
#pragma unroll
            for (int k = 0; k < 4; ++k) { x[2 * k] = bflo(xc[g][k]); x[2 * k + 1] = bfhi(xc[g][k]); }
            float sq = 0.f;
#pragma unroll
            for (int k = 0; k < 8; ++k) sq += x[k] * x[k];
            sq += DPP_XOR1(sq); sq += DPP_XOR2(sq); sq += DPP_HMIR(sq);
            const float r = rsqrtf(sq * (1.f / 64.f) + EPS);
            float o8[8];
#pragma unroll
            for (int k = 0; k < 8; ++k) { const float y = x[k] * r * (g < 2 ? gqc[k] : gkc[k]); const float pr = DPP_XOR1(y); o8[k] = c_rot ? y * cC[k] + pr * sC[k] : y; }
            u32x4 w; w.x = pk2(o8[0], o8[1]); w.y = pk2(o8[2], o8[3]); w.z = pk2(o8[4], o8[5]); w.w = pk2(o8[6], o8[7]);
            *(u32x4*)(row + PJ_CQ + (4 * g + hs) * 128 + sub * 8) = w;
        }
    }
}
DI void phase_gdn_post(Frame& F, CArgs* a, int layer, bf16* OAF, const bf16* OAB, const bf16* PJ) {
    const int gw = F.bid * NWAVES + F.wave, NGW = F.G * NWAVES, hs = F.lane >> 4, sub = F.lane & 15; const float* nw = a->in[9] + layer * 128;
    float gn[8];
#pragma unroll
    for (int k = 0; k < 8; ++k) gn[k] = nw[sub * 8 + k];
    for (int m = gw; m < JR; m += NGW) {
        u32x4 wf[2], wb[2], wz[2];
#pragma unroll
        for (int g = 0; g < 2; ++g) { const int h = 4 * g + hs; wf[g] = *(const u32x4*)(OAF + (size_t)m * 1024 + h * 128 + sub * 8); wb[g] = *(const u32x4*)(OAB + (size_t)m * 1024 + h * 128 + sub * 8);
            wz[g] = *(const u32x4*)(PJ + (size_t)m * LDPJ + PJ_AZ + h * 128 + sub * 8); }
#pragma unroll
        for (int g = 0; g < 2; ++g) { float x[8], z[8];
#pragma unroll
            for (int k = 0; k < 4; ++k) { x[2 * k] = bflo(wf[g][k]) + bflo(wb[g][k]); x[2 * k + 1] = bfhi(wf[g][k]) + bfhi(wb[g][k]); z[2 * k] = bflo(wz[g][k]); z[2 * k + 1] = bfhi(wz[g][k]); }
            float sq = 0.f;
#pragma unroll
            for (int k = 0; k < 8; ++k) sq += x[k] * x[k];
            sq += DPP_XOR1(sq); sq += DPP_XOR2(sq); sq += DPP_HMIR(sq); sq += DPP_MIR(sq);
            const float r = rsqrtf(sq * (1.f / 128.f) + EPS);
            u32x4 w;
#pragma unroll
            for (int k = 0; k < 4; ++k) w[k] = pk2(x[2 * k] * r * gn[2 * k] * silu_(z[2 * k]), x[2 * k + 1] * r * gn[2 * k + 1] * silu_(z[2 * k + 1]));
            *(u32x4*)(OAF + (size_t)m * 1024 + (4 * g + hs) * 128 + sub * 8) = w; }
    }
}
DI void phase_diff_combine(Frame& F, CArgs* a, int layer, const bf16* OC2, bf16* OCP) {
    const int gw = F.bid * NWAVES + F.wave, NGW = F.G * NWAVES, hs = F.lane >> 4, sub = F.lane & 15;
    const float* lm = a->in[14] + layer * 256; const float* sub_g = a->in[15] + layer * 128;
    const float l01 = wave_sum(lm[F.lane] * lm[64 + F.lane]), l23 = wave_sum(lm[128 + F.lane] * lm[192 + F.lane]);
    const float linit = 0.8f - 0.6f * __expf(-0.3f * (float)layer), lam = __expf(l01) - __expf(l23) + linit, post = 1.f - linit;
    float gs[8];
#pragma unroll
    for (int k = 0; k < 8; ++k) gs[k] = sub_g[sub * 8 + k] * post;
    for (int m = gw; m < JR; m += NGW) {
        u32x4 w0[2], w1[2];
#pragma unroll
        for (int g = 0; g < 2; ++g) { const int h = 4 * g + hs; w0[g] = *(const u32x4*)(OC2 + (size_t)m * 2048 + (h * 2) * 128 + sub * 8); w1[g] = *(const u32x4*)(OC2 + (size_t)m * 2048 + (h * 2 + 1) * 128 + sub * 8); }
#pragma unroll
        for (int g = 0; g < 2; ++g) { float x[8];
#pragma unroll
            for (int k = 0; k < 4; ++k) { x[2 * k] = bflo(w0[g][k]) - lam * bflo(w1[g][k]); x[2 * k + 1] = bfhi(w0[g][k]) - lam * bfhi(w1[g][k]); }
            float sq = 0.f;
#pragma unroll
            for (int k = 0; k < 8; ++k) sq += x[k] * x[k];
            sq += DPP_XOR1(sq); sq += DPP_XOR2(sq); sq += DPP_HMIR(sq); sq += DPP_MIR(sq);
            const float r = rsqrtf(sq * (1.f / 128.f) + EPS);
            u32x4 w;
#pragma unroll
            for (int k = 0; k < 4; ++k) w[k] = pk2(x[2 * k] * r * gs[2 * k], x[2 * k + 1] * r * gs[2 * k + 1]);
            *(u32x4*)(OCP + (size_t)m * 1024 + (4 * g + hs) * 128 + sub * 8) = w; }
    }
}
DI void phase_conv_act(Frame& F, CArgs* a, int layer, const bf16* U, bf16* ACT, const JobGeo& jg) {
    const float* cw = a->in[22] + (size_t)layer * 3 * NUP; const float* cb = a->in[23] + (size_t)layer * NUP;
    constexpr int CPR = DFF / 8;
    for (int it = F.bid * NTHREADS + F.tid; it < (JR / 4) * CPR; it += F.G * NTHREADS) {
        const int m0 = (it / CPR) * 4, c = (it % CPR) * 8, pos0 = m0 % jg.seqlen;
        const bool okm = pos0 > 0, okp = pos0 + 4 < jg.seqlen;
        u32x4 xg[6], xv[6];
#pragma unroll
        for (int rr = 0; rr < 6; ++rr) { const int mr = m0 - 1 + rr; const int mc = (rr == 0 && !okm) ? m0 : ((rr == 5 && !okp) ? m0 + 3 : mr);
            xg[rr] = *(const u32x4*)(U + (size_t)mc * NUP + c); xv[rr] = *(const u32x4*)(U + (size_t)mc * NUP + DFF + c); }
        if (!okm) { xg[0] = xg[0] ^ xg[0]; xv[0] = xv[0] ^ xv[0]; }
        if (!okp) { xg[5] = xg[5] ^ xg[5]; xv[5] = xv[5] ^ xv[5]; }
        float acc[4][8];
#pragma unroll
        for (int half = 0; half < 2; ++half) { const int col = half * DFF + c;
            f32x4 w[3][2], bb[2];
#pragma unroll
            for (int tp = 0; tp < 3; ++tp) { w[tp][0] = *(const f32x4*)(cw + tp * NUP + col); w[tp][1] = *(const f32x4*)(cw + tp * NUP + col + 4); }
            bb[0] = *(const f32x4*)(cb + col); bb[1] = *(const f32x4*)(cb + col + 4);
#pragma unroll
            for (int rr = 0; rr < 4; ++rr)
#pragma unroll
                for (int k = 0; k < 4; ++k) { const unsigned wm = half ? xv[rr][k] : xg[rr][k], w0 = half ? xv[rr + 1][k] : xg[rr + 1][k], wp = half ? xv[rr + 2][k] : xg[rr + 2][k];
                    const int q = k >> 1, e = (2 * k) & 3;
                    const float yl = w[0][q][e] * bflo(wm) + w[1][q][e] * bflo(w0) + w[2][q][e] * bflo(wp) + bb[q][e];
                    const float yh = w[0][q][e + 1] * bfhi(wm) + w[1][q][e + 1] * bfhi(w0) + w[2][q][e + 1] * bfhi(wp) + bb[q][e + 1];
                    if (half == 0) { acc[rr][2 * k] = silu_(yl); acc[rr][2 * k + 1] = silu_(yh); } else { acc[rr][2 * k] *= yl; acc[rr][2 * k + 1] *= yh; } }
        }
#pragma unroll
        for (int rr = 0; rr < 4; ++rr) { u32x4 o; o.x = pk2(acc[rr][0], acc[rr][1]); o.y = pk2(acc[rr][2], acc[rr][3]); o.z = pk2(acc[rr][4], acc[rr][5]); o.w = pk2(acc[rr][6], acc[rr][7]);
            *(u32x4*)(ACT + ((size_t)(c >> 6) * JR + (m0 + rr)) * 64 + (c & 63)) = o; }
    }
}
DI void phase_conv_edges(Frame& F, CArgs* a, int layer, const bf16* UH, bf16* ACT, const JobGeo& jg) {
    const float* cw = a->in[22] + (size_t)layer * 3 * NUP; const float* cb = a->in[23] + (size_t)layer * NUP;
    constexpr int CPR = DFF / 8;
    for (int it = F.bid * NTHREADS + F.tid; it < 128 * CPR; it += F.G * NTHREADS) {
        const int e = it / CPR, c = (it % CPR) * 8, p = e >> 1, side = e & 1, row = 256 * p + (side ? 255 : 0), pos = row % jg.seqlen;
        const bool okm = pos > 0, okp = pos + 1 < jg.seqlen;
        const bf16* rm = side ? UH + (size_t)(p * 4 + 2) * NUP : UH + (size_t)((okm ? p - 1 : p) * 4 + 3) * NUP;
        const bf16* r0 = UH + (size_t)(p * 4 + (side ? 3 : 0)) * NUP;
        const bf16* rp = side ? UH + (size_t)((okp ? p + 1 : p) * 4 + 0) * NUP : UH + (size_t)(p * 4 + 1) * NUP;
        float acc[8];
#pragma unroll
        for (int half = 0; half < 2; ++half) { const int col = half * DFF + c;
            u32x4 xm = *(const u32x4*)(rm + col), x0 = *(const u32x4*)(r0 + col), xp = *(const u32x4*)(rp + col);
            if (!side && !okm) xm = xm ^ xm;
            if (side && !okp) xp = xp ^ xp;
            f32x4 w[3][2], bb[2];
#pragma unroll
            for (int tp = 0; tp < 3; ++tp) { w[tp][0] = *(const f32x4*)(cw + tp * NUP + col); w[tp][1] = *(const f32x4*)(cw + tp * NUP + col + 4); }
            bb[0] = *(const f32x4*)(cb + col); bb[1] = *(const f32x4*)(cb + col + 4);
#pragma unroll
            for (int k = 0; k < 4; ++k) { const int q = k >> 1, e2 = (2 * k) & 3;
                const float yl = w[0][q][e2] * bflo(xm[k]) + w[1][q][e2] * bflo(x0[k]) + w[2][q][e2] * bflo(xp[k]) + bb[q][e2];
                const float yh = w[0][q][e2 + 1] * bfhi(xm[k]) + w[1][q][e2 + 1] * bfhi(x0[k]) + w[2][q][e2 + 1] * bfhi(xp[k]) + bb[q][e2 + 1];
                if (half == 0) { acc[2 * k] = silu_(yl); acc[2 * k + 1] = silu_(yh); } else { acc[2 * k] *= yl; acc[2 * k + 1] *= yh; } }
        }
        u32x4 o; o.x = pk2(acc[0], acc[1]); o.y = pk2(acc[2], acc[3]); o.z = pk2(acc[4], acc[5]); o.w = pk2(acc[6], acc[7]);
        *(u32x4*)(ACT + ((size_t)(c >> 6) * JR + row) * 64 + (c & 63)) = o;
    }
}
DI void phase_pconvert(Frame& F, const float* P, bf16* PB) {
    for (int it = F.bid * NTHREADS + F.tid; it < JR * PLE / 8; it += F.G * NTHREADS) { const f32x4 a = *((const f32x4*)P + 2 * it), b = *((const f32x4*)P + 2 * it + 1);
        *((u32x4*)PB + it) = pg8::pack8(a, b); }
}
constexpr int G1_LF = 0, G1_TU = 17408, G1_TW = 26624, G1_TAB = 35840, G1_CW = 36864, G1_LB = 41472, G1_T1T = 44032, G1_T2R = 46592, G1_QN = 49152, G1_KN = 66560, G1_KT = 83968, G1_VT = 102400;
DI bf16x8 ldsfrag(const LAS unsigned char* p) { return *(const LAS bf16x8*)p; }
DI int kt_swz(int row) { return ((row >> 4) & 7) << 3; }
DI void phase_g1(Frame& F, CArgs* a, int layer, const bf16* PJ, const float* AB, unsigned char* G1B, float* GL, const JobGeo& jg) {
    const int wave = F.wave;
    LAS unsigned char* L = F.lds;
    LAS bf16* QN = (LAS bf16*)(L + G1_QN); LAS bf16* KN = (LAS bf16*)(L + G1_KN); LAS bf16* KT = (LAS bf16*)(L + G1_KT); LAS bf16* VT = (LAS bf16*)(L + G1_VT);
    LAS float* LF = (LAS float*)(L + G1_LF); LAS bf16* TU = (LAS bf16*)(L + G1_TU); LAS bf16* TW = (LAS bf16*)(L + G1_TW);
    LAS float* T_GC = (LAS float*)(L + G1_TAB); LAS float* T_BETA = T_GC + 64; LAS float* T_EGC = T_GC + 128; LAS float* T_EKD = T_GC + 192;
    LAS float* CW = (LAS float*)(L + G1_CW);
    LAS bf16* LB = (LAS bf16*)(L + G1_LB);
    LAS bf16* T1T = (LAS bf16*)(L + G1_T1T);
    LAS bf16* T2R = (LAS bf16*)(L + G1_T2R);
    u32x4 xr[18]; float pal = 0.f, pbl = 0.f; int hd_loaded = -1;
#define G1_PREFETCH(UU) do { const int dir_ = (UU) & 1, h_ = ((UU) >> 1) & 7, n_ = (UU) >> 4; const int t_ = n_ * 64 + (dir_ ? 63 - ci : ci); \
        const int s0_ = ((n_ * 64) / jg.seqlen) * jg.seqlen; const int om_ = t_ > s0_ ? LDPJ : 0, op_ = t_ < s0_ + jg.seqlen - 1 ? LDPJ : 0; \
        _Pragma("unroll") for (int part = 0; part < 3; ++part) { const bf16* p_ = PJ + (size_t)t_ * LDPJ + part * 1024 + h_ * 128 + cc; \
            xr[part * 6 + 0] = *(const u32x4*)p_; xr[part * 6 + 1] = *(const u32x4*)(p_ + 8); xr[part * 6 + 2] = *(const u32x4*)(p_ - om_); xr[part * 6 + 3] = *(const u32x4*)(p_ - om_ + 8); \
            xr[part * 6 + 4] = *(const u32x4*)(p_ + op_); xr[part * 6 + 5] = *(const u32x4*)(p_ + op_ + 8); } \
        if (wave == 0) { const int tl_ = n_ * 64 + (dir_ ? 63 - lane : lane); pal = AB[(size_t)tl_ * 32 + dir_ * 8 + h_]; pbl = AB[(size_t)tl_ * 32 + 16 + dir_ * 8 + h_]; } } while (0)
    int u = F.bid;
    { const int tid = F.tid, lane = F.lane, ci = tid >> 3, cc = (tid & 7) * 16; if (u < 4096) G1_PREFETCH(u); }
    for (; u < 4096; u += F.G) {
        int tid_o = F.tid; asm volatile("" : "+v"(tid_o));
        const int tid = tid_o, lane = tid & 63, r = lane & 31, hh = lane >> 5, ci = tid >> 3, cc = (tid & 7) * 16;
        const int dir = u & 1, h = (u >> 1) & 7, n = u >> 4;
        unsigned char* outb = G1B + (size_t)u * G1_UNIT_BYTES;
        if ((u & 15) != hd_loaded) {
            __syncthreads();
            if (tid < 288) { const int row = tid >> 5, d4 = (tid & 31) * 4, part = row / 3, tap = row % 3;
                *(LAS f32x4*)(CW + row * 128 + d4) = *(const f32x4*)(a->in[6] + (size_t)layer * 9216 + tap * 3072 + part * 1024 + h * 128 + d4); }
            hd_loaded = u & 15;
            __syncthreads();
        }
        if (wave == 0) {
            const float alog = a->in[7][layer * 16 + dir * 8 + h], dtb = a->in[8][layer * 16 + dir * 8 + h];
            float g = -__expf(alog) * softplus_(pal + dtb);
#pragma unroll
            for (int o = 1; o < 64; o <<= 1) { const float v = __shfl_up(g, o); if (lane >= o) g += v; }
            const float gl = __shfl(g, 63);
            T_GC[lane] = g; T_BETA[lane] = sigmoidf_(pbl); T_EGC[lane] = __expf(g); T_EKD[lane] = __expf(gl - g);
            if (lane == 0) GL[u] = __expf(gl);
        }
        {
            const int t = n * 64 + (dir ? 63 - ci : ci); const int s0 = ((n * 64) / jg.seqlen) * jg.seqlen; const bool okm = t > s0, okp = t < s0 + jg.seqlen - 1;
#pragma unroll
            for (int part = 0; part < 3; ++part) {
                float y[16];
#pragma unroll
                for (int hf = 0; hf < 2; ++hf) {
                    u32x4 c0 = xr[part * 6 + hf], m0 = xr[part * 6 + 2 + hf], n0 = xr[part * 6 + 4 + hf];
                    if (!okm) m0 = m0 ^ m0; if (!okp) n0 = n0 ^ n0;
                    const LAS float* w = CW + part * 384 + cc + 8 * hf;
                    const f32x4 wa0 = *(const LAS f32x4*)w, wa1 = *(const LAS f32x4*)(w + 4), wb0 = *(const LAS f32x4*)(w + 128), wb1 = *(const LAS f32x4*)(w + 132), wc0 = *(const LAS f32x4*)(w + 256), wc1 = *(const LAS f32x4*)(w + 260);
#pragma unroll
                    for (int k = 0; k < 4; ++k) { const float wl0 = k < 2 ? wa0[2 * k] : wa1[2 * k - 4], wh0 = k < 2 ? wa0[2 * k + 1] : wa1[2 * k - 3];
                        const float wl1 = k < 2 ? wb0[2 * k] : wb1[2 * k - 4], wh1 = k < 2 ? wb0[2 * k + 1] : wb1[2 * k - 3];
                        const float wl2 = k < 2 ? wc0[2 * k] : wc1[2 * k - 4], wh2 = k < 2 ? wc0[2 * k + 1] : wc1[2 * k - 3];
                        y[8 * hf + 2 * k] = silu_(wl0 * bflo(m0[k]) + wl1 * bflo(c0[k]) + wl2 * bflo(n0[k]));
                        y[8 * hf + 2 * k + 1] = silu_(wh0 * bfhi(m0[k]) + wh1 * bfhi(c0[k]) + wh2 * bfhi(n0[k])); }
                }
                float rs = 1.f;
                if (part < 2) { float sq = 0.f;
#pragma unroll
                    for (int e = 0; e < 16; ++e) sq += y[e] * y[e];
                    sq += __shfl_xor(sq, 1); sq += __shfl_xor(sq, 2); sq += __shfl_xor(sq, 4);
                    rs = rsqrtf(sq + EPS) * (part == 0 ? 0.088388347648318440f : 1.f); }
                if (part < 2) { LAS bf16* dst = part == 0 ? QN : KN; u32x4 q0, q1;
#pragma unroll
                    for (int k = 0; k < 4; ++k) { q0[k] = pk2(y[2 * k] * rs, y[2 * k + 1] * rs); q1[k] = pk2(y[8 + 2 * k] * rs, y[8 + 2 * k + 1] * rs); }
                    *(LAS u32x4*)(dst + ci * 136 + cc) = q0; *(LAS u32x4*)(dst + ci * 136 + cc + 8) = q1; }
                if (part >= 1) { LAS bf16* dT = part == 1 ? KT : VT; const int sw = kt_swz(cc);
#pragma unroll
                    for (int e = 0; e < 16; ++e) dT[(cc + e) * 72 + (ci ^ sw)] = f2bf(y[e] * rs); }
            }
        }
        if (u + F.G < 4096) G1_PREFETCH(u + F.G);
        __syncthreads();
        if (wave < 4) {
            const int it = wave >> 1, jt = wave & 1; f32x16 acc = {};
            if (!(it == 0 && jt == 1)) {
#pragma unroll
                for (int ks = 0; ks < 8; ++ks) acc = MFMA32(ldsfrag((const LAS unsigned char*)KN + (32 * it + r) * 272 + (16 * ks + 8 * hh) * 2), ldsfrag((const LAS unsigned char*)KN + (32 * jt + r) * 272 + (16 * ks + 8 * hh) * 2), acc);
            }
            const int j = 32 * jt + r; const float gcj = T_GC[j];
#pragma unroll
            for (int reg = 0; reg < 16; ++reg) { const int i = 32 * it + crow(reg, hh); const float v = (i > j) ? acc[reg] * T_BETA[i] * __expf(T_GC[i] - gcj) : 0.f;
                LF[i * 68 + j] = v; if (it == 1 && jt == 0) LB[crow(reg, hh) * 40 + r] = f2bf(v); }
        } else {
            const int w4 = wave - 4, ct = w4 >> 1, it = w4 & 1; f32x16 acc = {};
            if (!(it == 0 && ct == 1)) {
#pragma unroll
                for (int ks = 0; ks < 8; ++ks) acc = MFMA32(ldsfrag((const LAS unsigned char*)KN + (32 * ct + r) * 272 + (16 * ks + 8 * hh) * 2), ldsfrag((const LAS unsigned char*)QN + (32 * it + r) * 272 + (16 * ks + 8 * hh) * 2), acc);
            }
            const int i = 32 * it + r; const float gci = T_GC[i];
#pragma unroll
            for (int reg = 0; reg < 16; ++reg) { const int c = 32 * ct + crow(reg, hh); acc[reg] = (i >= c) ? acc[reg] * __expf(gci - T_GC[c]) : 0.f; }
            *(bf16x8*)(outb + G1_IN + ((it * 4 + 2 * ct + 0) * 64 + lane) * 16) = pack_step<0>(acc);
            *(bf16x8*)(outb + G1_IN + ((it * 4 + 2 * ct + 1) * 64 + lane) * 16) = pack_step<1>(acc);
        }
        __syncthreads();
        if (wave < 2) {
            const int b0 = wave * 32;
            float t[32]; const float lanef = (float)lane;
            const LAS float* lp = LF + b0 * 68 + b0;
            f32x4 lcur[8], lnxt[8];
#pragma unroll
            for (int q = 0; q < 8; ++q) { lcur[q] = (f32x4){0.f, 0.f, 0.f, 0.f}; lnxt[q] = (f32x4){0.f, 0.f, 0.f, 0.f}; }
#pragma unroll
            for (int c = 0; c < 32; ++c) {
                if (c + 1 < 32) {
#pragma unroll
                    for (int q = 0; q < 8; ++q) if (4 * q < c + 1) lnxt[q] = *(const LAS f32x4*)(lp + (c + 1) * 68 + 4 * q); }
                float a0 = fmaxf(0.f, 1.f - fabsf(lanef - (float)c)), a1 = 0.f;
#pragma unroll
                for (int q = 0; q < 8; ++q) if (4 * q < c) { const f32x4 l = lcur[q]; const int s4 = 4 * q;
                    a0 -= l[0] * t[s4]; if (s4 + 1 < c) a1 -= l[1] * t[s4 + 1]; if (s4 + 2 < c) a0 -= l[2] * t[s4 + 2]; if (s4 + 3 < c) a1 -= l[3] * t[s4 + 3]; }
                t[c] = a0 + a1; asm volatile("" : "+v"(t[c]), "+v"(lp));
#pragma unroll
                for (int q = 0; q < 8; ++q) lcur[q] = lnxt[q]; }
            if (lane < 32) {
                const int j = b0 + lane; const float bj = T_BETA[j], bej = bj * T_EGC[j];
#pragma unroll
                for (int c = 0; c < 32; ++c) { TU[(b0 + c) * 72 + j] = f2bf(t[c] * bj); TW[(b0 + c) * 72 + j] = f2bf(t[c] * bej); }
                if (wave == 0) {
#pragma unroll
                    for (int q = 0; q < 4; ++q) { u32x4 w; w.x = pk2(t[8 * q], t[8 * q + 1]); w.y = pk2(t[8 * q + 2], t[8 * q + 3]); w.z = pk2(t[8 * q + 4], t[8 * q + 5]); w.w = pk2(t[8 * q + 6], t[8 * q + 7]);
                        *(LAS u32x4*)(T1T + lane * 40 + 8 * q) = w; }
                } else {
#pragma unroll
                    for (int c = 0; c < 32; ++c) { T2R[c * 40 + lane] = f2bf(t[c]); TU[c * 72 + j] = 0; TW[c * 72 + j] = 0; }
                }
            }
        } else {
            for (int f = wave - 2; f < 32; f += 6) {
                if (f < 16) { const int mt = f >> 3, ks = f & 7, dt = ks >> 1, s = ks & 1; const int i = 32 * mt + r, d0 = 32 * dt + 16 * s + 4 * hh; const float e = T_EGC[i];
                    const u32x2 lo = *(const LAS u32x2*)(QN + i * 136 + d0), hi = *(const LAS u32x2*)(QN + i * 136 + d0 + 8);
                    u32x4 o; o.x = pk2(bflo(lo.x) * e, bfhi(lo.x) * e); o.y = pk2(bflo(lo.y) * e, bfhi(lo.y) * e); o.z = pk2(bflo(hi.x) * e, bfhi(hi.x) * e); o.w = pk2(bflo(hi.y) * e, bfhi(hi.y) * e);
                    *(u32x4*)(outb + G1_QD + (f * 64 + lane) * 16) = o;
                } else { const int g = f - 16, dt = g >> 2, ks = g & 3, ct = ks >> 1, s = ks & 1; const int d = 32 * dt + r, c0 = 32 * ct + 16 * s + 4 * hh, sw = kt_swz(d);
                    const u32x2 lo = *(const LAS u32x2*)(KT + d * 72 + (c0 ^ sw)), hi = *(const LAS u32x2*)(KT + d * 72 + ((c0 + 8) ^ sw));
                    const f32x4 e0 = *(const LAS f32x4*)(T_EKD + c0), e1 = *(const LAS f32x4*)(T_EKD + c0 + 8);
                    u32x4 o; o.x = pk2(bflo(lo.x) * e0[0], bfhi(lo.x) * e0[1]); o.y = pk2(bflo(lo.y) * e0[2], bfhi(lo.y) * e0[3]); o.z = pk2(bflo(hi.x) * e1[0], bfhi(hi.x) * e1[1]); o.w = pk2(bflo(hi.y) * e1[2], bfhi(hi.y) * e1[3]);
                    *(u32x4*)(outb + G1_KD + (g * 64 + lane) * 16) = o; }
            }
        }
        __syncthreads();
        if (wave == 0) {
            f32x16 x = {};
#pragma unroll
            for (int ks = 0; ks < 2; ++ks) x = MFMA32(ldsfrag((const LAS unsigned char*)LB + r * 80 + (16 * ks + 8 * hh) * 2), ldsfrag((const LAS unsigned char*)T1T + r * 80 + (16 * ks + 8 * hh) * 2), x);
            f32x16 t21 = {};
            { const u32x2 lo = *(const LAS u32x2*)(T2R + r * 40 + 4 * hh), hi = *(const LAS u32x2*)(T2R + r * 40 + 8 + 4 * hh); const u32x4 af = {lo.x, lo.y, hi.x, hi.y};
              t21 = MFMA32(__builtin_bit_cast(bf16x8, af), pack_step<0>(x), t21); }
            { const u32x2 lo = *(const LAS u32x2*)(T2R + r * 40 + 16 + 4 * hh), hi = *(const LAS u32x2*)(T2R + r * 40 + 24 + 4 * hh); const u32x4 af = {lo.x, lo.y, hi.x, hi.y};
              t21 = MFMA32(__builtin_bit_cast(bf16x8, af), pack_step<1>(x), t21); }
            const float bj = T_BETA[r], bej = bj * T_EGC[r];
#pragma unroll
            for (int reg = 0; reg < 16; ++reg) { const int i = 32 + crow(reg, hh); TU[i * 72 + r] = f2bf(-t21[reg] * bj); TW[i * 72 + r] = f2bf(-t21[reg] * bej); }
        }
        __syncthreads();
        {
            const int dt = wave >> 1, it = wave & 1; f32x16 acc = {};
#pragma unroll
            for (int ks = 0; ks < 4; ++ks) acc = MFMA32(ldsfrag((const LAS unsigned char*)KT + (32 * dt + r) * 144 + ((16 * ks + 8 * hh) ^ kt_swz(32 * dt + r)) * 2), ldsfrag((const LAS unsigned char*)TW + (32 * it + r) * 144 + (16 * ks + 8 * hh) * 2), acc);
            *(bf16x8*)(outb + G1_W + ((it * 8 + 2 * dt + 0) * 64 + lane) * 16) = pack_step<0>(acc);
            *(bf16x8*)(outb + G1_W + ((it * 8 + 2 * dt + 1) * 64 + lane) * 16) = pack_step<1>(acc);
            const int et = wave >> 1; f32x16 au = {};
#pragma unroll
            for (int ks = 0; ks < 4; ++ks) au = MFMA32(ldsfrag((const LAS unsigned char*)TU + (32 * it + r) * 144 + (16 * ks + 8 * hh) * 2), ldsfrag((const LAS unsigned char*)VT + (32 * et + r) * 144 + ((16 * ks + 8 * hh) ^ kt_swz(32 * et + r)) * 2), au);
            *(bf16x8*)(outb + G1_U + ((et * 2 + it) * 64 + lane) * 32) = pack_step<0>(au);
            *(bf16x8*)(outb + G1_U + ((et * 2 + it) * 64 + lane) * 32 + 16) = pack_step<1>(au);
        }
        __syncthreads();
    }
#undef G1_PREFETCH
}
DI void scan_unit(Frame& F, const unsigned char* G1B, const float* GL, bf16* OAF, bf16* OAB, int sid, const JobGeo& jg) {
    const int seq = sid >> 4, h = (sid >> 1) & 7, dir = sid & 1, N = jg.seqlen >> 6;
    const int tid = F.tid, lane = F.lane, wave = F.wave, r = lane & 31, hh = lane >> 5;
    bf16* OUT = dir ? OAB : OAF;
    f32x16 S0 = {}, S1 = {}, S2 = {}, S3 = {};
    const int lt = tid - 256;
    if (wave >= 4) {
        const int n = seq * N + (dir ? N - 1 : 0); const unsigned char* up = G1B + ((size_t)(n * 8 + h) * 2 + dir) * G1_UNIT_BYTES;
        u32x4 stg[14];
#pragma unroll
        for (int k = 0; k < 14; ++k) stg[k] = *(const u32x4*)(up + lt * 16 + k * 4096);
#pragma unroll
        for (int k = 0; k < 14; ++k) *(LAS u32x4*)(F.lds + lt * 16 + k * 4096) = stg[k];
    }
    __syncthreads();
    for (int st = 0; st < N; ++st) {
        const int n = seq * N + (dir ? N - 1 - st : st); const int unit = (n * 8 + h) * 2 + dir;
        const unsigned char* up = G1B + (size_t)unit * G1_UNIT_BYTES;
        if (wave < 4) {
            const LAS unsigned char* sl = F.lds + (st & 1) * G1_STAGE + lane * 16;
            const unsigned char* uu = up + G1_U + ((wave * 2) * 64 + lane) * 32;
            const u32x4 u0a = *(const u32x4*)uu, u0b = *(const u32x4*)(uu + 16), u1a = *(const u32x4*)(uu + 2048), u1b = *(const u32x4*)(uu + 2048 + 16);
            const float egl = GL[unit];
            f32x16 ws0 = {}, ws1 = {}, o0 = {}, o1 = {};
#define SCAN_STEP1(SX, DT) do { { const bf16x8 fr = pack_step<0>(SX); const int ks = 2 * (DT); \
                ws0 = MFMA32(ldsfrag(sl + G1_W + ks * 1024), fr, ws0); ws1 = MFMA32(ldsfrag(sl + G1_W + (8 + ks) * 1024), fr, ws1); \
                o0 = MFMA32(ldsfrag(sl + G1_QD + ks * 1024), fr, o0); o1 = MFMA32(ldsfrag(sl + G1_QD + (8 + ks) * 1024), fr, o1); } asm volatile("" ::: "memory"); \
              { const bf16x8 fr = pack_step<1>(SX); const int ks = 2 * (DT) + 1; \
                ws0 = MFMA32(ldsfrag(sl + G1_W + ks * 1024), fr, ws0); ws1 = MFMA32(ldsfrag(sl + G1_W + (8 + ks) * 1024), fr, ws1); \
                o0 = MFMA32(ldsfrag(sl + G1_QD + ks * 1024), fr, o0); o1 = MFMA32(ldsfrag(sl + G1_QD + (8 + ks) * 1024), fr, o1); } asm volatile("" ::: "memory"); } while (0)
            SCAN_STEP1(S0, 0); SCAN_STEP1(S1, 1); SCAN_STEP1(S2, 2); SCAN_STEP1(S3, 3);
#undef SCAN_STEP1
            f32x16 vn0, vn1;
#pragma unroll
            for (int k = 0; k < 4; ++k) { vn0[2 * k] = bflo(u0a[k]) - ws0[2 * k]; vn0[2 * k + 1] = bfhi(u0a[k]) - ws0[2 * k + 1]; vn0[8 + 2 * k] = bflo(u0b[k]) - ws0[8 + 2 * k]; vn0[8 + 2 * k + 1] = bfhi(u0b[k]) - ws0[8 + 2 * k + 1];
                vn1[2 * k] = bflo(u1a[k]) - ws1[2 * k]; vn1[2 * k + 1] = bfhi(u1a[k]) - ws1[2 * k + 1]; vn1[8 + 2 * k] = bflo(u1b[k]) - ws1[8 + 2 * k]; vn1[8 + 2 * k + 1] = bfhi(u1b[k]) - ws1[8 + 2 * k + 1]; }
            S0 *= egl; S1 *= egl; S2 *= egl; S3 *= egl;
#define SCAN_STEP2(VN, CT, SS) do { const bf16x8 vf = pack_step<SS>(VN); const int ks = 2 * (CT) + (SS); \
                o0 = MFMA32(ldsfrag(sl + G1_IN + ks * 1024), vf, o0); o1 = MFMA32(ldsfrag(sl + G1_IN + (4 + ks) * 1024), vf, o1); \
                S0 = MFMA32(ldsfrag(sl + G1_KD + (0 + ks) * 1024), vf, S0); S1 = MFMA32(ldsfrag(sl + G1_KD + (4 + ks) * 1024), vf, S1); \
                S2 = MFMA32(ldsfrag(sl + G1_KD + (8 + ks) * 1024), vf, S2); S3 = MFMA32(ldsfrag(sl + G1_KD + (12 + ks) * 1024), vf, S3); asm volatile("" ::: "memory"); } while (0)
            SCAN_STEP2(vn0, 0, 0); SCAN_STEP2(vn0, 0, 1); SCAN_STEP2(vn1, 1, 0); SCAN_STEP2(vn1, 1, 1);
#undef SCAN_STEP2
            const long rs = dir ? -1024 : 1024;
            bf16* ob = OUT + (size_t)(n * 64 + (dir ? 63 : 0)) * 1024 + h * 128 + 32 * wave + r + (long)(4 * hh) * rs;
#pragma unroll
            for (int reg = 0; reg < 16; ++reg) { ob[0] = f2bf(o0[reg]); ob[32 * rs] = f2bf(o1[reg]);
                ob += ((reg & 3) == 3 ? 5 : 1) * rs; asm volatile("" : "+v"(ob)); }
        }
        if (wave >= 4 && st + 1 < N) {
            const int n2 = seq * N + (dir ? N - 2 - st : st + 1); const unsigned char* up2 = G1B + ((size_t)(n2 * 8 + h) * 2 + dir) * G1_UNIT_BYTES;
            u32x4 stg[14];
#pragma unroll
            for (int k = 0; k < 14; ++k) stg[k] = *(const u32x4*)(up2 + lt * 16 + k * 4096);
#pragma unroll
            for (int k = 0; k < 14; ++k) *(LAS u32x4*)(F.lds + ((st + 1) & 1) * G1_STAGE + lt * 16 + k * 4096) = stg[k];
        }
        __syncthreads();
    }
}
constexpr int NPHASE = 16;
#ifndef ATTN_BODY
#define ATTN_BODY attn_dma_body
#endif
#ifndef PG8_SP2
#define PG8_SP2 true
#endif
#ifndef PG8_ALIGN
#define PG8_ALIGN true
#endif
__global__ void __launch_bounds__(NTHREADS, 2) fwd_kernel(Args a) {
    extern __shared__ __attribute__((aligned(16))) unsigned char lds_raw[];
    Frame F;
    F.lds = (LAS unsigned char*)lds_raw; F.MISC = (volatile LAS unsigned*)(F.lds + MISC_OFF);
    F.tid = threadIdx.x; F.lane = F.tid & 63; F.wave = __builtin_amdgcn_readfirstlane(F.tid >> 6); F.G = gridDim.x; F.bid = blockIdx.x;
    const int wave0 = F.wave;
    CArgs* ap = (CArgs*)__builtin_amdgcn_kernarg_segment_ptr();
    F.ws = ap->ws; F.ctl = (gu32*)(ap->ws + WS_CTL);
    const int one_launch = ap->one_launch, ph_lo = ap->ph_lo, ph_hi = ap->ph_hi;
    for (int u = F.tid; u < (LDS_BYTES - LDSCTL_OFF) / 4; u += NTHREADS) ((LAS unsigned*)(F.lds + LDSCTL_OFF))[u] = 0u;
    __syncthreads();
    XcdBarrier bar; bar.bar = (unsigned*)(F.ctl + CW_BAR); bar.x = 0; bar.st = nullptr;
    if (one_launch) bar = xcd_barrier_post((unsigned*)(F.ctl + CW_BAR), F.MISC + 8);
#ifndef PROBE_MASK
#define PROBE_MASK 0
#endif
#ifndef PROBE_BID
#define PROBE_BID 0
#endif
    unsigned long long pr_acc = 0, pr_t0 = 0; (void)pr_t0;
#define PSTART() do { if (PROBE_MASK) pr_t0 = __builtin_amdgcn_s_memrealtime(); } while (0)
#define PEND(k) do { if (PROBE_MASK && ((PROBE_MASK >> (k)) & 1)) pr_acc += __builtin_amdgcn_s_memrealtime() - pr_t0; } while (0)
#define SEAM() do { if (one_launch) { XcdBarrier b2_ = bar; asm volatile("" : "+s"(b2_.bar), "+s"(b2_.x)); xcd_barrier(b2_, F.wave == 0 && __builtin_amdgcn_mbcnt_hi(~0u, __builtin_amdgcn_mbcnt_lo(~0u, 0u)) == 0u); } } while (0)
#define REFRESH() int layer = layer_i, job = job_i; asm volatile("" : "+s"(layer), "+s"(job)); const JobGeo jg = job_geo(job); (void)jg; do { int w_ = wave0; asm volatile("" : "+s"(w_)); int t_ = (w_ << 6) | (int)__builtin_amdgcn_mbcnt_hi(~0u, __builtin_amdgcn_mbcnt_lo(~0u, 0u)); asm volatile("" : "+v"(t_)); F.tid = t_; F.lane = t_ & 63; F.wave = __builtin_amdgcn_readfirstlane(t_ >> 6); asm volatile("" : "+s"(ap)); F.ws = ap->ws; F.ctl = (gu32*)(F.ws + OPQ(WS_CTL)); int b_ = blockIdx.x, g_ = gridDim.x; asm volatile("" : "+s"(b_), "+s"(g_)); F.bid = b_; F.G = g_; } while (0)
#ifndef PH4MASK
#define PH4MASK 7
#endif
#ifndef PHMASK
#define PHMASK 0xffff
#endif
#define IN(k) (((PHMASK >> (k)) & 1) && ({ int lo_ = ph_lo, hi_ = ph_hi; asm volatile("" : "+s"(lo_), "+s"(hi_)); lo_ <= (k) && (k) < hi_; }))
#define OPQ(x) ({ size_t c_ = (x); asm volatile("" : "+s"(c_)); c_; })
#define XIN0 (job == 0 ? ap->in[0] : ap->in[1] + (size_t)(job - 1) * JR * DM)
#define HB ((bf16*)(F.ws + OPQ(WS_HB)))
#define AB ((float*)(F.ws + OPQ(WS_AB)))
#define PB ((bf16*)(F.ws + OPQ(WS_PB)))
#define GL ((float*)(F.ws + OPQ(WS_GL)))
#define OAF ((bf16*)(F.ws + OPQ(WS_OAF)))
#define OAB ((bf16*)(F.ws + OPQ(WS_OAB)))
#define OB ((bf16*)(F.ws + OPQ(WS_OB)))
#define OC2 ((bf16*)(F.ws + OPQ(WS_OC2)))
#define OCP ((bf16*)(F.ws + OPQ(WS_OCP)))
#define XLB ((bf16*)(ap->out + (size_t)jg.row0 * DM))
#define X9B ((bf16*)(F.ws + OPQ(WS_OC2)))
#define PJ ((bf16*)(F.ws + OPQ(WS_PJ)))
#define G1B (F.ws + OPQ(WS_G1))
#define GT ((bf16*)(F.ws + OPQ(WS_GT)))
#define MG ((bf16*)(F.ws + OPQ(WS_MG)))
#define UB ((bf16*)(F.ws + OPQ(WS_U)))
#define ACT ((bf16*)(F.ws + OPQ(WS_ACT)))
#define PL ((bf16*)(F.ws + OPQ(WS_PL)))
#define Win_t ((const bf16*)(F.ws + OPQ(WS_WIN)))
    const int l0 = ap->l0, l1 = ap->l1, j0 = ap->j0, j1 = ap->j1;
    for (int layer_i = l0; layer_i < l1; ++layer_i) { const int job_i = 0;
        if (IN(0)) { REFRESH(); PSTART(); phase_weights(F, ap, layer); if (!one_launch) { SEAM(); } PEND(0); }
        for (int job_i = j0; job_i < j1; ++job_i) {

            if (IN(1)) { REFRESH(); PSTART(); if (layer == 0) phase_rms(F, XIN0, ap->in[4] + layer * DM, HB); else phase_rms_b(F, XLB, ap->in[4] + layer * DM, HB); SEAM(); PEND(1); }
            if (IN(2)) { REFRESH(); PSTART();
                pg8::Gemm g{HB, Win_t, JR, NP1, DM, DM, DM, 128}; pg8::StaticOrder S; S.init(JR, NP1, F.G, F.bid);
                pg8::EpiProj E{PJ, AB};
                pg8::gemm_phase<pg8::EpiProj, pg8::StaticOrder, PG8_ALIGN, PG8_SP2>(F.lds, g, S, E, F.wave);
                SEAM(); PEND(2);
            }
            if (IN(3)) { REFRESH(); PSTART();
                phase_g1(F, ap, layer, PJ, AB, G1B, GL, jg);
#if PROBE_MASK == 0x10000
                pr_acc += __builtin_amdgcn_s_memrealtime() - pr_t0;
#endif
#if PROBE_MASK == 0x100000
                pr_t0 = __builtin_amdgcn_s_memrealtime();
#endif
                phase_prep(F, ap, layer, PJ, jg);
#if PROBE_MASK == 0x100000
                pr_acc += __builtin_amdgcn_s_memrealtime() - pr_t0;
#endif
                { const float* P = job == 0 ? ap->in[2] + (size_t)layer * 16384 * PLE : ap->in[3] + ((size_t)layer * 32768 + (size_t)(job - 1) * 16384) * PLE;
                  phase_pconvert(F, P, PB); }
                SEAM(); PEND(3);
            }
            if (IN(4)) { REFRESH(); PSTART();
                gu32* qh = F.ctl + CW_Q + 64 * (layer * NJOB + job);
                const int nscan = jg.nseq * 16, ntot = nscan + 512 + 1024;
#define QNEXT() do { __syncthreads(); if (F.tid == 0) F.MISC[16] = __hip_atomic_fetch_add(qh, 1u, RLX_AGENT); __syncthreads(); u = (int)F.MISC[16]; } while (0)
                int u; QNEXT();
#if (PH4MASK & 1)
                while (u < nscan) { scan_unit(F, G1B, GL, OAF, OAB, u, jg); __syncthreads(); if (F.tid == 0) __hip_atomic_fetch_add(qh + 2, 1u, __ATOMIC_RELEASE, __HIP_MEMORY_SCOPE_AGENT); QNEXT(); }
#endif
                bool fastB, fastC;
                { const float* qb_ = ap->in[10] + layer * 128; const float* kb_ = ap->in[11] + layer * 128; const float* qc_ = ap->in[12] + layer * 64; const float* kc_ = ap->in[13] + layer * 64;
                  float g1 = fmaxf(fabsf(qb_[F.lane]), fabsf(qb_[64 + F.lane])), g2 = fmaxf(fabsf(kb_[F.lane]), fabsf(kb_[64 + F.lane])), g3 = fabsf(qc_[F.lane]), g4 = fabsf(kc_[F.lane]);
#pragma unroll
                  for (int o = 1; o < 64; o <<= 1) { g1 = fmaxf(g1, __shfl_xor(g1, o)); g2 = fmaxf(g2, __shfl_xor(g2, o)); g3 = fmaxf(g3, __shfl_xor(g3, o)); g4 = fmaxf(g4, __shfl_xor(g4, o)); }
                  fastB = __builtin_amdgcn_readfirstlane((int)(1.4426950408889634f * 11.313708498984761f * g1 * g2 <= 60.f)) != 0;
                  fastC = __builtin_amdgcn_readfirstlane((int)(1.4426950408889634f * 8.f * g3 * g4 <= 60.f)) != 0; }
#define ATT_B(FASTV) do { unsigned long long tb_ = 0; if (PROBE_MASK == 0x20000) tb_ = __builtin_amdgcn_s_memrealtime(); const int v = u - nscan, hq = v >> 6, qb = v & 63, s0 = ((qb * 256) / jg.seqlen) * jg.seqlen; \
                    att::ATTN_BODY<LDPJ, LDPJ, 1024, 8, FASTV>(PJ + (size_t)(qb * 256) * LDPJ + PJ_BQ + hq * 128, PJ + (size_t)s0 * LDPJ + PJ_BK + (hq >> 2) * 128, PJ + (size_t)s0 * LDPJ + PJ_BV + (hq >> 2) * 128, \
                                                                 OB + (size_t)(qb * 256) * 1024 + hq * 128, jg.seqlen, 0, (char*)lds_raw, F.tid, (unsigned*)qh, F.MISC + 16); if (PROBE_MASK == 0x20000 && pr_acc == 0 && layer == 0 && job == 0) pr_acc = 16ull * (__builtin_amdgcn_s_memrealtime() - tb_); u = (int)F.MISC[16]; } while (0)
#define ATT_C(FASTV) do { unsigned long long tb_ = 0; if (PROBE_MASK == 0x40000) tb_ = __builtin_amdgcn_s_memrealtime(); const int v = u - nscan - 512, hc = v >> 6, qb = v & 63, h = hc >> 1, comp = hc & 1, s0 = ((qb * 256) / jg.seqlen) * jg.seqlen; \
                    att::ATTN_BODY<LDPJ, LDPJ, 2048, 4, FASTV>(PJ + (size_t)(qb * 256) * LDPJ + PJ_CQ + h * 128, PJ + (size_t)s0 * LDPJ + PJ_CK + h * 128, PJ + (size_t)s0 * LDPJ + PJ_CV + h * 128, \
                                                                 OC2 + (size_t)(qb * 256) * 2048 + hc * 128, jg.seqlen, comp * 4, (char*)lds_raw, F.tid, (unsigned*)qh, F.MISC + 16); if (PROBE_MASK == 0x40000 && pr_acc == 0 && layer == 0 && job == 0) pr_acc = 16ull * (__builtin_amdgcn_s_memrealtime() - tb_); u = (int)F.MISC[16]; } while (0)
#if (PH4MASK & 2)
                if (fastB) { while (u < nscan + 512) ATT_B(true); } else { while (u < nscan + 512) ATT_B(false); }
#endif
#if (PH4MASK & 4)
                if (fastC) { while (u < ntot) ATT_C(true); } else { while (u < ntot) ATT_C(false); }
#endif
#undef ATT_B
#undef ATT_C
                if (u < ntot + 1536 + 256) { if (F.tid == 0) { while (__hip_atomic_load(qh + 2, __ATOMIC_RELAXED, __HIP_MEMORY_SCOPE_AGENT) < (unsigned)nscan) __builtin_amdgcn_s_sleep(8); } __syncthreads(); }
                { pg8::Gemm g{HB, Win_t + (size_t)NP1 * DM, JR, 2048, DM, DM, DM, 128}; pg8::EpiSigmoid E{PJ + PJ_AQ, LDPJ};
                  while (u < ntot + 512) { pg8::OneTile S; S.init(JR, 2048, 1, u - ntot);
                      pg8::gemm_phase<pg8::EpiSigmoid, pg8::OneTile, PG8_ALIGN, PG8_SP2>(F.lds, g, S, E, F.wave); QNEXT(); } }
                { pg8::Gemm g{HB, Win_t + (size_t)(NP1 + 2048) * DM, JR, NGT - 2048, DM, DM, DM, 128}; pg8::EpiSigmoid E{GT + 2048, NGT};
                  while (u < ntot + 1536) { pg8::OneTile S; S.init(JR, NGT - 2048, 1, u - ntot - 512);
                      pg8::gemm_phase<pg8::EpiSigmoid, pg8::OneTile, PG8_ALIGN, PG8_SP2>(F.lds, g, S, E, F.wave); QNEXT(); } }
                if (u < ntot + 1536 + 256) { if (F.tid == 0) (void)__hip_atomic_load(qh + 2, __ATOMIC_ACQUIRE, __HIP_MEMORY_SCOPE_AGENT); __syncthreads(); }
                while (u < ntot + 1536 + 256) { Frame F2 = F; F2.bid = u - ntot - 1536; F2.G = 256; phase_gdn_post(F2, ap, layer, OAF, OAB, PJ); QNEXT(); }
#undef QNEXT
#if PROBE_MASK == 0x200000
                pr_t0 = __builtin_amdgcn_s_memrealtime();
#endif
                SEAM(); PEND(4);
#if PROBE_MASK == 0x200000
                pr_acc += __builtin_amdgcn_s_memrealtime() - pr_t0;
#endif
            }
            if (IN(5)) { REFRESH(); PSTART();
                phase_diff_combine(F, ap, layer, OC2, OCP);
#if PROBE_MASK == 0x80000
                pr_acc += __builtin_amdgcn_s_memrealtime() - pr_t0;
#endif
                SEAM(); PEND(5);
            }
            if (IN(6)) { REFRESH(); PSTART();
                { pg8::Gemm g{OAF, (const bf16*)(F.ws + OPQ(WS_WOA)), JR, DM, 1024, 1024, 1024, 128}; pg8::MultiOrder<3> S; S.init(JR, DM, F.G, F.bid);
                  static_assert(WS_WOB - WS_WOA == WS_WOC - WS_WOB, "merge weights must be equally spaced");
                  pg8::EpiMerge3 E{MG, GT, NGT, PJ + PJ_AQ, LDPJ, OAF, (const bf16*)(F.ws + OPQ(WS_WOA)), (long)((WS_OB - WS_OAF) / 2), (long)((WS_OCP - WS_OB) / 2) - (long)((WS_OB - WS_OAF) / 2), (long)((WS_WOB - WS_WOA) / 2)};
                  pg8::gemm_phase<pg8::EpiMerge3, pg8::MultiOrder<3>, PG8_ALIGN, PG8_SP2>(F.lds, g, S, E, F.wave); }
                SEAM(); PEND(6);
            }
            if (IN(9)) { REFRESH(); PSTART();
                pg8::Gemm g{MG, (const bf16*)(F.ws + OPQ(WS_WOUT)), JR, DM, DM, DM, DM, 128}; pg8::StaticOrder S; S.init(JR, DM, F.G, F.bid);
                if (layer == 0) { pg8::EpiResidToB E{X9B, XIN0}; pg8::gemm_phase<pg8::EpiResidToB, pg8::StaticOrder, PG8_ALIGN, PG8_SP2>(F.lds, g, S, E, F.wave); }
                else { pg8::EpiResidBB E{X9B, XLB}; pg8::gemm_phase<pg8::EpiResidBB, pg8::StaticOrder, PG8_ALIGN, PG8_SP2>(F.lds, g, S, E, F.wave); }
                SEAM(); PEND(9);
            }
            if (IN(10)) { REFRESH(); PSTART(); phase_rms_b(F, X9B, ap->in[20] + layer * DM, HB); SEAM(); PEND(10); }
            if (IN(11)) { REFRESH(); PSTART();
                pg8::Gemm g{HB, (const bf16*)(F.ws + OPQ(WS_WUP)), JR, NUP, DM, DM, DM, 128}; pg8::StaticOrder S; S.init(JR, NUP, F.G, F.bid);
                pg8::EpiConvAct E{ACT, UB, ap->in[22] + (size_t)layer * 3 * NUP, ap->in[23] + (size_t)layer * NUP, (PG8_LAS float*)(F.lds + LDSCTL_OFF + 2048)};
                pg8::gemm_phase<pg8::EpiConvAct, pg8::StaticOrder, PG8_ALIGN, PG8_SP2>(F.lds, g, S, E, F.wave);
                SEAM(); PEND(11);
            }
            if (IN(12)) { REFRESH(); PSTART();
                phase_conv_edges(F, ap, layer, UB, ACT, jg);
                __syncthreads();
                { pg8::Gemm g{PB, (const bf16*)(F.ws + OPQ(WS_WPLE)), JR, DM, PLE, PLE, PLE, 128}; pg8::StaticOrder S; S.init(JR, DM, F.G, F.bid);
                  pg8::EpiStoreBf16 E{PL, DM};
                  pg8::gemm_phase<pg8::EpiStoreBf16, pg8::StaticOrder, PG8_ALIGN, PG8_SP2>(F.lds, g, S, E, F.wave); }
                SEAM(); PEND(12);
            }
            if (IN(13)) { REFRESH(); PSTART();
                pg8::Gemm g{ACT, (const bf16*)(F.ws + OPQ(WS_WDOWN)), JR, DM, DFF, 64, DFF, (size_t)JR * 128};   pg8::StaticOrder S; S.init(JR, DM, F.G, F.bid);
                pg8::EpiResidBB E{HB, X9B};
                pg8::gemm_phase<pg8::EpiResidBB, pg8::StaticOrder, PG8_ALIGN, PG8_SP2>(F.lds, g, S, E, F.wave);
                SEAM(); PEND(13);
            }
            if (IN(15)) { REFRESH(); PSTART();
                pg8::Gemm g{HB, (const bf16*)(F.ws + OPQ(WS_WPG)), JR, DM, DM, DM, DM, 128}; pg8::StaticOrder S; S.init(JR, DM, F.G, F.bid);
                if (layer == NLAYER - 1) { pg8::EpiPleB E{ap->out + (size_t)jg.row0 * DM, HB, PL}; pg8::gemm_phase<pg8::EpiPleB, pg8::StaticOrder, PG8_ALIGN, PG8_SP2>(F.lds, g, S, E, F.wave); }
                else { pg8::EpiPleBB E{XLB, HB, PL}; pg8::gemm_phase<pg8::EpiPleBB, pg8::StaticOrder, PG8_ALIGN, PG8_SP2>(F.lds, g, S, E, F.wave); }
                SEAM(); PEND(15);
            }
        }
    }
    if (PROBE_MASK && F.bid == PROBE_BID) { const unsigned long long t0 = __builtin_amdgcn_s_memrealtime(); while (__builtin_amdgcn_s_memrealtime() - t0 < 4ull * pr_acc) __builtin_amdgcn_s_sleep(16); }
#undef SEAM
#undef IN
#undef HB
#undef XIN0
#undef AB
#undef PB
#undef GL
#undef OAF
#undef OAB
#undef OB
#undef OC2
#undef OCP
#undef X9B
#undef XLB
#undef PJ
#undef G1B
#undef GT
#undef MG
#undef UB
#undef ACT
#undef PL
#undef Win_t
}

#ifndef MK_ONE_LAUNCH
#define MK_ONE_LAUNCH 1
#endif
extern "C" void kernel_launch(void* const* d_in, const int* in_sizes, int n_in, void* d_out, int out_size, void* d_ws, size_t ws_size, hipStream_t stream) {
    static int grid = 0;
    if (grid == 0) {
        if (n_in != 27 || out_size != MALL * DM || ws_size < WS_END) { fprintf(stderr, "kernel_launch: unexpected shapes: n_in %d out %d ws %zu (need %zu)\n", n_in, out_size, ws_size, (size_t)WS_END); grid = -1; return; }
        int dev = 0, cus = 0, per_cu = 0;
        if (hipGetDevice(&dev) != hipSuccess || hipDeviceGetAttribute(&cus, hipDeviceAttributeMultiprocessorCount, dev) != hipSuccess) { grid = -1; return; }
        if (hipFuncSetAttribute((const void*)fwd_kernel, hipFuncAttributeMaxDynamicSharedMemorySize, LDS_BYTES) != hipSuccess) { fprintf(stderr, "kernel_launch: hipFuncSetAttribute failed\n"); grid = -1; return; }
        if (hipOccupancyMaxActiveBlocksPerMultiprocessor(&per_cu, (const void*)fwd_kernel, NTHREADS, LDS_BYTES) != hipSuccess || per_cu < 1) fprintf(stderr, "kernel_launch: occupancy query says %d\n", per_cu);
        (void)hipGetLastError();
        grid = cus;
    }
    if (grid < 0) return;
    (void)hipMemsetAsync((char*)d_ws + WS_CTL, 0, CTL_ZERO_BYTES, stream);
    Args a{};
    for (int i = 0; i < 27; ++i) a.in[i] = (const float*)d_in[i];
    a.out = (float*)d_out; a.ws = (unsigned char*)d_ws; a.dbg = 0;
#if MK_ONE_LAUNCH
    a.l0 = 0; a.l1 = NLAYER; a.j0 = 0; a.j1 = NJOB; a.ph_lo = 0; a.ph_hi = NPHASE; a.one_launch = 1;
    hipLaunchKernelGGL(fwd_kernel, dim3(grid), dim3(NTHREADS), LDS_BYTES, stream, a);
#else
    a.one_launch = 0;
    for (int l = 0; l < NLAYER; ++l) {
        a.l0 = l; a.l1 = l + 1; a.j0 = 0; a.j1 = 0; a.ph_lo = 0; a.ph_hi = 1;
        hipLaunchKernelGGL(fwd_kernel, dim3(grid), dim3(NTHREADS), LDS_BYTES, stream, a);
        for (int j = 0; j < NJOB; ++j) for (int p = 1; p < NPHASE; ++p) { a.j0 = j; a.j1 = j + 1; a.ph_lo = p; a.ph_hi = p + 1;
            hipLaunchKernelGGL(fwd_kernel, dim3(grid), dim3(NTHREADS), LDS_BYTES, stream, a); }
    }
#endif
    const hipError_t le = hipPeekAtLastError();
    if (le != hipSuccess) fprintf(stderr, "kernel_launch: launch failed: %s\n", hipGetErrorName(le));
}
```
